# Optimizing an MI355X kernel written in HIP

```python
import math
import jax, jax.numpy as jnp
from jax import lax
import numpy as np

D_MODEL = 1024
BATCH = 2
SEQ = 16384
DEPTH = 2

CTX_LEN = 256
GRID_W = 64
EPS = 1e-6
N_MOD = 9
MACARON_WEIGHT = 0.5
D_FF = 2816

S5_WIDTH = 256
S5_GROUP = 16
S5_GROUPS = S5_WIDTH // S5_GROUP
S5_STATE = 64
DT_MIN = 1e-3
DT_MAX = 1e-1
CONV_WIDTH = 256
CONV_K = 31
POOL_WIDTH = 256
POOL_WINDOWS = (2, 4, 8, 16)
POOL_GROUP = POOL_WIDTH // len(POOL_WINDOWS)
MLA_HEADS = 8
MLA_NOPE = 64
MLA_ROPE = 32
MLA_V = 64
MLA_Q_RANK = 256
MLA_KV_RANK = 128
MLA_WIDTH = MLA_HEADS * MLA_V
ROPE_BASE = 10000.0
Q_BLOCK = 128

D_MIX = S5_WIDTH + CONV_WIDTH + POOL_WIDTH + MLA_WIDTH
IN_S5 = 0
IN_CONV = IN_S5 + S5_WIDTH
IN_POOL = IN_CONV + 2 * CONV_WIDTH
IN_CQ = IN_POOL + POOL_WIDTH
IN_CKV = IN_CQ + MLA_Q_RANK
IN_KR = IN_CKV + MLA_KV_RANK
D_IN = IN_KR + MLA_ROPE

kernel_name = "hybrid_s5_conv_pool_mla_prefix_dit"


def rms_norm(x, g):
    xf = x.astype(jnp.float32)
    y = xf * lax.rsqrt(jnp.mean(xf * xf, axis=-1, keepdims=True) + EPS)
    return (y * g.astype(jnp.float32)).astype(x.dtype)


def layer_norm(x, g, b):
    xf = x.astype(jnp.float32)
    mu = jnp.mean(xf, axis=-1, keepdims=True)
    var = jnp.mean(jnp.square(xf - mu), axis=-1, keepdims=True)
    y = (xf - mu) * lax.rsqrt(var + EPS)
    return (y * g.astype(jnp.float32) + b.astype(jnp.float32)).astype(x.dtype)


def ffn_sublayer(x, mod, base, pre_g, post_g, w_gate, w_up, w_down):
    h = rms_norm(x, pre_g) * (1 + mod[:, :, base + 1]) + mod[:, :, base]
    y = (jax.nn.silu(h @ w_gate) * (h @ w_up)) @ w_down
    return x + MACARON_WEIGHT * mod[:, :, base + 2] * rms_norm(y, post_g)


def s5_scan(u, lam_bar, b_bar, h0):
    bu = jnp.einsum('blgh,gph->blgp', u, b_bar)
    if h0 is not None:
        bu = bu.at[:, 0].add(lam_bar * h0)
    a = jnp.broadcast_to(lam_bar, bu.shape)

    def combine(left, right):
        a1, b1 = left
        a2, b2 = right
        return a1 * a2, a2 * b1 + b2

    _, h = lax.associative_scan(combine, (a, bu), axis=1)
    return h


def s5_direction(u_ctx, u_lat, p, d, ctx_out):
    f32 = jnp.float32
    lam = lax.complex(p['s5_lam_re'][d].astype(f32), p['s5_lam_im'][d].astype(f32))
    lam = lax.complex(jnp.minimum(lam.real, -1e-4), lam.imag)
    dt = jnp.exp(p['s5_log_dt'][d].astype(f32))[:, None]
    lam_bar = jnp.exp(lam * dt)
    b = lax.complex(p['s5_b_re'][d].astype(f32), p['s5_b_im'][d].astype(f32))
    b_bar = ((lam_bar - 1.0) / lam)[..., None] * b
    c_mat = lax.complex(p['s5_c_re'][d].astype(f32), p['s5_c_im'][d].astype(f32))
    h_ctx = s5_scan(u_ctx, lam_bar, b_bar, None)
    h_lat = s5_scan(u_lat, lam_bar, b_bar, h_ctx[:, -1])
    y_lat = jnp.einsum('blgp,ghp->blgh', h_lat, c_mat).real
    y_ctx = jnp.einsum('blgp,ghp->blgh', h_ctx, c_mat).real if ctx_out else None
    return y_lat, y_ctx


def s5_mixer(u_ctx, u_lat, p, ctx_out):
    def groups(u):
        return u.astype(jnp.float32).reshape(u.shape[0], u.shape[1], S5_GROUPS, S5_GROUP)

    def rev(t):
        return jnp.flip(t, axis=1)

    uc, ul = groups(u_ctx), groups(u_lat)
    yl_f, yc_f = s5_direction(uc, ul, p, 0, ctx_out)
    yl_b, yc_b = s5_direction(rev(uc), rev(ul), p, 1, ctx_out)

    def finish(y, u):
        y = y.reshape(u.shape) + p['s5_d'].astype(jnp.float32) * u.astype(jnp.float32)
        y = jax.nn.gelu(y).astype(u.dtype)
        return y * jax.nn.sigmoid(y @ p['s5_w_glu'] + p['s5_b_glu'])

    y_lat = finish(yl_f + rev(yl_b), u_lat)
    y_ctx = finish(yc_f + rev(yc_b), u_ctx) if ctx_out else None
    return y_lat, y_ctx


def conv_mixer(z, p):
    h = z[..., :CONV_WIDTH] * jax.nn.sigmoid(z[..., CONV_WIDTH:])
    h = lax.conv_general_dilated(
        h, p['conv_w'][:, None, :], window_strides=(1,),
        padding=[(CONV_K // 2, CONV_K // 2)],
        dimension_numbers=('NWC', 'WIO', 'NWC'),
        feature_group_count=CONV_WIDTH) + p['conv_b']
    return jax.nn.silu(layer_norm(h, p['conv_ln_g'], p['conv_ln_b']))


def pool_mixer(z, p):
    L = z.shape[1]
    zf = z.astype(jnp.float32)
    cs = jnp.pad(jnp.cumsum(zf, axis=1), ((0, 0), (1, 0), (0, 0)))
    t = jnp.arange(L)
    outs = []
    for gi, w in enumerate(POOL_WINDOWS):
        sl = slice(gi * POOL_GROUP, (gi + 1) * POOL_GROUP)
        lo = jnp.maximum(t - (w - 1) // 2, 0)
        hi = jnp.minimum(t + w // 2, L - 1)
        csg = cs[..., sl]
        mean = (csg[:, hi + 1] - csg[:, lo]) / (hi - lo + 1).astype(jnp.float32)[:, None]
        outs.append(jnp.einsum('blc,cd->bld', mean - zf[..., sl], p['pool_w'][gi].astype(jnp.float32)))
    y = jnp.concatenate(outs, axis=-1) * p['pool_scale'].astype(jnp.float32)
    return y.astype(z.dtype)


def grid_rope(n_lat):
    rows = n_lat // GRID_W
    row = jnp.repeat(jnp.arange(rows), GRID_W).astype(jnp.float32)
    col = (jnp.arange(rows * GRID_W) % GRID_W).astype(jnp.float32)
    axis_dim = MLA_ROPE // 2
    inv = ROPE_BASE ** (-jnp.arange(0, axis_dim, 2, dtype=jnp.float32) / axis_dim)
    ang_r = (row[:, None] * inv)[:, None, :]
    ang_c = (col[:, None] * inv)[:, None, :]
    return jnp.cos(ang_r), jnp.sin(ang_r), jnp.cos(ang_c), jnp.sin(ang_c)


def rope_2d(x, rope):
    cos_r, sin_r, cos_c, sin_c = rope
    xf = x.astype(jnp.float32)

    def rot(xh, cos, sin):
        x1, x2 = jnp.split(xh, 2, axis=-1)
        return jnp.concatenate([x1 * cos - x2 * sin, x2 * cos + x1 * sin], axis=-1)

    xr, xc = jnp.split(xf, 2, axis=-1)
    return jnp.concatenate([rot(xr, cos_r, sin_r), rot(xc, cos_c, sin_c)], axis=-1).astype(x.dtype)


def mla_keys_values(ckv, k_rope, p, rope):
    B, L, _ = ckv.shape
    kv = (rms_norm(ckv, p['mla_kv_norm']) @ p['mla_w_ukv']).reshape(B, L, MLA_HEADS, MLA_NOPE + MLA_V)
    k_nope, v = kv[..., :MLA_NOPE], kv[..., MLA_NOPE:]
    k_rope = k_rope[:, :, None, :]
    if rope is not None:
        k_rope = rope_2d(k_rope, rope)
    k_rope = jnp.broadcast_to(k_rope, (B, L, MLA_HEADS, MLA_ROPE))
    return jnp.concatenate([k_nope, k_rope], axis=-1), v


def mla_queries(cq, p, rope):
    B, L, _ = cq.shape
    q = (rms_norm(cq, p['mla_q_norm']) @ p['mla_w_uq']).reshape(B, L, MLA_HEADS, MLA_NOPE + MLA_ROPE)
    if rope is None:
        return q
    return jnp.concatenate([q[..., :MLA_NOPE], rope_2d(q[..., MLA_NOPE:], rope)], axis=-1)


def block_attention(q, k, v):
    B, Lq, H, Dk = q.shape
    nb = Lq // Q_BLOCK
    scale = Dk ** -0.5
    qb = jnp.moveaxis(q.reshape(B, nb, Q_BLOCK, H, Dk), 1, 0)

    def one_block(qi):
        s = jnp.einsum('bqhd,bkhd->bhqk', qi, k, preferred_element_type=jnp.float32) * scale
        pr = jax.nn.softmax(s, axis=-1).astype(v.dtype)
        return jnp.einsum('bhqk,bkhd->bqhd', pr, v)

    o = lax.map(one_block, qb)
    return jnp.moveaxis(o, 0, 1).reshape(B, Lq, H * v.shape[-1])


def token_mixing(x_lat, x_ctx, mod_lat, mod_ctx, rope, p, ctx_out):
    base = 3

    def pre(x, mod):
        return rms_norm(x, p['pre'][1]) * (1 + mod[:, :, base + 1]) + mod[:, :, base]

    h_lat = pre(x_lat, mod_lat)
    h_ctx = pre(x_ctx, mod_ctx)
    z_lat = h_lat @ p['w_in']
    if ctx_out:
        z_ctx = h_ctx @ p['w_in']
        u_ctx, kvz_ctx = z_ctx[..., IN_S5:IN_CONV], z_ctx[..., IN_CKV:D_IN]
    else:
        u_ctx = h_ctx @ p['w_in'][:, IN_S5:IN_CONV]
        kvz_ctx = h_ctx @ p['w_in'][:, IN_CKV:D_IN]

    s5_lat, s5_ctx = s5_mixer(u_ctx, z_lat[..., IN_S5:IN_CONV], p, ctx_out)
    conv_lat = conv_mixer(z_lat[..., IN_CONV:IN_POOL], p)
    pool_lat = pool_mixer(z_lat[..., IN_POOL:IN_CQ], p)
    k_ctx, v_ctx = mla_keys_values(kvz_ctx[..., :MLA_KV_RANK], kvz_ctx[..., MLA_KV_RANK:], p, None)
    k_lat, v_lat = mla_keys_values(z_lat[..., IN_CKV:IN_KR], z_lat[..., IN_KR:D_IN], p, rope)
    q_lat = mla_queries(z_lat[..., IN_CQ:IN_CKV], p, rope)
    att_lat = block_attention(q_lat, jnp.concatenate([k_lat, k_ctx], axis=1),
                              jnp.concatenate([v_lat, v_ctx], axis=1))

    y_lat = jnp.concatenate([s5_lat, conv_lat, pool_lat, att_lat], axis=-1) @ p['w_out']
    x_lat = x_lat + mod_lat[:, :, base + 2] * rms_norm(y_lat, p['post'][1])
    if not ctx_out:
        return x_lat, None

    conv_ctx = conv_mixer(z_ctx[..., IN_CONV:IN_POOL], p)
    pool_ctx = pool_mixer(z_ctx[..., IN_POOL:IN_CQ], p)
    q_ctx = mla_queries(z_ctx[..., IN_CQ:IN_CKV], p, None)
    att_ctx = block_attention(q_ctx, k_ctx, v_ctx)
    y_ctx = jnp.concatenate([s5_ctx, conv_ctx, pool_ctx, att_ctx], axis=-1) @ p['w_out']
    x_ctx = x_ctx + mod_ctx[:, :, base + 2] * rms_norm(y_ctx, p['post'][1])
    return x_lat, x_ctx


def setup_inputs(seed: int = 0) -> dict:
    key = jax.random.key(seed)
    ks = iter(jax.random.split(key, 40))
    f32 = jnp.float32

    def nrm(shape, std):
        return std * jax.random.normal(next(ks), shape, f32)

    def gain(shape):
        return 1.0 + nrm(shape, 0.02)

    D, F = D_MODEL, D_FF
    G, P, H = S5_GROUPS, S5_STATE, S5_GROUP
    return {
        "x": nrm((BATCH, SEQ, D), 1.0),
        "c": nrm((BATCH, D), 1.0),
        "ctx": nrm((BATCH, CTX_LEN, D), 1.0),
        "c_ctx": nrm((D,), 1.0),
        "w_ada": nrm((DEPTH, D, N_MOD * D), 0.5 * D ** -0.5),
        "b_ada": nrm((DEPTH, N_MOD * D), 0.02),
        "norm_pre": gain((DEPTH, 3, D)),
        "norm_post": gain((DEPTH, 3, D)),
        "ffn_w_gate": nrm((DEPTH, 2, D, F), D ** -0.5),
        "ffn_w_up": nrm((DEPTH, 2, D, F), D ** -0.5),
        "ffn_w_down": nrm((DEPTH, 2, F, D), F ** -0.5),
        "w_in": nrm((DEPTH, D, D_IN), D ** -0.5),
        "w_out": nrm((DEPTH, D_MIX, D), D_MIX ** -0.5),
        "s5_lam_re": -0.5 + nrm((DEPTH, 2, G, P), 0.01),
        "s5_lam_im": math.pi * jnp.arange(P, dtype=f32) + nrm((DEPTH, 2, G, P), 0.01),
        "s5_log_dt": jax.random.uniform(next(ks), (DEPTH, 2, G), f32, math.log(DT_MIN), math.log(DT_MAX)),
        "s5_b_re": nrm((DEPTH, 2, G, P, H), (2 * H) ** -0.5),
        "s5_b_im": nrm((DEPTH, 2, G, P, H), (2 * H) ** -0.5),
        "s5_c_re": nrm((DEPTH, 2, G, H, P), 0.5),
        "s5_c_im": nrm((DEPTH, 2, G, H, P), 0.5),
        "s5_d": nrm((DEPTH, S5_WIDTH), 1.0),
        "s5_w_glu": nrm((DEPTH, S5_WIDTH, S5_WIDTH), S5_WIDTH ** -0.5),
        "s5_b_glu": nrm((DEPTH, S5_WIDTH), 0.02),
        "conv_w": nrm((DEPTH, CONV_K, CONV_WIDTH), CONV_K ** -0.5),
        "conv_b": nrm((DEPTH, CONV_WIDTH), 0.02),
        "conv_ln_g": gain((DEPTH, CONV_WIDTH)),
        "conv_ln_b": nrm((DEPTH, CONV_WIDTH), 0.02),
        "pool_w": nrm((DEPTH, len(POOL_WINDOWS), POOL_GROUP, POOL_GROUP), POOL_GROUP ** -0.5),
        "pool_scale": gain((DEPTH, POOL_WIDTH)),
        "mla_q_norm": gain((DEPTH, MLA_Q_RANK)),
        "mla_w_uq": nrm((DEPTH, MLA_Q_RANK, MLA_HEADS * (MLA_NOPE + MLA_ROPE)), MLA_Q_RANK ** -0.5),
        "mla_kv_norm": gain((DEPTH, MLA_KV_RANK)),
        "mla_w_ukv": nrm((DEPTH, MLA_KV_RANK, MLA_HEADS * (MLA_NOPE + MLA_V)), MLA_KV_RANK ** -0.5),
    }


def reference(x, c, ctx, c_ctx, w_ada, b_ada, norm_pre, norm_post, ffn_w_gate, ffn_w_up, ffn_w_down,
              w_in, w_out, s5_lam_re, s5_lam_im, s5_log_dt, s5_b_re, s5_b_im, s5_c_re, s5_c_im, s5_d,
              s5_w_glu, s5_b_glu, conv_w, conv_b, conv_ln_g, conv_ln_b, pool_w, pool_scale,
              mla_q_norm, mla_w_uq, mla_kv_norm, mla_w_ukv):
    batch, n_lat, _ = x.shape
    rope = grid_rope(n_lat)
    x_lat, x_ctx = x, ctx
    for l in range(DEPTH):
        last = l == DEPTH - 1
        p = {
            'pre': norm_pre[l], 'post': norm_post[l], 'w_in': w_in[l], 'w_out': w_out[l],
            's5_lam_re': s5_lam_re[l], 's5_lam_im': s5_lam_im[l], 's5_log_dt': s5_log_dt[l],
            's5_b_re': s5_b_re[l], 's5_b_im': s5_b_im[l], 's5_c_re': s5_c_re[l], 's5_c_im': s5_c_im[l],
            's5_d': s5_d[l], 's5_w_glu': s5_w_glu[l], 's5_b_glu': s5_b_glu[l],
            'conv_w': conv_w[l], 'conv_b': conv_b[l], 'conv_ln_g': conv_ln_g[l], 'conv_ln_b': conv_ln_b[l],
            'pool_w': pool_w[l], 'pool_scale': pool_scale[l],
            'mla_q_norm': mla_q_norm[l], 'mla_w_uq': mla_w_uq[l],
            'mla_kv_norm': mla_kv_norm[l], 'mla_w_ukv': mla_w_ukv[l],
        }
        mod_lat = (jax.nn.silu(c) @ w_ada[l] + b_ada[l]).reshape(batch, 1, N_MOD, D_MODEL)
        mod_ctx = (jax.nn.silu(c_ctx) @ w_ada[l] + b_ada[l]).reshape(1, 1, N_MOD, D_MODEL)
        x_lat = ffn_sublayer(x_lat, mod_lat, 0, norm_pre[l, 0], norm_post[l, 0],
                             ffn_w_gate[l, 0], ffn_w_up[l, 0], ffn_w_down[l, 0])
        x_ctx = ffn_sublayer(x_ctx, mod_ctx, 0, norm_pre[l, 0], norm_post[l, 0],
                             ffn_w_gate[l, 0], ffn_w_up[l, 0], ffn_w_down[l, 0])
        x_lat, x_ctx = token_mixing(x_lat, x_ctx, mod_lat, mod_ctx, rope, p, not last)
        x_lat = ffn_sublayer(x_lat, mod_lat, 6, norm_pre[l, 2], norm_post[l, 2],
                             ffn_w_gate[l, 1], ffn_w_up[l, 1], ffn_w_down[l, 1])
        if not last:
            x_ctx = ffn_sublayer(x_ctx, mod_ctx, 6, norm_pre[l, 2], norm_post[l, 2],
                                 ffn_w_gate[l, 1], ffn_w_up[l, 1], ffn_w_down[l, 1])
    return x_lat
```

```cpp
#include <hip/hip_runtime.h>
#include <hip/hip_cooperative_groups.h>
#include <cstdio>
#include <cstdint>
namespace cg = cooperative_groups;

#ifndef ONE_LAUNCH
#define ONE_LAUNCH 1
#endif
#define PROBE_MODE 0
#define EXTRA_SYNCS 0
#define MISC_DUP 0
#define ATT_PROBE 0
#define DUP_MASK 0

#define DI __device__ __forceinline__
#define PH_FN __device__ __forceinline__
typedef unsigned short bf16_t;
using bf16x8 = __attribute__((ext_vector_type(8))) short;
using f32x16 = __attribute__((ext_vector_type(16))) float;
using f32x4 = __attribute__((ext_vector_type(4))) float;
typedef unsigned u32x4 __attribute__((ext_vector_type(4)));
typedef __bf16 bf16x2_t __attribute__((ext_vector_type(2)));
typedef float f2_t __attribute__((ext_vector_type(2)));

constexpr int D = 1024, SEQ = 16384, NB = 2, CTXL = 256;
constexpr int NL = NB * SEQ, NC = NB * CTXL, NT = NL + NC;
constexpr int FF = 2816, DIN = 1440, DMIX = 1280;
constexpr int NH = 8, DK = 96, LK = SEQ + CTXL;
constexpr int IN_CONV = 256, IN_POOL = 768, IN_CQ = 1024, IN_CKV = 1280, IN_KR = 1408;
constexpr int NCHUNK = LK / 64;
constexpr float EPS = 1e-6f;
constexpr float QSCALE = 0.10206207261596575f * 1.4426950408889634f;

constexpr size_t EL_GU = 5632ull * 1024, EL_D = 1024ull * 2816, EL_IN = 1536ull * 1024, EL_OUT = 1024ull * 1280,
                 EL_UQ = 768ull * 256, EL_UKV = 1024ull * 128, EL_GLU = 256ull * 256;
constexpr size_t WO_GU0 = 0, WO_GU1 = EL_GU, WO_D0 = 2 * EL_GU, WO_D1 = WO_D0 + EL_D, WO_IN = WO_D1 + EL_D,
                 WO_OUT = WO_IN + EL_IN, WO_UQ = WO_OUT + EL_OUT, WO_UKV = WO_UQ + EL_UQ, WO_GLU = WO_UKV + EL_UKV,
                 WL_EL = WO_GLU + EL_GLU;
constexpr size_t al256(size_t x) { return (x + 255) & ~(size_t)255; }
constexpr size_t OFF_W = 0;
constexpr size_t OFF_MOD = al256(OFF_W + 2 * WL_EL * 2);
constexpr size_t OFF_ROPE = al256(OFF_MOD + 2ull * 3 * 9216 * 4);
constexpr size_t OFF_LAMB = al256(OFF_ROPE + 256ull * 8 * 2 * 4);
constexpr size_t OFF_BBAR = al256(OFF_LAMB + 2ull * 2048 * 16);
constexpr size_t OFF_CC = al256(OFF_BBAR + 2ull * 2048 * 32 * 4);
constexpr size_t OFF_XC = al256(OFF_CC + 2ull * 32 * 2048 * 2);
constexpr size_t OFF_HY = al256(OFF_XC + (size_t)NC * D * 4);
constexpr size_t OFF_BIG = al256(OFF_HY + (size_t)NT * D * 2);
constexpr size_t OFF_ACT = OFF_BIG;
constexpr size_t OFF_Z = OFF_BIG;
constexpr size_t OFF_Q = al256(OFF_Z + (size_t)NT * DIN * 2);
constexpr size_t OFF_K = al256(OFF_Q + (size_t)NT * 768 * 2);
constexpr size_t OFF_VT = al256(OFF_K + (size_t)NB * NH * LK * 96 * 2);
constexpr size_t OFF_MIX = al256(OFF_VT + (size_t)NB * NH * 64 * LK * 2);
constexpr size_t OFF_S5P = al256(OFF_MIX + (size_t)NT * DMIX * 2);
constexpr size_t OFF_E = al256(OFF_S5P + (size_t)NT * 256 * 2);
constexpr size_t OFF_S = al256(OFF_E + 2ull * 2 * NCHUNK * 1024 * 8);
constexpr size_t OFF_BAR = al256(OFF_S + 2ull * 2 * NCHUNK * 1024 * 8);
constexpr size_t WS_END = al256(OFF_BAR + 3456 * 4);
static_assert(OFF_ACT + (size_t)NT * FF * 2 <= WS_END, "act fits");

struct KP { const float* in[33]; float* out; char* ws; };

DI int TIDX() { int t = threadIdx.x; asm volatile("" : "+v"(t)); return t; }
DI float bf2f(bf16_t b) { return __uint_as_float((unsigned)b << 16); }
DI unsigned pack2(float a, float b) { f2_t v = {a, b}; bf16x2_t r = __builtin_convertvector(v, bf16x2_t); return __builtin_bit_cast(unsigned, r); }
DI bf16_t f2bf(float a) { return (bf16_t)(pack2(a, 0.f) & 0xffffu); }
DI float fast_exp(float x) { return __builtin_amdgcn_exp2f(x * 1.4426950408889634f); }
DI float sigmoidf_(float x) { return __builtin_amdgcn_rcpf(1.f + fast_exp(-x)); }
DI float siluf_(float x) { return x * sigmoidf_(x); }
DI float gelu_tanh(float x) { float u = 0.7978845608028654f * (x + 0.044715f * x * x * x); float t = 1.f - 2.f * __builtin_amdgcn_rcpf(1.f + fast_exp(2.f * u)); return 0.5f * x * (1.f + t); }
DI float shflx(float v, int m) { const int idx = ((TIDX() & 63) ^ m) << 2; return __int_as_float(__builtin_amdgcn_ds_bpermute(idx, __float_as_int(v))); }
DI float xhalf_max(float v) { const auto r = __builtin_amdgcn_permlane32_swap(__float_as_uint(v), __float_as_uint(v), false, false); return fmaxf(__uint_as_float(r[0]), __uint_as_float(r[1])); }
DI float xhalf_sum(float v) { const auto r = __builtin_amdgcn_permlane32_swap(__float_as_uint(v), __float_as_uint(v), false, false); return __uint_as_float(r[0]) + __uint_as_float(r[1]); }
DI float wave_sum(float v) { for (int m = 32; m >= 1; m >>= 1) v += shflx(v, m); return v; }
DI int crow(int i, int hh) { return (i & 3) + 8 * (i >> 2) + 4 * hh; }
DI int row_mod(int row) { return row < NL ? (row >= SEQ ? 1 : 0) : 2; }
DI int vblock() { const int G = gridDim.x, b = blockIdx.x; return (G & 7) ? b : (G >> 3) * (b & 7) + (b >> 3); }
DI void tile_mn(int it, int TM, int TN, int& mt, int& nt) {
    const int band = it / (8 * TN), within = it - band * 8 * TN;
    const int gm = min(8, TM - 8 * band);
    nt = within / gm; mt = 8 * band + (within - nt * gm);
}
DI void gld16(u32x4& r, const void* p) { asm volatile("global_load_dwordx4 %0, %1, off" : "=&v"(r) : "v"(p) : "memory"); }
DI void vm_wait8(u32x4& a, u32x4& b, u32x4& c, u32x4& d, u32x4& e, u32x4& f, u32x4& g, u32x4& h) {
    asm volatile("s_waitcnt vmcnt(0)" : "+v"(a), "+v"(b), "+v"(c), "+v"(d), "+v"(e), "+v"(f), "+v"(g), "+v"(h) : : "memory"); }
DI void vm_wait5(u32x4& a, u32x4& b, u32x4& c, u32x4& d, u32x4& e) {
    asm volatile("s_waitcnt vmcnt(0)" : "+v"(a), "+v"(b), "+v"(c), "+v"(d), "+v"(e) : : "memory"); }
#define MFMA32(a, b, c) __builtin_amdgcn_mfma_f32_32x32x16_bf16((a), (b), (c), 0, 0, 0)
#define MFMA16(a, b, c) __builtin_amdgcn_mfma_f32_16x16x32_bf16((a), (b), (c), 0, 0, 0)

#define XB_TMO      128
#define XB_XCNT(j)  (256  + 64 * (j))
#define XB_XSUB(j)  (1280 + 64 * (j))
#define XB_XGEN(j)  (2304 + 64 * (j))
#define XB_TOP      3328
#define XB_TOPGEN   3392
#define XCD_BAR_WORDS 3456
#define XB_SPIN_CAP (1u << 18)
#define LAS __attribute__((address_space(3)))

__device__ __forceinline__ unsigned xb_ld(unsigned* p)              { return __hip_atomic_load(p, __ATOMIC_RELAXED, __HIP_MEMORY_SCOPE_AGENT); }
__device__ __forceinline__ unsigned xb_add(unsigned* p, unsigned v) { return __hip_atomic_fetch_add(p, v, __ATOMIC_RELAXED, __HIP_MEMORY_SCOPE_AGENT); }
__device__ __forceinline__ unsigned xb_xcc_id() { return (unsigned)__builtin_amdgcn_s_getreg((3 << 11) | 20) & 0xFu; }
#define XB_SPIN(cond, bar) do { unsigned _sp = 0; while (cond) { __builtin_amdgcn_s_sleep(1); \
    if ((++_sp & 255u) == 0u) { if (xb_ld(&(bar)[XB_TMO])) break; if (_sp > XB_SPIN_CAP) { atomicAdd(&(bar)[XB_TMO], 1u); break; } } } } while (0)

struct XcdBarrier {
    unsigned* bar; unsigned x;
    volatile LAS unsigned* st;
};

__device__ __forceinline__ XcdBarrier xcd_barrier_post(unsigned* bar, volatile LAS unsigned* st) {
    XcdBarrier b; b.bar = bar; b.x = xb_xcc_id(); b.st = st;
    if (TIDX() == 0) (void)xb_add(&bar[XB_XCNT(b.x)], 1u);
    return b;
}
__device__ __forceinline__ void xcd_barrier_complete(unsigned* bar, unsigned x, unsigned& nloc, unsigned& nx) {
    const unsigned G = gridDim.x * gridDim.y * gridDim.z;
    unsigned sum, cnt, mine, sp = 0u;
    for (;;) {
        sum = 0u; cnt = 0u; mine = 0u;
#pragma unroll
        for (unsigned j = 0; j < 16; ++j) { const unsigned c = xb_ld(&bar[XB_XCNT(j)]); sum += c; cnt += (c > 0u) ? 1u : 0u; mine = (j == x) ? c : mine; }
        if (sum == G) break;
        __builtin_amdgcn_s_sleep(1);
        if ((++sp & 255u) == 0u) { if (xb_ld(&bar[XB_TMO])) break; if (sp > XB_SPIN_CAP) { atomicAdd(&bar[XB_TMO], 1u); break; } }
    }
    nloc = mine > 0u ? mine : 1u; nx = cnt > 0u ? cnt : 1u;
}

__device__ __forceinline__ void xcd_barrier(const XcdBarrier& b) {
    asm volatile("s_waitcnt vmcnt(0)" ::: "memory");
    __syncthreads();
    if (TIDX() == 0) {
        unsigned* bar = b.bar;
        __builtin_amdgcn_s_waitcnt(0);
        unsigned nloc = b.st[0], nx = b.st[1];
        if (nloc == 0u) { xcd_barrier_complete(bar, b.x, nloc, nx); b.st[0] = nloc; b.st[1] = nx; }
        const unsigned old = xb_add(&bar[XB_XSUB(b.x)], 1u);
        const unsigned gen = old / nloc;
        if (old + 1u == (gen + 1u) * nloc) {
            __builtin_amdgcn_fence(__ATOMIC_RELEASE, "agent");
            asm volatile("s_waitcnt vmcnt(0)" ::: "memory");
            const unsigned og = xb_add(&bar[XB_TOP], 1u);
            const unsigned tg = og / nx;
            if (og + 1u == (tg + 1u) * nx) xb_add(&bar[XB_TOPGEN], 1u);
            else XB_SPIN(xb_ld(&bar[XB_TOPGEN]) == tg, bar);
            __builtin_amdgcn_fence(__ATOMIC_ACQUIRE, "agent");
            xb_add(&bar[XB_XGEN(b.x)], 1u);
            asm volatile("s_waitcnt vmcnt(0)" ::: "memory");
        } else {
            XB_SPIN(xb_ld(&bar[XB_XGEN(b.x)]) == gen, bar);
            __builtin_amdgcn_fence(__ATOMIC_ACQUIRE, "agent");
            asm volatile("s_waitcnt vmcnt(0)" ::: "memory");
        }
    }
    __syncthreads();
}


DI void vm_wait_sel(u32x4& a, u32x4& b, u32x4& c, u32x4& d, u32x4& e, u32x4& f, u32x4& g, u32x4& h, int all) {
    asm volatile("s_cmp_lg_u32 %8, 0\n\ts_cbranch_scc1 1f\n\ts_waitcnt vmcnt(8)\n\ts_branch 2f\n1:\n\ts_waitcnt vmcnt(0)\n2:"
                 : "+v"(a), "+v"(b), "+v"(c), "+v"(d), "+v"(e), "+v"(f), "+v"(g), "+v"(h) : "s"(all) : "memory", "scc"); }

template <int MODE = 0, class Epi>
DI void gemm_tile(const bf16_t* __restrict__ A, int lda, const bf16_t* __restrict__ Bt, int ldb, int K, int row0, int col0, char* smem, Epi&& epi) {
    bf16_t* sA = (bf16_t*)smem;
    bf16_t* sB = sA + 2 * 8192;
    const int tid = TIDX(), lane = tid & 63, wave = tid >> 6;
    const int wm = wave >> 1, wn = wave & 1, l31 = lane & 31, hh = lane >> 5;
    u32x4 r0a[4], r0b[4], r1a[4], r1b[4];
    const bf16_t* Ap = A + (size_t)(row0 + (tid >> 3)) * lda + (tid & 7) * 8;
    const bf16_t* Bp = Bt + (size_t)(col0 + (tid >> 3)) * ldb + (tid & 7) * 8;
    const int wr_off = (tid >> 3) * 64 + (((tid & 7) ^ ((tid >> 4) & 7)) * 8);
    f32x16 acc[2][2];
#pragma unroll
    for (int a = 0; a < 2; ++a)
#pragma unroll
        for (int b = 0; b < 2; ++b)
#pragma unroll
            for (int i = 0; i < 16; ++i) acc[a][b][i] = 0.f;
    const int nk = K >> 6;
#pragma unroll
    for (int i = 0; i < 4; ++i) { r0a[i] = *(const u32x4*)(Ap + (size_t)i * 32 * lda); r0b[i] = *(const u32x4*)(Bp + (size_t)i * 32 * ldb); }
#pragma unroll
    for (int i = 0; i < 4; ++i) { *(u32x4*)(sA + wr_off + i * 2048) = r0a[i]; *(u32x4*)(sB + wr_off + i * 2048) = r0b[i]; }
#pragma unroll
    for (int i = 0; i < 4; ++i) { gld16(r1a[i], Ap + (size_t)i * 32 * lda + 64); gld16(r1b[i], Bp + (size_t)i * 32 * ldb + 64); }
    __syncthreads();
    const int sw = (l31 >> 1) & 7;
    const bf16_t* cA = sA + (wm * 64 + l31) * 64;
    const bf16_t* cB = sB + (wn * 64 + l31) * 64;
#define GEMM_LDFRAG(buf_, ks_, a0_, a1_, b0_, b1_) do { const int ch = ((2 * (ks_) + hh) ^ sw) * 8; \
            a0_ = *(const bf16x8*)(cA + (buf_) * 8192 + ch); a1_ = *(const bf16x8*)(cA + (buf_) * 8192 + 32 * 64 + ch); \
            b0_ = *(const bf16x8*)(cB + (buf_) * 8192 + ch); b1_ = *(const bf16x8*)(cB + (buf_) * 8192 + 32 * 64 + ch); } while (0)
#define GEMM_MMA(a0_, a1_, b0_, b1_) do { acc[0][0] = MFMA32(a0_, b0_, acc[0][0]); acc[0][1] = MFMA32(a0_, b1_, acc[0][1]); \
            acc[1][0] = MFMA32(a1_, b0_, acc[1][0]); acc[1][1] = MFMA32(a1_, b1_, acc[1][1]); } while (0)
#define SB_ __builtin_amdgcn_sched_barrier(0)
#define GEMM_COMPUTE(buf_) do { bf16x8 pa0, pa1, pb0, pb1, qa0, qa1, qb0, qb1; \
            GEMM_LDFRAG(buf_, 0, pa0, pa1, pb0, pb1); GEMM_LDFRAG(buf_, 1, qa0, qa1, qb0, qb1); SB_; GEMM_MMA(pa0, pa1, pb0, pb1); SB_; \
            GEMM_LDFRAG(buf_, 2, pa0, pa1, pb0, pb1); SB_; GEMM_MMA(qa0, qa1, qb0, qb1); SB_; \
            GEMM_LDFRAG(buf_, 3, qa0, qa1, qb0, qb1); SB_; GEMM_MMA(pa0, pa1, pb0, pb1); SB_; GEMM_MMA(qa0, qa1, qb0, qb1); SB_; } while (0)
    for (int kt = 0; kt < nk; kt += 2) {
        const bool m2 = (kt + 2) < nk, m3 = (kt + 3) < nk;
        if (m2 && MODE == 0) {
            const int k0 = (kt + 2) << 6;
#pragma unroll
            for (int i = 0; i < 4; ++i) { gld16(r0a[i], Ap + (size_t)i * 32 * lda + k0); gld16(r0b[i], Bp + (size_t)i * 32 * ldb + k0); }
        }
        GEMM_COMPUTE(0);
        vm_wait_sel(r1a[0], r1a[1], r1a[2], r1a[3], r1b[0], r1b[1], r1b[2], r1b[3], __builtin_amdgcn_readfirstlane((m2 && MODE == 0) ? 0 : 1));
        if (MODE < 2)
#pragma unroll
        for (int i = 0; i < 4; ++i) { *(u32x4*)(sA + 8192 + wr_off + i * 2048) = r1a[i]; *(u32x4*)(sB + 8192 + wr_off + i * 2048) = r1b[i]; }
        __syncthreads();
        if (m3 && MODE == 0) {
            const int k0 = (kt + 3) << 6;
#pragma unroll
            for (int i = 0; i < 4; ++i) { gld16(r1a[i], Ap + (size_t)i * 32 * lda + k0); gld16(r1b[i], Bp + (size_t)i * 32 * ldb + k0); }
        }
        GEMM_COMPUTE(1);
        if (m2) {
            vm_wait_sel(r0a[0], r0a[1], r0a[2], r0a[3], r0b[0], r0b[1], r0b[2], r0b[3], __builtin_amdgcn_readfirstlane((m3 && MODE == 0) ? 0 : 1));
            if (MODE < 2)
#pragma unroll
            for (int i = 0; i < 4; ++i) { *(u32x4*)(sA + wr_off + i * 2048) = r0a[i]; *(u32x4*)(sB + wr_off + i * 2048) = r0b[i]; }
        }
        __syncthreads();
    }
#undef GEMM_COMPUTE
#undef GEMM_LDFRAG
#undef GEMM_MMA
    epi(acc, row0 + wm * 64, col0 + wn * 64);
}

DI const bf16_t* uni_ptr(const bf16_t* p) {
    const unsigned long long v = (unsigned long long)p;
    const unsigned lo = __builtin_amdgcn_readfirstlane((unsigned)v), hi = __builtin_amdgcn_readfirstlane((unsigned)(v >> 32));
    return (const bf16_t*)(((unsigned long long)hi << 32) | lo); }
DI void gld16s(u32x4& r, unsigned voff, const void* sbase) { asm volatile("global_load_dwordx4 %0, %1, %2" : "=&v"(r) : "v"(voff), "s"(sbase) : "memory"); }
DI void vm_wait12(u32x4& a, u32x4& b, u32x4& c, u32x4& d, u32x4& e, u32x4& f, u32x4& g, u32x4& h, u32x4& i, u32x4& j, u32x4& k, u32x4& l) {
    asm volatile("s_waitcnt vmcnt(0)" : "+v"(a), "+v"(b), "+v"(c), "+v"(d), "+v"(e), "+v"(f), "+v"(g), "+v"(h), "+v"(i), "+v"(j), "+v"(k), "+v"(l) : : "memory"); }

template <class Epi>
DI void gemm_tile256(const bf16_t* __restrict__ A, int lda, const bf16_t* __restrict__ Bt, int ldb, int K, int row0, int col0, char* smem, Epi&& epi) {
    bf16_t* sA = (bf16_t*)smem;
    bf16_t* sB = sA + 256 * 64;
    const int tid = TIDX(), lane = tid & 63, wave = tid >> 6;
    const int wm = wave >> 1, wn = wave & 1, l31 = lane & 31, hh = lane >> 5;
    u32x4 ra[8], rb[4];
    const bf16_t* Ab = uni_ptr(A + (size_t)row0 * lda);
    const bf16_t* Bb = uni_ptr(Bt + (size_t)col0 * ldb);
    const unsigned voa = ((unsigned)(tid >> 3) * (unsigned)lda + (tid & 7) * 8) * 2u;
    const unsigned vob = ((unsigned)(tid >> 3) * (unsigned)ldb + (tid & 7) * 8) * 2u;
    const int wr_off = (tid >> 3) * 64 + (((tid & 7) ^ ((tid >> 4) & 7)) * 8);
    f32x16 acc[4][2];
#pragma unroll
    for (int a = 0; a < 4; ++a)
#pragma unroll
        for (int b = 0; b < 2; ++b)
#pragma unroll
            for (int i = 0; i < 16; ++i) acc[a][b][i] = 0.f;
    const int nk = K >> 6;
#pragma unroll
    for (int i = 0; i < 8; ++i) gld16s(ra[i], voa, Ab + (size_t)i * 32 * lda);
#pragma unroll
    for (int i = 0; i < 4; ++i) gld16s(rb[i], vob, Bb + (size_t)i * 32 * ldb);
    const int sw = (l31 >> 1) & 7;
    const bf16_t* cA = sA + (wm * 128 + l31) * 64;
    const bf16_t* cB = sB + (wn * 64 + l31) * 64;
    for (int kt = 0; kt < nk; ++kt) {
        vm_wait12(ra[0], ra[1], ra[2], ra[3], ra[4], ra[5], ra[6], ra[7], rb[0], rb[1], rb[2], rb[3]);
#pragma unroll
        for (int i = 0; i < 8; ++i) *(u32x4*)(sA + wr_off + i * 2048) = ra[i];
#pragma unroll
        for (int i = 0; i < 4; ++i) *(u32x4*)(sB + wr_off + i * 2048) = rb[i];
        __syncthreads();
        if (kt + 1 < nk) {
            const int k0 = (kt + 1) << 6;
#pragma unroll
            for (int i = 0; i < 8; ++i) gld16s(ra[i], voa, Ab + (size_t)i * 32 * lda + k0);
#pragma unroll
            for (int i = 0; i < 4; ++i) gld16s(rb[i], vob, Bb + (size_t)i * 32 * ldb + k0);
        }
        __builtin_amdgcn_s_setprio(1);
#pragma unroll
        for (int ks = 0; ks < 4; ++ks) {
            const int ch = ((2 * ks + hh) ^ sw) * 8;
            const bf16x8 b0 = *(const bf16x8*)(cB + ch), b1 = *(const bf16x8*)(cB + 32 * 64 + ch);
#pragma unroll
            for (int mi = 0; mi < 4; ++mi) {
                const bf16x8 a = *(const bf16x8*)(cA + mi * 32 * 64 + ch);
                acc[mi][0] = MFMA32(a, b0, acc[mi][0]);
                acc[mi][1] = MFMA32(a, b1, acc[mi][1]);
            }
        }
        __builtin_amdgcn_s_setprio(0);
        __syncthreads();
    }
    epi(acc, row0 + wm * 128, col0 + wn * 64);
}

DI void transpose_store(bf16_t* dst, int K, int n0, int k0, const float* tile) {
    const int kp = TIDX() & 31, nn = TIDX() >> 5;
#pragma unroll
    for (int i = 0; i < 8; ++i) {
        const int n = nn + 8 * i;
        *(unsigned*)(dst + (size_t)(n0 + n) * K + k0 + 2 * kp) = pack2(tile[(2 * kp) * 65 + n], tile[(2 * kp + 1) * 65 + n]);
    }
}
template <class F>
DI void transpose_tile(bf16_t* dst, int K, int tn, int tk, F src, float* tile) {
    const int tx = TIDX() & 63, ty = TIDX() >> 6;
    const int n0 = tn * 64, k0 = tk * 64;
    float v[16];
#pragma unroll
    for (int i = 0; i < 16; ++i) v[i] = src(k0 + ty + 4 * i, n0 + tx);
#pragma unroll
    for (int i = 0; i < 16; ++i) tile[(ty + 4 * i) * 65 + tx] = v[i];
    __syncthreads();
    transpose_store(dst, K, n0, k0, tile);
    __syncthreads();
}
DI void poolfold_tile(bf16_t* dst, int tn, int tk, const float* wi, const float* pw, const float* ps, float* smemf) {
    float* wt = smemf;
    float* pt = smemf + 64 * 65;
    float* ot = pt + 64 * 64;
    const int tx = TIDX() & 63, ty = TIDX() >> 6;
    const int n0 = tn * 64, k0 = tk * 64, g = (n0 - IN_POOL) >> 6;
    const float sc = ps[g * 64 + tx];
#pragma unroll
    for (int i = 0; i < 16; ++i) {
        const int r = ty + 4 * i;
        wt[r * 65 + tx] = wi[(size_t)(k0 + r) * DIN + IN_POOL + g * 64 + tx];
        pt[r * 64 + tx] = pw[g * 4096 + r * 64 + tx] * sc;
    }
    __syncthreads();
    float acc[16];
#pragma unroll
    for (int i = 0; i < 16; ++i) acc[i] = 0.f;
    for (int ii = 0; ii < 64; ++ii) {
        const float pv = pt[ii * 64 + tx];
#pragma unroll
        for (int i = 0; i < 16; ++i) acc[i] += wt[(ty + 4 * i) * 65 + ii] * pv;
    }
#pragma unroll
    for (int i = 0; i < 16; ++i) ot[(ty + 4 * i) * 65 + tx] = acc[i];
    __syncthreads();
    transpose_store(dst, 1024, n0, k0, ot);
    __syncthreads();
}

PH_FN void prep_phase(const KP& p, char* smem) {
    float* tile = (float*)smem;
    bf16_t* W = (bf16_t*)(p.ws + OFF_W);
    const int NTR = 5024;
    const int n_items = 2 * NTR + 288 + 1 + 16;
    for (int it = blockIdx.x; it < n_items; it += gridDim.x) {
        if (it < 2 * NTR) {
            const int l = it / NTR; int r = it % NTR;
            bf16_t* Wl = W + (size_t)l * WL_EL;
            if (r < 2816) {
                const int f = r / 1408; r %= 1408;
                const float* g = p.in[8] + (size_t)(l * 2 + f) * D * FF;
                const float* u = p.in[9] + (size_t)(l * 2 + f) * D * FF;
                transpose_tile(Wl + (f ? WO_GU1 : WO_GU0), 1024, r / 16, r % 16, [&](int k, int n) {
                    const int j = n >> 7, w = n & 127, c = j * 64 + (w >> 6) * 32 + (w & 31);
                    return ((w >> 5) & 1) ? u[(size_t)k * FF + c] : g[(size_t)k * FF + c]; }, tile);
            } else if (r < 2816 + 1408) {
                r -= 2816; const int f = r / 704; r %= 704;
                const float* dn = p.in[10] + (size_t)(l * 2 + f) * FF * D;
                transpose_tile(Wl + (f ? WO_D1 : WO_D0), 2816, r / 44, r % 44, [&](int k, int n) { return dn[(size_t)k * D + n]; }, tile);
            } else if (r < 4224 + 384) {
                r -= 4224;
                const float* wi = p.in[11] + (size_t)l * D * DIN;
                const float* pw = p.in[27] + (size_t)l * 4 * 64 * 64;
                const float* ps = p.in[28] + (size_t)l * 256;
                const int tn = r / 16, tk = r % 16;
                if (tn >= IN_POOL / 64 && tn < IN_CQ / 64) poolfold_tile(Wl + WO_IN, tn, tk, wi, pw, ps, tile);
                else transpose_tile(Wl + WO_IN, 1024, tn, tk, [&](int k, int n) { return n < DIN ? wi[(size_t)k * DIN + n] : 0.f; }, tile);
            } else if (r < 4608 + 320) {
                r -= 4608;
                const float* wo = p.in[12] + (size_t)l * DMIX * D;
                transpose_tile(Wl + WO_OUT, 1280, r / 20, r % 20, [&](int k, int n) { return wo[(size_t)k * D + n]; }, tile);
            } else if (r < 4928 + 48) {
                r -= 4928;
                const float* wq = p.in[30] + (size_t)l * 256 * 768;
                const float* gn = p.in[29] + (size_t)l * 256;
                transpose_tile(Wl + WO_UQ, 256, r / 4, r % 4, [&](int k, int n) { return wq[(size_t)k * 768 + n] * gn[k] * QSCALE; }, tile);
            } else if (r < 4976 + 32) {
                r -= 4976;
                const float* wk = p.in[32] + (size_t)l * 128 * 1024;
                const float* gn = p.in[31] + (size_t)l * 128;
                transpose_tile(Wl + WO_UKV, 128, r / 2, r % 2, [&](int k, int n) { return wk[(size_t)k * 1024 + n] * gn[k]; }, tile);
            } else {
                r -= 5008;
                const float* wg = p.in[21] + (size_t)l * 256 * 256;
                transpose_tile(Wl + WO_GLU, 256, r / 4, r % 4, [&](int k, int n) { return wg[(size_t)k * 256 + n]; }, tile);
            }
        } else if (it < 2 * NTR + 288) {
            const int r = it - 2 * NTR, l = r / 144, n0 = (r % 144) * 64;
            float* sc = (float*)smem;
            float* red = sc + 3072;
            for (int i = TIDX(); i < 3072; i += 256) {
                const int v = i >> 10, k = i & 1023;
                const float cv = v < 2 ? p.in[1][v * 1024 + k] : p.in[3][k];
                sc[i] = cv / (1.f + expf(-cv));
            }
            __syncthreads();
            const int tx = TIDX() & 63, ty = TIDX() >> 6;
            const float* wa = p.in[4] + (size_t)l * D * 9216 + n0 + tx;
            float a0 = 0.f, a1 = 0.f, a2 = 0.f;
#pragma unroll 32
            for (int k = ty * 256; k < ty * 256 + 256; ++k) {
                const float w = wa[(size_t)k * 9216];
                a0 += sc[k] * w; a1 += sc[1024 + k] * w; a2 += sc[2048 + k] * w;
            }
            red[(ty * 3 + 0) * 64 + tx] = a0; red[(ty * 3 + 1) * 64 + tx] = a1; red[(ty * 3 + 2) * 64 + tx] = a2;
            __syncthreads();
            if (TIDX() < 192) {
                const int v = TIDX() >> 6;
                float s = p.in[5][l * 9216 + n0 + tx];
                for (int q = 0; q < 4; ++q) s += red[(q * 3 + v) * 64 + tx];
                ((float*)(p.ws + OFF_MOD))[(size_t)(l * 3 + v) * 9216 + n0 + tx] = s;
            }
            __syncthreads();
        } else if (it == 2 * NTR + 288) {
            float* tab = (float*)(p.ws + OFF_ROPE);
            const int pos = TIDX();
            for (int i = 0; i < 8; ++i) {
                const float inv = powf(10000.f, -(float)(2 * i) / 16.f);
                const float ang = (float)pos * inv;
                tab[(pos * 8 + i) * 2 + 0] = cosf(ang);
                tab[(pos * 8 + i) * 2 + 1] = sinf(ang);
            }
        } else {
            const int idx = (it - (2 * NTR + 289)) * 256 + TIDX();
            const int pp = idx & 63, g = (idx >> 6) & 15, ld = idx >> 10;
            float lr = fminf(p.in[13][idx], -1e-4f), li = p.in[14][idx];
            const float dt = expf(p.in[15][ld * 16 + g]);
            const float mag = expf(lr * dt);
            const float br = mag * cosf(li * dt), bi = mag * sinf(li * dt);
            float tr = br, ti = bi;
            for (int q = 0; q < 6; ++q) { const float nr = tr * tr - ti * ti, ni = 2.f * tr * ti; tr = nr; ti = ni; }
            ((float4*)(p.ws + OFF_LAMB))[idx] = make_float4(br, bi, tr, ti);
            const float nr = br - 1.f, ni = bi, den = 1.f / (lr * lr + li * li);
            const float cr = (nr * lr + ni * li) * den, ci = (ni * lr - nr * li) * den;
            float* bb = (float*)(p.ws + OFF_BBAR) + (size_t)idx * 32;
            const float* sbr = p.in[16] + (size_t)idx * 16; const float* sbi = p.in[17] + (size_t)idx * 16;
            for (int h = 0; h < 16; ++h) { const float xr = sbr[h], xi = sbi[h]; bb[2 * h] = cr * xr - ci * xi; bb[2 * h + 1] = cr * xi + ci * xr; }
            bf16_t* cc = (bf16_t*)(p.ws + OFF_CC) + (size_t)(ld * 16 + g) * 2048;
            const float* scr = p.in[18] + (size_t)(ld * 16 + g) * 1024; const float* sci = p.in[19] + (size_t)(ld * 16 + g) * 1024;
            for (int h = 0; h < 16; ++h) { cc[h * 128 + pp] = f2bf(scr[h * 64 + pp]); cc[h * 128 + 64 + pp] = f2bf(-sci[h * 64 + pp]); }
        }
    }
}

PH_FN void rowop_phase(const KP& p, int l_mod_post, int gate_idx, float coef, const float* gpost, bool has_y,
                    int l_mod_pre, int shift_idx, const float* gpre, bool has_pre, bool first, int nrows = NT) {
    const int lane = TIDX() & 63;
    const int wid = blockIdx.x * 4 + (TIDX() >> 6), nw = gridDim.x * 4;
    bf16_t* HY = (bf16_t*)(p.ws + OFF_HY);
    float* Xc = (float*)(p.ws + OFF_XC);
    const float* MOD = (const float*)(p.ws + OFF_MOD);
    for (int row = wid; row < nrows; row += nw) {
        const int mv = row_mod(row);
        float* xp = row < NL ? p.out + (size_t)row * D : Xc + (size_t)(row - NL) * D;
        const float* xin = first ? (row < NL ? p.in[0] + (size_t)row * D : p.in[2] + (size_t)(row - NL) * D) : xp;
        float4 x[4];
#pragma unroll
        for (int i = 0; i < 4; ++i) x[i] = *(const float4*)(xin + lane * 4 + 256 * i);
        if (has_y) {
            float4 y[4]; float ss = 0.f;
#pragma unroll
            for (int i = 0; i < 4; ++i) {
                const uint2 raw = *(const uint2*)(HY + (size_t)row * D + lane * 4 + 256 * i);
                y[i].x = __uint_as_float(raw.x << 16); y[i].y = __uint_as_float(raw.x & 0xffff0000u);
                y[i].z = __uint_as_float(raw.y << 16); y[i].w = __uint_as_float(raw.y & 0xffff0000u);
                ss += y[i].x * y[i].x + y[i].y * y[i].y + y[i].z * y[i].z + y[i].w * y[i].w;
            }
            ss = wave_sum(ss);
            const float rstd = rsqrtf(ss * (1.f / D) + EPS);
            const float* gt = MOD + (size_t)(l_mod_post * 3 + mv) * 9216 + gate_idx * 1024;
#pragma unroll
            for (int i = 0; i < 4; ++i) {
                const float4 g = *(const float4*)(gt + lane * 4 + 256 * i);
                const float4 w = *(const float4*)(gpost + lane * 4 + 256 * i);
                x[i].x += coef * g.x * (y[i].x * rstd * w.x); x[i].y += coef * g.y * (y[i].y * rstd * w.y);
                x[i].z += coef * g.z * (y[i].z * rstd * w.z); x[i].w += coef * g.w * (y[i].w * rstd * w.w);
            }
        }
        if (has_y) {
#pragma unroll
            for (int i = 0; i < 4; ++i) *(float4*)(xp + lane * 4 + 256 * i) = x[i];
        }
        if (has_pre) {
            float ss = 0.f;
#pragma unroll
            for (int i = 0; i < 4; ++i) ss += x[i].x * x[i].x + x[i].y * x[i].y + x[i].z * x[i].z + x[i].w * x[i].w;
            ss = wave_sum(ss);
            const float rstd = rsqrtf(ss * (1.f / D) + EPS);
            const float* sh = MOD + (size_t)(l_mod_pre * 3 + mv) * 9216 + shift_idx * 1024;
#pragma unroll
            for (int i = 0; i < 4; ++i) {
                const float4 s0 = *(const float4*)(sh + lane * 4 + 256 * i);
                const float4 s1 = *(const float4*)(sh + 1024 + lane * 4 + 256 * i);
                const float4 w = *(const float4*)(gpre + lane * 4 + 256 * i);
                const float h0 = x[i].x * rstd * w.x * (1.f + s1.x) + s0.x, h1 = x[i].y * rstd * w.y * (1.f + s1.y) + s0.y;
                const float h2 = x[i].z * rstd * w.z * (1.f + s1.z) + s0.z, h3 = x[i].w * rstd * w.w * (1.f + s1.w) + s0.w;
                uint2 o; o.x = pack2(h0, h1); o.y = pack2(h2, h3);
                *(uint2*)(HY + (size_t)row * D + lane * 4 + 256 * i) = o;
            }
        }
    }
}

template <int MODE = 0>
PH_FN void gemm1_phase(const KP& p, int l, int f, char* smem, int ntm = NT / 256) {
    const bf16_t* H = (const bf16_t*)(p.ws + OFF_HY);
    const bf16_t* W = (const bf16_t*)(p.ws + OFF_W) + (size_t)l * WL_EL + (f ? WO_GU1 : WO_GU0);
    bf16_t* ACT = (bf16_t*)(p.ws + OFF_ACT);
    const int lane = TIDX() & 63, l31 = lane & 31, hh = lane >> 5;
    const int n_items = (NL / 256) * 44;
    const int n_ctx = ntm > NL / 256 ? (NC / 128) * 44 : 0;
    for (int it = vblock(); it < n_ctx; it += gridDim.x) {
        const int mt = it / 44, nt = it - mt * 44;
        gemm_tile(H, D, W, D, D, NL + mt * 128, nt * 128, smem, [&](f32x16 (&acc)[2][2], int r0, int c0) {
            const int col = (c0 >> 7) * 64 + ((c0 >> 6) & 1) * 32 + l31;
#pragma unroll
            for (int mi = 0; mi < 2; ++mi)
#pragma unroll
                for (int i = 0; i < 16; ++i) ACT[(size_t)(r0 + 32 * mi + crow(i, hh)) * FF + col] = f2bf(siluf_(acc[mi][0][i]) * acc[mi][1][i]);
        });
    }
    for (int it = vblock(); it < n_items; it += gridDim.x) {
        int mt, nt; tile_mn(it, NL / 256, 44, mt, nt);
        gemm_tile256(H, D, W, D, D, mt * 256, nt * 128, smem, [&](f32x16 (&acc)[4][2], int r0, int c0) {
            const int col = (c0 >> 7) * 64 + ((c0 >> 6) & 1) * 32 + l31;
#pragma unroll
            for (int mi = 0; mi < 4; ++mi)
#pragma unroll
                for (int i = 0; i < 16; ++i) {
                    const int row = r0 + 32 * mi + crow(i, hh);
                    ACT[(size_t)row * FF + col] = f2bf(siluf_(acc[mi][0][i]) * acc[mi][1][i]);
                }
        });
    }
}

template <int MODE = 0>
PH_FN void gemm_store_phase(const bf16_t* A, int lda, const bf16_t* W, int K, int ntn, bf16_t* C, int ldc, int ncols, char* smem, int ntm = NT / 128) {
    const int lane = TIDX() & 63, l31 = lane & 31, hh = lane >> 5;
    const int n_items = ntm * ntn;
    for (int it = vblock(); it < n_items; it += gridDim.x) {
        int mt, nt; tile_mn(it, ntm, ntn, mt, nt);
        gemm_tile<MODE>(A, lda, W, K, K, mt * 128, nt * 128, smem, [&](f32x16 (&acc)[2][2], int r0, int c0) {
            if (MODE != 0 && acc[0][0][0] != 123456.789f) return;
#pragma unroll
            for (int ni = 0; ni < 2; ++ni) {
                const int col = c0 + 32 * ni + l31;
                if (col < ncols) {
#pragma unroll
                    for (int mi = 0; mi < 2; ++mi)
#pragma unroll
                        for (int i = 0; i < 16; ++i) C[(size_t)(r0 + 32 * mi + crow(i, hh)) * ldc + col] = f2bf(acc[mi][ni][i]);
                }
            }
        });
    }
}

template <int LDC>
PH_FN void gemm_store_phase256(const bf16_t* A, int lda, const bf16_t* W, int K, int ntn, bf16_t* C, char* smem, int ntm, int nctx128) {
    const int lane = TIDX() & 63, l31 = lane & 31, hh = lane >> 5;
    const int n_items = ntm * ntn;
    for (int it = vblock(); it < nctx128 * ntn; it += gridDim.x) {
        const int mt = it / ntn, nt = it - mt * ntn;
        gemm_tile(A, lda, W, K, K, NL + mt * 128, nt * 128, smem, [&](f32x16 (&acc)[2][2], int r0, int c0) {
#pragma unroll
            for (int mi = 0; mi < 2; ++mi) {
                bf16_t* cp = C + (size_t)(r0 + 32 * mi + 4 * hh) * LDC + c0 + l31;
#pragma unroll
                for (int ni = 0; ni < 2; ++ni)
#pragma unroll
                    for (int i = 0; i < 16; ++i) if (LDC == D || c0 + l31 + 32 * ni < LDC) cp[((i & 3) + 8 * (i >> 2)) * LDC + 32 * ni] = f2bf(acc[mi][ni][i]);
            }
        });
    }
    for (int it = vblock(); it < n_items; it += gridDim.x) {
        int mt, nt; tile_mn(it, ntm, ntn, mt, nt);
        gemm_tile256(A, lda, W, K, K, mt * 256, nt * 128, smem, [&](f32x16 (&acc)[4][2], int r0, int c0) {
#pragma unroll
            for (int mi = 0; mi < 4; ++mi) {
                bf16_t* cp = C + (size_t)(r0 + 32 * mi + 4 * hh) * LDC + c0 + l31;
#pragma unroll
                for (int ni = 0; ni < 2; ++ni)
#pragma unroll
                    for (int i = 0; i < 16; ++i) if (LDC == D || c0 + l31 + 32 * ni < LDC) cp[((i & 3) + 8 * (i >> 2)) * LDC + 32 * ni] = f2bf(acc[mi][ni][i]);
                __builtin_amdgcn_sched_barrier(0);
            }
        });
    }
}

PH_FN void glu_phase(const KP& p, int l, char* smem) {
    const bf16_t* S5P = (const bf16_t*)(p.ws + OFF_S5P);
    const bf16_t* W = (const bf16_t*)(p.ws + OFF_W) + (size_t)l * WL_EL + WO_GLU;
    bf16_t* MIX = (bf16_t*)(p.ws + OFF_MIX);
    const float* bg = p.in[22] + l * 256;
    const int lane = TIDX() & 63, l31 = lane & 31, hh = lane >> 5;
    const int n_items = (NT / 128) * 2;
    for (int it = vblock(); it < n_items; it += gridDim.x) {
        const int mt = it >> 1, nt = it & 1;
        gemm_tile(S5P, 256, W, 256, 256, mt * 128, nt * 128, smem, [&](f32x16 (&acc)[2][2], int r0, int c0) {
#pragma unroll
            for (int ni = 0; ni < 2; ++ni) {
                const int col = c0 + 32 * ni + l31;
                const float b = bg[col];
#pragma unroll
                for (int mi = 0; mi < 2; ++mi)
#pragma unroll
                    for (int i = 0; i < 16; ++i) {
                        const int row = r0 + 32 * mi + crow(i, hh);
                        const float y = bf2f(S5P[(size_t)row * 256 + col]);
                        MIX[(size_t)row * DMIX + col] = f2bf(y * sigmoidf_(acc[mi][ni][i] + b));
                        if ((i & 3) == 3) __builtin_amdgcn_sched_barrier(0);
                    }
            }
        });
    }
}

DI void key_pos(int row, int& b, int& pos) {
    if (row < NL) { b = row >= SEQ ? 1 : 0; pos = row - b * SEQ; }
    else { const int r = row - NL; b = r >> 8; pos = SEQ + (r & 255); }
}

DI void qkv_item(const KP& p, int l, int it, char* smem) {
    const bf16_t* Z = (const bf16_t*)(p.ws + OFF_Z);
    const bf16_t* Wl = (const bf16_t*)(p.ws + OFF_W) + (size_t)l * WL_EL;
    bf16_t* Q = (bf16_t*)(p.ws + OFF_Q);
    bf16_t* Kb = (bf16_t*)(p.ws + OFF_K);
    bf16_t* Vt = (bf16_t*)(p.ws + OFF_VT);
    const float* tab = (const float*)(p.ws + OFF_ROPE);
    const int mt = it / 14, sub = it % 14, row0 = mt * 128;
    const int tid = TIDX(), lane = tid & 63, l31 = lane & 31, hh = lane >> 5;
    __shared__ float s_rs[128];
    {
        const int r = tid >> 1, half = tid & 1;
        const bool isq = sub < 6;
        const int n = isq ? 128 : 64;
        const bf16_t* src = Z + (size_t)(row0 + r) * DIN + (isq ? IN_CQ : IN_CKV) + half * n;
        float ss = 0.f;
        for (int i = 0; i < n; i += 8) {
            const uint4 v = *(const uint4*)(src + i);
            const unsigned w[4] = {v.x, v.y, v.z, v.w};
#pragma unroll
            for (int q = 0; q < 4; ++q) { const float a = __uint_as_float(w[q] << 16), b = __uint_as_float(w[q] & 0xffff0000u); ss += a * a + b * b; }
        }
        ss += shflx(ss, 1);
        if (half == 0) s_rs[r] = rsqrtf(ss / (float)(2 * n) + EPS);
    }
    __syncthreads();
    if (sub < 6) {
        gemm_tile(Z + IN_CQ, DIN, Wl + WO_UQ, 256, 256, row0, sub * 128, smem, [&](f32x16 (&acc)[2][2], int r0, int c0) {
#pragma unroll
            for (int ni = 0; ni < 2; ++ni) {
                const int cb = c0 + 32 * ni, col = cb + l31;
                const bool is_rope = ((cb >> 5) % 3) == 2;
                const int axis = l31 >> 4, second = (l31 >> 3) & 1, fi = l31 & 7;
#pragma unroll
                for (int mi = 0; mi < 2; ++mi)
#pragma unroll
                    for (int i = 0; i < 16; ++i) {
                        const int row = r0 + 32 * mi + crow(i, hh);
                        float v = acc[mi][ni][i] * s_rs[row - row0];
                        if (is_rope) {
                            const float pr = shflx(v, 8);
                            if (row < NL) {
                                const int t = row & (SEQ - 1);
                                const int pos = axis ? (t & 63) : (t >> 6);
                                const float cs = tab[(pos * 8 + fi) * 2], sn = tab[(pos * 8 + fi) * 2 + 1];
                                v = second ? (v * cs + pr * sn) : (v * cs - pr * sn);
                            }
                        }
                        Q[(size_t)row * 768 + col] = f2bf(v);
                        if ((i & 3) == 3) __builtin_amdgcn_sched_barrier(0);
                    }
            }
        });
    } else {
        const int head = sub - 6;
        gemm_tile(Z + IN_CKV, DIN, Wl + WO_UKV, 128, 128, row0, head * 128, smem, [&](f32x16 (&acc)[2][2], int r0, int c0) {
            const bool isv = (c0 >> 6) & 1;
#pragma unroll
            for (int ni = 0; ni < 2; ++ni) {
                const int dcol = 32 * ni + l31;
#pragma unroll
                for (int mi = 0; mi < 2; ++mi)
#pragma unroll
                    for (int q = 0; q < 4; ++q) {
                        const int rowb = r0 + 32 * mi + 8 * q + 4 * hh;
                        int b, pos; key_pos(rowb, b, pos);
                        float v[4];
#pragma unroll
                        for (int j = 0; j < 4; ++j) v[j] = acc[mi][ni][4 * q + j] * s_rs[rowb + j - row0];
                        if (isv) {
                            uint2 o; o.x = pack2(v[0], v[1]); o.y = pack2(v[2], v[3]);
                            *(uint2*)(Vt + ((size_t)(b * NH + head) * 64 + dcol) * LK + ((pos & ~12) | ((pos & 4) << 1) | ((pos & 8) >> 1))) = o;
                        } else {
#pragma unroll
                            for (int j = 0; j < 4; ++j) Kb[((size_t)(b * NH + head) * LK + pos + j) * DK + dcol] = f2bf(v[j]);
                        }
                    }
            }
        });
        for (int e = tid; e < 128 * 32; e += 256) {
            const int r = e >> 5, d = e & 31, row = row0 + r;
            const bf16_t* kr = Z + (size_t)row * DIN + IN_KR;
            float v = bf2f(kr[d]);
            if (row < NL) {
                const float pr = bf2f(kr[d ^ 8]);
                const int t = row & (SEQ - 1), axis = d >> 4, second = (d >> 3) & 1, fi = d & 7;
                const int pos = axis ? (t & 63) : (t >> 6);
                const float cs = tab[(pos * 8 + fi) * 2], sn = tab[(pos * 8 + fi) * 2 + 1];
                v = second ? (v * cs + pr * sn) : (v * cs - pr * sn);
            }
            int b, pos; key_pos(row, b, pos);
            Kb[((size_t)(b * NH + head) * LK + pos) * DK + 64 + d] = f2bf(v);
        }
    }
    __syncthreads();
}

DI void convpool_item(const KP& p, int l, int it, char* smem) {
    const bf16_t* Z = (const bf16_t*)(p.ws + OFF_Z);
    bf16_t* MIX = (bf16_t*)(p.ws + OFF_MIX);
    float* hs = (float*)smem;
    int L, rowbase, t0;
    if (it < 1024) { L = SEQ; rowbase = (it >> 9) * SEQ; t0 = (it & 511) * 32; }
    else { const int r = it - 1024; L = CTXL; rowbase = NL + (r >> 3) * CTXL; t0 = (r & 7) * 32; }
    const int c = TIDX(), lane = c & 63, wave = c >> 6;
    {
        const int c4 = (c & 63) * 4, ts = c >> 6;
#pragma unroll 4
        for (int j = ts; j < 62; j += 4) {
            const int t = t0 - 15 + j;
            float4 h = make_float4(0.f, 0.f, 0.f, 0.f);
            if (t >= 0 && t < L) {
                const bf16_t* zr = Z + (size_t)(rowbase + t) * DIN + IN_CONV + c4;
                const uint2 v = *(const uint2*)zr, g = *(const uint2*)(zr + 256);
                h.x = __uint_as_float(v.x << 16) * sigmoidf_(__uint_as_float(g.x << 16));
                h.y = __uint_as_float(v.x & 0xffff0000u) * sigmoidf_(__uint_as_float(g.x & 0xffff0000u));
                h.z = __uint_as_float(v.y << 16) * sigmoidf_(__uint_as_float(g.y << 16));
                h.w = __uint_as_float(v.y & 0xffff0000u) * sigmoidf_(__uint_as_float(g.y & 0xffff0000u));
            }
            *(float4*)(hs + j * 256 + c4) = h;
        }
    }
    __syncthreads();
    float w[31];
#pragma unroll
    for (int k = 0; k < 31; ++k) w[k] = p.in[23][(size_t)(l * 31 + k) * 256 + c];
    const float cb = p.in[24][l * 256 + c];
#pragma unroll 1
    for (int tt = 0; tt < 32; ++tt) {
        float s = cb;
#pragma unroll
        for (int k = 0; k < 31; ++k) s += w[k] * hs[(tt + k) * 256 + c];
        hs[tt * 256 + c] = s;
    }
    __syncthreads();
    {
        const float4 lg = *(const float4*)(p.in[25] + l * 256 + lane * 4);
        const float4 lb = *(const float4*)(p.in[26] + l * 256 + lane * 4);
#pragma unroll 1
        for (int q = 0; q < 8; ++q) {
            const int tt = wave * 8 + q;
            const float4 v = *(const float4*)(hs + tt * 256 + lane * 4);
            const float mean = wave_sum(v.x + v.y + v.z + v.w) * (1.f / 256.f);
            const float d0 = v.x - mean, d1 = v.y - mean, d2 = v.z - mean, d3 = v.w - mean;
            const float var = wave_sum(d0 * d0 + d1 * d1 + d2 * d2 + d3 * d3) * (1.f / 256.f);
            const float rstd = rsqrtf(var + EPS);
            uint2 o;
            o.x = pack2(siluf_(d0 * rstd * lg.x + lb.x), siluf_(d1 * rstd * lg.y + lb.y));
            o.y = pack2(siluf_(d2 * rstd * lg.z + lb.z), siluf_(d3 * rstd * lg.w + lb.w));
            *(uint2*)(MIX + (size_t)(rowbase + t0 + tt) * DMIX + 256 + lane * 4) = o;
        }
    }
    __syncthreads();
    {
        const int c4 = (c & 63) * 4, ts = c >> 6;
#pragma unroll 4
        for (int j = ts; j < 47; j += 4) {
            const int t = t0 - 7 + j;
            float4 h = make_float4(0.f, 0.f, 0.f, 0.f);
            if (t >= 0 && t < L) {
                const uint2 v = *(const uint2*)(Z + (size_t)(rowbase + t) * DIN + IN_POOL + c4);
                h.x = __uint_as_float(v.x << 16); h.y = __uint_as_float(v.x & 0xffff0000u); h.z = __uint_as_float(v.y << 16); h.w = __uint_as_float(v.y & 0xffff0000u);
            }
            *(float4*)(hs + j * 256 + c4) = h;
        }
    }
    __syncthreads();
    {
        const int win = 2 << (c >> 6), wa = (win - 1) >> 1, wb = win >> 1;
#pragma unroll 1
        for (int tt = 0; tt < 32; ++tt) {
            const int t = t0 + tt;
            const int lo = max(t - wa, 0), hi = min(t + wb, L - 1);
            float s = 0.f;
            for (int q = lo; q <= hi; ++q) s += hs[(q - t0 + 7) * 256 + c];
            const float o = s / (float)(hi - lo + 1) - hs[(tt + 7) * 256 + c];
            MIX[(size_t)(rowbase + t) * DMIX + 512 + c] = f2bf(o);
        }
    }
    __syncthreads();
}

DI int chunk_row(int b, int k) { return k < 4 ? NL + b * CTXL + 64 * k : b * SEQ + 64 * (k - 4); }

template <bool FINAL>
DI void s5_item(const KP& p, int l, int it, char* smem) {
    const int g4 = it & 3, k = (it >> 2) % NCHUNK, b = (it >> 2) / NCHUNK;
    const int tid = TIDX(), lane = tid & 63, wave = tid >> 6, g = g4 * 4 + wave;
    const bf16_t* Z = (const bf16_t*)(p.ws + OFF_Z);
    float* Us = (float*)smem + wave * 1024;
    bf16_t* Hs = (bf16_t*)(smem + 16384) + wave * (16 * 136);
    const int rbase = chunk_row(b, k);
    {
        const uint4* src = (const uint4*)(Z + (size_t)(rbase + lane) * DIN + g * 16);
        const uint4 v0 = src[0], v1 = src[1];
        const unsigned w[8] = {v0.x, v0.y, v0.z, v0.w, v1.x, v1.y, v1.z, v1.w};
#pragma unroll
        for (int q = 0; q < 8; ++q) { Us[lane * 16 + 2 * q] = __uint_as_float(w[q] << 16); Us[lane * 16 + 2 * q + 1] = __uint_as_float(w[q] & 0xffff0000u); }
    }
    __syncthreads();
    f32x4 yacc[4];
#pragma unroll
    for (int s = 0; s < 4; ++s) yacc[s] = f32x4{0.f, 0.f, 0.f, 0.f};
#pragma unroll
    for (int dir = 0; dir < 2; ++dir) {
        const int pidx = ((l * 2 + dir) * 16 + g) * 64 + lane;
        const float4 lam = ((const float4*)(p.ws + OFF_LAMB))[pidx];
        float br[16], bi[16];
        {
            const float4* bb = (const float4*)((const float*)(p.ws + OFF_BBAR) + (size_t)pidx * 32);
#pragma unroll
            for (int q = 0; q < 8; ++q) { const float4 v = bb[q]; br[2 * q] = v.x; bi[2 * q] = v.y; br[2 * q + 1] = v.z; bi[2 * q + 1] = v.w; }
        }
        const size_t sidx = ((size_t)((b * 2 + dir) * NCHUNK + k) * 16 + g) * 64 + lane;
        float hr = 0.f, hi = 0.f;
        bf16x8 cfr[4];
        if (FINAL) {
            const float2 s0 = ((const float2*)(p.ws + OFF_S))[sidx];
            hr = s0.x; hi = s0.y;
            const bf16_t* cc = (const bf16_t*)(p.ws + OFF_CC) + (size_t)((l * 2 + dir) * 16 + g) * 2048 + (lane & 15) * 128 + (lane >> 4) * 8;
#pragma unroll
            for (int ks = 0; ks < 4; ++ks) cfr[ks] = *(const bf16x8*)(cc + 32 * ks);
        }
#pragma unroll
        for (int s = 0; s < 4; ++s) {
            const int sb = dir ? 3 - s : s;
#pragma unroll 1
            for (int tt = 0; tt < 16; ++tt) {
                const int tl = dir ? 15 - tt : tt, t = sb * 16 + tl;
                const float4* up = (const float4*)(Us + t * 16);
                float ar = 0.f, ai = 0.f;
#pragma unroll
                for (int q = 0; q < 4; ++q) {
                    const float4 u = up[q];
                    ar += br[4 * q] * u.x + br[4 * q + 1] * u.y + br[4 * q + 2] * u.z + br[4 * q + 3] * u.w;
                    ai += bi[4 * q] * u.x + bi[4 * q + 1] * u.y + bi[4 * q + 2] * u.z + bi[4 * q + 3] * u.w;
                }
                const float nr = lam.x * hr - lam.y * hi + ar, ni = lam.x * hi + lam.y * hr + ai;
                hr = nr; hi = ni;
                if (FINAL) { Hs[tl * 136 + lane] = f2bf(hr); Hs[tl * 136 + 64 + lane] = f2bf(hi); }
            }
            if (FINAL) {
                __syncthreads();
                const bf16_t* hp = Hs + (lane & 15) * 136 + (lane >> 4) * 8;
#pragma unroll
                for (int ks = 0; ks < 4; ++ks) { const bf16x8 a = *(const bf16x8*)(hp + 32 * ks); yacc[sb] = MFMA16(a, cfr[ks], yacc[sb]); }
                __syncthreads();
            }
        }
        if (!FINAL) ((float2*)(p.ws + OFF_E))[sidx] = make_float2(hr, hi);
    }
    if (FINAL) {
        bf16_t* S5P = (bf16_t*)(p.ws + OFF_S5P);
        const int hcol = lane & 15;
        const float dg = p.in[20][l * 256 + g * 16 + hcol];
#pragma unroll
        for (int s = 0; s < 4; ++s)
#pragma unroll
            for (int j = 0; j < 4; ++j) {
                const int t = s * 16 + (lane >> 4) * 4 + j;
                const float y = yacc[s][j] + dg * Us[t * 16 + hcol];
                S5P[(size_t)(rbase + t) * 256 + g * 16 + hcol] = f2bf(gelu_tanh(y));
            }
    }
    __syncthreads();
}

DI void s5_carry(const KP& p, int l, int blk) {
    const int idx = blk * 256 + TIDX();
    const int gp = idx & 1023, dir = (idx >> 10) & 1, b = idx >> 11;
    const float4 lam = ((const float4*)(p.ws + OFF_LAMB))[(l * 2 + dir) * 1024 + gp];
    const float2* E = (const float2*)(p.ws + OFF_E) + (size_t)(b * 2 + dir) * NCHUNK * 1024 + gp;
    float2* S = (float2*)(p.ws + OFF_S) + (size_t)(b * 2 + dir) * NCHUNK * 1024 + gp;
    float sr = 0.f, si = 0.f;
    for (int j0 = 0; j0 < NCHUNK; j0 += 4) {
        const int k0 = dir ? (j0 < 4 ? 3 - j0 : 263 - j0) : j0, stp = dir ? -1 : 1;
        const float2 e0 = E[(size_t)k0 * 1024], e1 = E[(size_t)(k0 + stp) * 1024], e2 = E[(size_t)(k0 + 2 * stp) * 1024], e3 = E[(size_t)(k0 + 3 * stp) * 1024];
        float nr, ni;
        S[(size_t)k0 * 1024] = make_float2(sr, si);
        nr = lam.z * sr - lam.w * si + e0.x; ni = lam.z * si + lam.w * sr + e0.y; sr = nr; si = ni;
        S[(size_t)(k0 + stp) * 1024] = make_float2(sr, si);
        nr = lam.z * sr - lam.w * si + e1.x; ni = lam.z * si + lam.w * sr + e1.y; sr = nr; si = ni;
        S[(size_t)(k0 + 2 * stp) * 1024] = make_float2(sr, si);
        nr = lam.z * sr - lam.w * si + e2.x; ni = lam.z * si + lam.w * sr + e2.y; sr = nr; si = ni;
        S[(size_t)(k0 + 3 * stp) * 1024] = make_float2(sr, si);
        nr = lam.z * sr - lam.w * si + e3.x; ni = lam.z * si + lam.w * sr + e3.y; sr = nr; si = ni;
    }
}

DI void attn_item(const KP& p, int it, char* smem) {
    const bf16_t* Q = (const bf16_t*)(p.ws + OFF_Q);
    const bf16_t* Kg = (const bf16_t*)(p.ws + OFF_K);
    const bf16_t* Vg = (const bf16_t*)(p.ws + OFF_VT);
    bf16_t* MIX = (bf16_t*)(p.ws + OFF_MIX);
    const int tid = TIDX(), lane = tid & 63, wave = tid >> 6, l31 = lane & 31, hh = lane >> 5;
    int bh, qrow0, kt0, T;
    if (it < 1024) { bh = it >> 6; qrow0 = (bh >> 3) * SEQ + (it & 63) * 256; kt0 = 0; T = NCHUNK; }
    else { bh = it - 1024; qrow0 = NL + (bh >> 3) * CTXL; kt0 = SEQ / 64; T = CTXL / 64; }
    const int head = bh & 7;
    const bf16_t* Kb = Kg + (size_t)bh * LK * DK + (size_t)kt0 * 64 * DK;
    const bf16_t* Vb = Vg + (size_t)bh * 64 * LK + kt0 * 64;
    bf16_t* sK = (bf16_t*)smem;
    bf16_t* sV = sK + 2 * 64 * 104;
    const int qrow = qrow0 + wave * 64 + l31;
    bf16x8 qf[2][6];
#pragma unroll
    for (int qb = 0; qb < 2; ++qb)
#pragma unroll
        for (int s = 0; s < 6; ++s) qf[qb][s] = *(const bf16x8*)(Q + (size_t)(qrow + 32 * qb) * 768 + head * 96 + 16 * s + 8 * hh);
    f32x16 o[2][2];
#pragma unroll
    for (int i = 0; i < 16; ++i) { o[0][0][i] = 0.f; o[0][1][i] = 0.f; o[1][0][i] = 0.f; o[1][1][i] = 0.f; }
    float m_run[2] = {-1e30f, -1e30f}, l_run[2] = {0.f, 0.f};
    u32x4 rk0, rk1, rk2, rv0, rv1;
    const int vrow = tid >> 3, vcol = (tid & 7) * 8;
    const int kw0 = (tid / 12) * 104 + (tid % 12) * 8, kw1 = ((tid + 256) / 12) * 104 + ((tid + 256) % 12) * 8, kw2 = ((tid + 512) / 12) * 104 + ((tid + 512) % 12) * 8;
    const bf16_t* cK = sK + l31 * 104 + 8 * hh;
    const bf16_t* cV = sV + l31 * 72 + 8 * hh;
#define ATT_KWRITE(buf_) do { bf16_t* k_ = sK + (buf_) * 64 * 104; *(u32x4*)(k_ + kw0) = rk0; *(u32x4*)(k_ + kw1) = rk1; *(u32x4*)(k_ + kw2) = rk2; } while (0)
#define ATT_VWRITE(buf_) do { bf16_t* v_ = sV + (buf_) * 64 * 72 + vrow * 72 + vcol; *(u32x4*)(v_) = rv0; *(u32x4*)(v_ + 32 * 72) = rv1; } while (0)
    {
        const bf16_t* kp = Kb + tid * 8;
        rk0 = *(const u32x4*)(kp); rk1 = *(const u32x4*)(kp + 2048); rk2 = *(const u32x4*)(kp + 4096);
        const bf16_t* vp = Vb + (size_t)vrow * LK + vcol;
        rv0 = *(const u32x4*)(vp); rv1 = *(const u32x4*)(vp + (size_t)32 * LK);
        ATT_KWRITE(0); ATT_VWRITE(0);
    }
    __syncthreads();
    for (int t = 0; t < T; ++t) {
        const int buf = t & 1;
        const bool more = (t + 1) < T;
        if (more) {
            const bf16_t* kp_ = Kb + (size_t)(t + 1) * 64 * DK + tid * 8; gld16(rk0, kp_); gld16(rk1, kp_ + 2048); gld16(rk2, kp_ + 4096);
            const bf16_t* vp_ = Vb + (size_t)vrow * LK + (t + 1) * 64 + vcol; gld16(rv0, vp_); gld16(rv1, vp_ + (size_t)32 * LK);
        }
#pragma unroll
        for (int kb = 0; kb < 2; ++kb) {
            f32x16 s[2];
#pragma unroll
            for (int i = 0; i < 16; ++i) { s[0][i] = 0.f; s[1][i] = 0.f; }
            bf16x8 kf[6];
#pragma unroll
            for (int ks = 0; ks < 6; ++ks) kf[ks] = *(const bf16x8*)(cK + buf * 64 * 104 + kb * 32 * 104 + 16 * ks);
            __builtin_amdgcn_sched_barrier(0);
            __builtin_amdgcn_s_setprio(1);
#pragma unroll
            for (int ks = 0; ks < 6; ++ks) {
                s[0] = MFMA32(kf[ks], qf[0][ks], s[0]);
                s[1] = MFMA32(kf[ks], qf[1][ks], s[1]);
            }
            __builtin_amdgcn_s_setprio(0);
#pragma unroll
            for (int qb = 0; qb < 2; ++qb) {
                float mx = s[qb][0];
#pragma unroll
                for (int i = 1; i < 16; ++i) mx = fmaxf(mx, s[qb][i]);
                mx = xhalf_max(mx);
                const float m_new = fmaxf(m_run[qb], mx);
                if (__builtin_amdgcn_ballot_w64(m_new > m_run[qb]) != 0ull) {
                    const float alpha = __builtin_amdgcn_exp2f(m_run[qb] - m_new);
                    m_run[qb] = m_new; l_run[qb] *= alpha;
#pragma unroll
                    for (int i = 0; i < 16; ++i) { o[qb][0][i] *= alpha; o[qb][1][i] *= alpha; }
                }
                float ps = 0.f;
#pragma unroll
                for (int i = 0; i < 16; ++i) { s[qb][i] = __builtin_amdgcn_exp2f(s[qb][i] - m_run[qb]); ps += s[qb][i]; }
                l_run[qb] += ps;
            }
            bf16x8 vf[2][2];
#pragma unroll
            for (int u = 0; u < 2; ++u)
#pragma unroll
                for (int dvb = 0; dvb < 2; ++dvb) vf[u][dvb] = *(const bf16x8*)(cV + buf * 64 * 72 + dvb * 32 * 72 + 32 * kb + 16 * u);
            __builtin_amdgcn_sched_barrier(0);
#pragma unroll
            for (int u = 0; u < 2; ++u) {
                const bf16x8 p0 = __builtin_bit_cast(bf16x8, u32x4{pack2(s[0][8 * u], s[0][8 * u + 1]), pack2(s[0][8 * u + 2], s[0][8 * u + 3]), pack2(s[0][8 * u + 4], s[0][8 * u + 5]), pack2(s[0][8 * u + 6], s[0][8 * u + 7])});
                const bf16x8 p1 = __builtin_bit_cast(bf16x8, u32x4{pack2(s[1][8 * u], s[1][8 * u + 1]), pack2(s[1][8 * u + 2], s[1][8 * u + 3]), pack2(s[1][8 * u + 4], s[1][8 * u + 5]), pack2(s[1][8 * u + 6], s[1][8 * u + 7])});
                __builtin_amdgcn_s_setprio(1);
#pragma unroll
                for (int dvb = 0; dvb < 2; ++dvb) {
                    o[0][dvb] = MFMA32(vf[u][dvb], p0, o[0][dvb]);
                    o[1][dvb] = MFMA32(vf[u][dvb], p1, o[1][dvb]);
                }
                __builtin_amdgcn_s_setprio(0);
            }
        }
        if (more) { vm_wait5(rk0, rk1, rk2, rv0, rv1); ATT_KWRITE(buf ^ 1); ATT_VWRITE(buf ^ 1); }
        __syncthreads();
    }
#undef ATT_KWRITE
#undef ATT_VWRITE
#pragma unroll
    for (int qb = 0; qb < 2; ++qb) {
        const float lt = xhalf_sum(l_run[qb]);
        const float inv = 1.f / lt;
#pragma unroll
        for (int dvb = 0; dvb < 2; ++dvb)
#pragma unroll
            for (int q = 0; q < 4; ++q) {
                uint2 ov; ov.x = pack2(o[qb][dvb][4 * q] * inv, o[qb][dvb][4 * q + 1] * inv); ov.y = pack2(o[qb][dvb][4 * q + 2] * inv, o[qb][dvb][4 * q + 3] * inv);
                *(uint2*)(MIX + (size_t)(qrow + 32 * qb) * DMIX + 768 + head * 64 + 32 * dvb + 8 * q + 4 * hh) = ov;
            }
    }
}

PH_FN void misc_phase(const KP& p, int l, char* smem) {
    const int n_qkv = 260 * 14, n_cp = l == 1 ? 1024 : 1040, n_s5 = 2 * NCHUNK * 4;
    const int rot = (blockIdx.x + gridDim.x / 2) % gridDim.x;
    for (int it = vblock(); it < n_qkv; it += gridDim.x) qkv_item(p, l, it, smem);
    for (int it = rot; it < n_cp; it += gridDim.x) convpool_item(p, l, it, smem);
    for (int it = blockIdx.x; it < n_s5; it += gridDim.x) s5_item<false>(p, l, it, smem);
#if MISC_DUP == 1
    for (int it = vblock(); it < n_qkv; it += gridDim.x) qkv_item(p, l, it, smem);
#elif MISC_DUP == 2
    for (int it = rot; it < n_cp; it += gridDim.x) convpool_item(p, l, it, smem);
#elif MISC_DUP == 3
    for (int it = blockIdx.x; it < n_s5; it += gridDim.x) s5_item<false>(p, l, it, smem);
#endif
}
PH_FN void attn_phase(const KP& p, int l, char* smem) {
    const int n_att = l == 1 ? 1024 : 1024 + 16;
    if (blockIdx.x < 16) s5_carry(p, l, blockIdx.x);
    for (int it = vblock(); it < n_att; it += gridDim.x) attn_item(p, it, smem);
}
PH_FN void s5fin_phase(const KP& p, int l, char* smem) {
    for (int it = blockIdx.x; it < 2 * NCHUNK * 4; it += gridDim.x) s5_item<true>(p, l, it, smem);
}

DI void run_phase(const KP& p, int ph, char* smem) {
    if (ph == 0) { prep_phase(p, smem); return; }
    if (ph == 27) {
        rowop_phase(p, 1, 8, 0.5f, p.in[7] + (1 * 3 + 2) * D, true, 0, 0, nullptr, false, false, NL);
        return;
    }
    const int l = (ph - 1) / 13, s = (ph - 1) % 13;
    const bf16_t* Wl = (const bf16_t*)(p.ws + OFF_W) + (size_t)l * WL_EL;
    const float* npre = p.in[6] + (size_t)l * 3 * D;
    const float* npost = p.in[7] + (size_t)l * 3 * D;
    const bool lastl = l == 1;
    switch (s) {
    case 0:
        if (l == 0) rowop_phase(p, 0, 0, 0.f, nullptr, false, 0, 0, npre, true, true);
        else rowop_phase(p, l - 1, 8, 0.5f, p.in[7] + ((l - 1) * 3 + 2) * D, true, l, 0, npre, true, false);
        break;
    case 1: case 11: gemm1_phase(p, l, s == 11, smem, (lastl && s == 11) ? NL / 256 : NT / 256); break;
    case 2: case 9: case 12: {
        const bool isout = s == 9;
        const bf16_t* Ag = (const bf16_t*)(p.ws + (isout ? OFF_MIX : OFF_ACT));
        const bf16_t* Wg = Wl + (isout ? WO_OUT : (s == 12 ? WO_D1 : WO_D0));
        const int Kg = isout ? DMIX : FF;
        gemm_store_phase256<D>(Ag, Kg, Wg, Kg, 8, (bf16_t*)(p.ws + OFF_HY), smem, NL / 256, (lastl && s != 2) ? 0 : NC / 128);
    } break;
    case 3: rowop_phase(p, l, 2, 0.5f, npost, true, l, 3, npre + D, true, l == 0); break;
    case 4: gemm_store_phase256<DIN>((const bf16_t*)(p.ws + OFF_HY), D, Wl + WO_IN, D, 12, (bf16_t*)(p.ws + OFF_Z), smem, NL / 256, NC / 128); break;
    case 5: misc_phase(p, l, smem); break;
    case 6: attn_phase(p, l, smem); break;
    case 7: s5fin_phase(p, l, smem); break;
    case 8: glu_phase(p, l, smem); break;
    case 10: rowop_phase(p, l, 5, 1.0f, npost + D, true, l, 6, npre + 2 * D, true, false, lastl ? NL : NT); break;
    }
}

constexpr int N_PHASES = 28;

__global__ void __launch_bounds__(256, 2) mega_kernel(KP p, int ph_lo, int ph_hi) {
    __shared__ __attribute__((aligned(16))) char smem[65536];
    __shared__ KP s_kp;
    if (TIDX() < 33) s_kp.in[TIDX()] = p.in[TIDX()];
    if (TIDX() == 33) s_kp.out = p.out;
    if (TIDX() == 34) s_kp.ws = p.ws;
    __shared__ uint4 xb_words;
    if (TIDX() == 0) xb_words = make_uint4(0u, 0u, 0u, 0u);
    __syncthreads();
    XcdBarrier xb = xcd_barrier_post((unsigned*)(p.ws + OFF_BAR), (volatile LAS unsigned*)&xb_words);
    for (int ph = ph_lo; ph < ph_hi; ++ph) {
        run_phase(p, ph, smem);
        if (DUP_MASK) {
            const int sbit = ph == 0 ? 13 : (ph == 27 ? 14 : (ph - 1) % 13);
            if ((DUP_MASK >> sbit) & 1) { xcd_barrier(xb); run_phase(p, ph, smem); }
        }
#if PROBE_MODE
        {
            const int sb = ph == 0 || ph == 27 ? -1 : (ph - 1) % 13, pl = (ph - 1) / 13;
            const bf16_t* Wl = (const bf16_t*)(s_kp.ws + OFF_W) + (size_t)pl * WL_EL;
            if (sb == 1 || sb == 11) { cg::this_grid().sync(); gemm1_phase<PROBE_MODE>(s_kp, pl, sb == 11, smem); }
            if (sb == 2 || sb == 12) { cg::this_grid().sync(); gemm_store_phase<PROBE_MODE>((const bf16_t*)(s_kp.ws + OFF_ACT), FF, Wl + (sb == 12 ? WO_D1 : WO_D0), FF, 8, (bf16_t*)(s_kp.ws + OFF_HY), D, D, smem); }
        }
#endif
        if (EXTRA_SYNCS) { xcd_barrier(xb); xcd_barrier(xb); }
        if (ph + 1 < ph_hi) { if (ph_hi < 0) cg::this_grid().sync(); else xcd_barrier(xb); }
    }
}

extern "C" void kernel_launch(void* const* d_in, const int* in_sizes, int n_in, void* d_out, int out_size, void* d_ws, size_t ws_size, hipStream_t stream) {
    static int grid = 0;
    if (grid == 0) {
        if (n_in != 33 || ws_size < WS_END) { fprintf(stderr, "kernel_launch: unexpected n_in %d or ws_size %zu < %zu\n", n_in, ws_size, (size_t)WS_END); grid = -1; return; }
        int dev = 0, cus = 0, per_cu = 0;
        hipGetDevice(&dev);
        hipDeviceGetAttribute(&cus, hipDeviceAttributeMultiprocessorCount, dev);
        hipOccupancyMaxActiveBlocksPerMultiprocessor(&per_cu, (const void*)mega_kernel, 256, 0);
        if (per_cu < 1) per_cu = 1;
        if (per_cu > 2) per_cu = 2;
        grid = cus * per_cu;
    }
    if (grid < 0) return;
    KP p{};
    for (int i = 0; i < 33; ++i) p.in[i] = (const float*)d_in[i];
    p.out = (float*)d_out; p.ws = (char*)d_ws;
    if (hipMemsetAsync((char*)d_ws + OFF_BAR, 0, 3456 * 4, stream) != hipSuccess) { fprintf(stderr, "kernel_launch: memset of barrier words failed\n"); return; }
#if ONE_LAUNCH
    int lo = 0, hi = N_PHASES;
    void* args[] = {&p, &lo, &hi};
    hipError_t e = hipLaunchCooperativeKernel((const void*)mega_kernel, dim3(grid), dim3(256), args, 0, stream);
    if (e != hipSuccess) fprintf(stderr, "cooperative launch failed: %s (grid %d)\n", hipGetErrorString(e), grid);
#else
    for (int ph = 0; ph < N_PHASES; ++ph) hipLaunchKernelGGL(mega_kernel, dim3(grid), dim3(256), 0, stream, p, ph, ph + 1);
#endif
}
```

```cpp
#include <hip/hip_runtime.h>
#include <hip/hip_cooperative_groups.h>
#include <cstdio>
#include <cstdint>
namespace cg = cooperative_groups;

#ifndef ONE_LAUNCH
#define ONE_LAUNCH 1
#endif
#define PROBE_MODE 0
#define EXTRA_SYNCS 0
#define MISC_DUP 0
#define ATT_PROBE 0
#define DUP_MASK 0

#define DI __device__ __forceinline__
#define PH_FN __device__ __forceinline__
typedef unsigned short bf16_t;
using bf16x8 = __attribute__((ext_vector_type(8))) short;
using f32x16 = __attribute__((ext_vector_type(16))) float;
using f32x4 = __attribute__((ext_vector_type(4))) float;
typedef unsigned u32x4 __attribute__((ext_vector_type(4)));
typedef __bf16 bf16x2_t __attribute__((ext_vector_type(2)));
typedef float f2_t __attribute__((ext_vector_type(2)));

constexpr int D = 1024, SEQ = 16384, NB = 2, CTXL = 256;
constexpr int NL = NB * SEQ, NC = NB * CTXL, NT = NL + NC;
constexpr int FF = 2816, DIN = 1440, DMIX = 1280;
constexpr int NH = 8, DK = 96, LK = SEQ + CTXL;
constexpr int IN_CONV = 256, IN_POOL = 768, IN_CQ = 1024, IN_CKV = 1280, IN_KR = 1408;
constexpr int NCHUNK = LK / 64;
constexpr float EPS = 1e-6f;
constexpr float QSCALE = 0.10206207261596575f * 1.4426950408889634f;

constexpr size_t EL_GU = 5632ull * 1024, EL_D = 1024ull * 2816, EL_IN = 1536ull * 1024, EL_OUT = 1024ull * 1280,
                 EL_UQ = 768ull * 256, EL_UKV = 1024ull * 128, EL_GLU = 256ull * 256;
constexpr size_t WO_GU0 = 0, WO_GU1 = EL_GU, WO_D0 = 2 * EL_GU, WO_D1 = WO_D0 + EL_D, WO_IN = WO_D1 + EL_D,
                 WO_OUT = WO_IN + EL_IN, WO_UQ = WO_OUT + EL_OUT, WO_UKV = WO_UQ + EL_UQ, WO_GLU = WO_UKV + EL_UKV,
                 WL_EL = WO_GLU + EL_GLU;
constexpr size_t al256(size_t x) { return (x + 255) & ~(size_t)255; }
constexpr size_t OFF_W = 0;
constexpr size_t OFF_MOD = al256(OFF_W + 2 * WL_EL * 2);
constexpr size_t OFF_ROPE = al256(OFF_MOD + 2ull * 3 * 9216 * 4);
constexpr size_t OFF_LAMB = al256(OFF_ROPE + 256ull * 8 * 2 * 4);
constexpr size_t OFF_BBAR = al256(OFF_LAMB + 2ull * 2048 * 16);
constexpr size_t OFF_CC = al256(OFF_BBAR + 2ull * 2048 * 32 * 4);
constexpr size_t OFF_XC = al256(OFF_CC + 2ull * 32 * 2048 * 2);
constexpr size_t OFF_HY = al256(OFF_XC + (size_t)NC * D * 4);
constexpr size_t OFF_BIG = al256(OFF_HY + (size_t)NT * D * 2);
constexpr size_t OFF_ACT = OFF_BIG;
constexpr size_t OFF_Z = OFF_BIG;
constexpr size_t OFF_Q = al256(OFF_Z + (size_t)NT * DIN * 2);
constexpr size_t OFF_K = al256(OFF_Q + (size_t)NT * 768 * 2);
constexpr size_t OFF_VT = al256(OFF_K + (size_t)NB * NH * LK * 96 * 2);
constexpr size_t OFF_MIX = al256(OFF_VT + (size_t)NB * NH * 64 * LK * 2);
constexpr size_t OFF_S5P = al256(OFF_MIX + (size_t)NT * DMIX * 2);
constexpr size_t OFF_E = al256(OFF_S5P + (size_t)NT * 256 * 2);
constexpr size_t OFF_S = al256(OFF_E + 2ull * 2 * NCHUNK * 1024 * 8);
constexpr size_t OFF_BAR = al256(OFF_S + 2ull * 2 * NCHUNK * 1024 * 8);
constexpr size_t WS_END = al256(OFF_BAR + 3456 * 4);
static_assert(OFF_ACT + (size_t)NT * FF * 2 <= WS_END, "act fits");

struct KP { const float* in[33]; float* out; char* ws; };

DI int TIDX() { int t = threadIdx.x; asm volatile("" : "+v"(t)); return t; }
DI float bf2f(bf16_t b) { return __uint_as_float((unsigned)b << 16); }
DI unsigned pack2(float a, float b) { f2_t v = {a, b}; bf16x2_t r = __builtin_convertvector(v, bf16x2_t); return __builtin_bit_cast(unsigned, r); }
DI bf16_t f2bf(float a) { return (bf16_t)(pack2(a, 0.f) & 0xffffu); }
DI float fast_exp(float x) { return __builtin_amdgcn_exp2f(x * 1.4426950408889634f); }
DI float sigmoidf_(float x) { return __builtin_amdgcn_rcpf(1.f + fast_exp(-x)); }
DI float siluf_(float x) { return x * sigmoidf_(x); }
DI float gelu_tanh(float x) { float u = 0.7978845608028654f * (x + 0.044715f * x * x * x); float t = 1.f - 2.f * __builtin_amdgcn_rcpf(1.f + fast_exp(2.f * u)); return 0.5f * x * (1.f + t); }
DI float shflx(float v, int m) { const int idx = ((TIDX() & 63) ^ m) << 2; return __int_as_float(__builtin_amdgcn_ds_bpermute(idx, __float_as_int(v))); }
DI float xhalf_max(float v) { const auto r = __builtin_amdgcn_permlane32_swap(__float_as_uint(v), __float_as_uint(v), false, false); return fmaxf(__uint_as_float(r[0]), __uint_as_float(r[1])); }
DI float xhalf_sum(float v) { const auto r = __builtin_amdgcn_permlane32_swap(__float_as_uint(v), __float_as_uint(v), false, false); return __uint_as_float(r[0]) + __uint_as_float(r[1]); }
DI float wave_sum(float v) { for (int m = 32; m >= 1; m >>= 1) v += shflx(v, m); return v; }
DI int crow(int i, int hh) { return (i & 3) + 8 * (i >> 2) + 4 * hh; }
DI int row_mod(int row) { return row < NL ? (row >= SEQ ? 1 : 0) : 2; }
DI int vblock() { const int G = gridDim.x, b = blockIdx.x; return (G & 7) ? b : (G >> 3) * (b & 7) + (b >> 3); }
DI void tile_mn(int it, int TM, int TN, int& mt, int& nt) {
    const int band = it / (8 * TN), within = it - band * 8 * TN;
    const int gm = min(8, TM - 8 * band);
    nt = within / gm; mt = 8 * band + (within - nt * gm);
}
DI void gld16(u32x4& r, const void* p) { asm volatile("global_load_dwordx4 %0, %1, off" : "=&v"(r) : "v"(p) : "memory"); }
DI void vm_wait8(u32x4& a, u32x4& b, u32x4& c, u32x4& d, u32x4& e, u32x4& f, u32x4& g, u32x4& h) {
    asm volatile("s_waitcnt vmcnt(0)" : "+v"(a), "+v"(b), "+v"(c), "+v"(d), "+v"(e), "+v"(f), "+v"(g), "+v"(h) : : "memory"); }
DI void vm_wait5(u32x4& a, u32x4& b, u32x4& c, u32x4& d, u32x4& e) {
    asm volatile("s_waitcnt vmcnt(0)" : "+v"(a), "+v"(b), "+v"(c), "+v"(d), "+v"(e) : : "memory"); }
#define MFMA32(a, b, c) __builtin_amdgcn_mfma_f32_32x32x16_bf16((a), (b), (c), 0, 0, 0)
#define MFMA16(a, b, c) __builtin_amdgcn_mfma_f32_16x16x32_bf16((a), (b), (c), 0, 0, 0)

#define XB_TMO      128
#define XB_XCNT(j)  (256  + 64 * (j))
#define XB_XSUB(j)  (1280 + 64 * (j))
#define XB_XGEN(j)  (2304 + 64 * (j))
#define XB_TOP      3328
#define XB_TOPGEN   3392
#define XCD_BAR_WORDS 3456
#define XB_SPIN_CAP (1u << 18)
#define LAS __attribute__((address_space(3)))

__device__ __forceinline__ unsigned xb_ld(unsigned* p)              { return __hip_atomic_load(p, __ATOMIC_RELAXED, __HIP_MEMORY_SCOPE_AGENT); }
__device__ __forceinline__ unsigned xb_add(unsigned* p, unsigned v) { return __hip_atomic_fetch_add(p, v, __ATOMIC_RELAXED, __HIP_MEMORY_SCOPE_AGENT); }
__device__ __forceinline__ unsigned xb_xcc_id() { return (unsigned)__builtin_amdgcn_s_getreg((3 << 11) | 20) & 0xFu; }
#define XB_SPIN(cond, bar) do { unsigned _sp = 0; while (cond) { __builtin_amdgcn_s_sleep(1); \
    if ((++_sp & 255u) == 0u) { if (xb_ld(&(bar)[XB_TMO])) break; if (_sp > XB_SPIN_CAP) { atomicAdd(&(bar)[XB_TMO], 1u); break; } } } } while (0)

struct XcdBarrier {
    unsigned* bar; unsigned x;
    volatile LAS unsigned* st;
};

__device__ __forceinline__ XcdBarrier xcd_barrier_post(unsigned* bar, volatile LAS unsigned* st) {
    XcdBarrier b; b.bar = bar; b.x = xb_xcc_id(); b.st = st;
    if (TIDX() == 0) (void)xb_add(&bar[XB_XCNT(b.x)], 1u);
    return b;
}
__device__ __forceinline__ void xcd_barrier_complete(unsigned* bar, unsigned x, unsigned& nloc, unsigned& nx) {
    const unsigned G = gridDim.x * gridDim.y * gridDim.z;
    unsigned sum, cnt, mine, sp = 0u;
    for (;;) {
        sum = 0u; cnt = 0u; mine = 0u;
#pragma unroll
        for (unsigned j = 0; j < 16; ++j) { const unsigned c = xb_ld(&bar[XB_XCNT(j)]); sum += c; cnt += (c > 0u) ? 1u : 0u; mine = (j == x) ? c : mine; }
        if (sum == G) break;
        __builtin_amdgcn_s_sleep(1);
        if ((++sp & 255u) == 0u) { if (xb_ld(&bar[XB_TMO])) break; if (sp > XB_SPIN_CAP) { atomicAdd(&bar[XB_TMO], 1u); break; } }
    }
    nloc = mine > 0u ? mine : 1u; nx = cnt > 0u ? cnt : 1u;
}

__device__ __forceinline__ void xcd_barrier(const XcdBarrier& b) {
    asm volatile("s_waitcnt vmcnt(0)" ::: "memory");
    __syncthreads();
    if (TIDX() == 0) {
        unsigned* bar = b.bar;
        __builtin_amdgcn_s_waitcnt(0);
        unsigned nloc = b.st[0], nx = b.st[1];
        if (nloc == 0u) { xcd_barrier_complete(bar, b.x, nloc, nx); b.st[0] = nloc; b.st[1] = nx; }
        const unsigned old = xb_add(&bar[XB_XSUB(b.x)], 1u);
        const unsigned gen = old / nloc;
        if (old + 1u == (gen + 1u) * nloc) {
            __builtin_amdgcn_fence(__ATOMIC_RELEASE, "agent");
            asm volatile("s_waitcnt vmcnt(0)" ::: "memory");
            const unsigned og = xb_add(&bar[XB_TOP], 1u);
            const unsigned tg = og / nx;
            if (og + 1u == (tg + 1u) * nx) xb_add(&bar[XB_TOPGEN], 1u);
            else XB_SPIN(xb_ld(&bar[XB_TOPGEN]) == tg, bar);
            __builtin_amdgcn_fence(__ATOMIC_ACQUIRE, "agent");
            xb_add(&bar[XB_XGEN(b.x)], 1u);
            asm volatile("s_waitcnt vmcnt(0)" ::: "memory");
        } else {
            XB_SPIN(xb_ld(&bar[XB_XGEN(b.x)]) == gen, bar);
            __builtin_amdgcn_fence(__ATOMIC_ACQUIRE, "agent");
            asm volatile("s_waitcnt vmcnt(0)" ::: "memory");
        }
    }
    __syncthreads();
}


DI void vm_wait_sel(u32x4& a, u32x4& b, u32x4& c, u32x4& d, u32x4& e, u32x4& f, u32x4& g, u32x4& h, int all) {
    asm volatile("s_cmp_lg_u32 %8, 0\n\ts_cbranch_scc1 1f\n\ts_waitcnt vmcnt(8)\n\ts_branch 2f\n1:\n\ts_waitcnt vmcnt(0)\n2:"
                 : "+v"(a), "+v"(b), "+v"(c), "+v"(d), "+v"(e), "+v"(f), "+v"(g), "+v"(h) : "s"(all) : "memory", "scc"); }

template <int MODE = 0, class Epi>
DI void gemm_tile(const bf16_t* __restrict__ A, int lda, const bf16_t* __restrict__ Bt, int ldb, int K, int row0, int col0, char* smem, Epi&& epi) {
    bf16_t* sA = (bf16_t*)smem;
    bf16_t* sB = sA + 2 * 8192;
    const int tid = TIDX(), lane = tid & 63, wave = tid >> 6;
    const int wm = wave >> 1, wn = wave & 1, l31 = lane & 31, hh = lane >> 5;
    u32x4 r0a[4], r0b[4], r1a[4], r1b[4];
    const bf16_t* Ap = A + (size_t)(row0 + (tid >> 3)) * lda + (tid & 7) * 8;
    const bf16_t* Bp = Bt + (size_t)(col0 + (tid >> 3)) * ldb + (tid & 7) * 8;
    const int wr_off = (tid >> 3) * 64 + (((tid & 7) ^ ((tid >> 4) & 7)) * 8);
    f32x16 acc[2][2];
#pragma unroll
    for (int a = 0; a < 2; ++a)
#pragma unroll
        for (int b = 0; b < 2; ++b)
#pragma unroll
            for (int i = 0; i < 16; ++i) acc[a][b][i] = 0.f;
    const int nk = K >> 6;
#pragma unroll
    for (int i = 0; i < 4; ++i) { r0a[i] = *(const u32x4*)(Ap + (size_t)i * 32 * lda); r0b[i] = *(const u32x4*)(Bp + (size_t)i * 32 * ldb); }
#pragma unroll
    for (int i = 0; i < 4; ++i) { *(u32x4*)(sA + wr_off + i * 2048) = r0a[i]; *(u32x4*)(sB + wr_off + i * 2048) = r0b[i]; }
#pragma unroll
    for (int i = 0; i < 4; ++i) { gld16(r1a[i], Ap + (size_t)i * 32 * lda + 64); gld16(r1b[i], Bp + (size_t)i * 32 * ldb + 64); }
    __syncthreads();
    const int sw = (l31 >> 1) & 7;
    const bf16_t* cA = sA + (wm * 64 + l31) * 64;
    const bf16_t* cB = sB + (wn * 64 + l31) * 64;
#define GEMM_LDFRAG(buf_, ks_, a0_, a1_, b0_, b1_) do { const int ch = ((2 * (ks_) + hh) ^ sw) * 8; \
            a0_ = *(const bf16x8*)(cA + (buf_) * 8192 + ch); a1_ = *(const bf16x8*)(cA + (buf_) * 8192 + 32 * 64 + ch); \
            b0_ = *(const bf16x8*)(cB + (buf_) * 8192 + ch); b1_ = *(const bf16x8*)(cB + (buf_) * 8192 + 32 * 64 + ch); } while (0)
#define GEMM_MMA(a0_, a1_, b0_, b1_) do { acc[0][0] = MFMA32(a0_, b0_, acc[0][0]); acc[0][1] = MFMA32(a0_, b1_, acc[0][1]); \
            acc[1][0] = MFMA32(a1_, b0_, acc[1][0]); acc[1][1] = MFMA32(a1_, b1_, acc[1][1]); } while (0)
#define SB_ __builtin_amdgcn_sched_barrier(0)
#define GEMM_COMPUTE(buf_) do { bf16x8 pa0, pa1, pb0, pb1, qa0, qa1, qb0, qb1; \
            GEMM_LDFRAG(buf_, 0, pa0, pa1, pb0, pb1); GEMM_LDFRAG(buf_, 1, qa0, qa1, qb0, qb1); SB_; GEMM_MMA(pa0, pa1, pb0, pb1); SB_; \
            GEMM_LDFRAG(buf_, 2, pa0, pa1, pb0, pb1); SB_; GEMM_MMA(qa0, qa1, qb0, qb1); SB_; \
            GEMM_LDFRAG(buf_, 3, qa0, qa1, qb0, qb1); SB_; GEMM_MMA(pa0, pa1, pb0, pb1); SB_; GEMM_MMA(qa0, qa1, qb0, qb1); SB_; } while (0)
    for (int kt = 0; kt < nk; kt += 2) {
        const bool m2 = (kt + 2) < nk, m3 = (kt + 3) < nk;
        if (m2 && MODE == 0) {
            const int k0 = (kt + 2) << 6;
#pragma unroll
            for (int i = 0; i < 4; ++i) { gld16(r0a[i], Ap + (size_t)i * 32 * lda + k0); gld16(r0b[i], Bp + (size_t)i * 32 * ldb + k0); }
        }
        GEMM_COMPUTE(0);
        vm_wait_sel(r1a[0], r1a[1], r1a[2], r1a[3], r1b[0], r1b[1], r1b[2], r1b[3], __builtin_amdgcn_readfirstlane((m2 && MODE == 0) ? 0 : 1));
        if (MODE < 2)
#pragma unroll
        for (int i = 0; i < 4; ++i) { *(u32x4*)(sA + 8192 + wr_off + i * 2048) = r1a[i]; *(u32x4*)(sB + 8192 + wr_off + i * 2048) = r1b[i]; }
        __syncthreads();
        if (m3 && MODE == 0) {
            const int k0 = (kt + 3) << 6;
#pragma unroll
            for (int i = 0; i < 4; ++i) { gld16(r1a[i], Ap + (size_t)i * 32 * lda + k0); gld16(r1b[i], Bp + (size_t)i * 32 * ldb + k0); }
        }
        GEMM_COMPUTE(1);
        if (m2) {
            vm_wait_sel(r0a[0], r0a[1], r0a[2], r0a[3], r0b[0], r0b[1], r0b[2], r0b[3], __builtin_amdgcn_readfirstlane((m3 && MODE == 0) ? 0 : 1));
            if (MODE < 2)
#pragma unroll
            for (int i = 0; i < 4; ++i) { *(u32x4*)(sA + wr_off + i * 2048) = r0a[i]; *(u32x4*)(sB + wr_off + i * 2048) = r0b[i]; }
        }
        __syncthreads();
    }
#undef GEMM_COMPUTE
#undef GEMM_LDFRAG
#undef GEMM_MMA
    epi(acc, row0 + wm * 64, col0 + wn * 64);
}

DI const bf16_t* uni_ptr(const bf16_t* p) {
    const unsigned long long v = (unsigned long long)p;
    const unsigned lo = __builtin_amdgcn_readfirstlane((unsigned)v), hi = __builtin_amdgcn_readfirstlane((unsigned)(v >> 32));
    return (const bf16_t*)(((unsigned long long)hi << 32) | lo); }
DI void gld16s(u32x4& r, unsigned voff, const void* sbase) { asm volatile("global_load_dwordx4 %0, %1, %2" : "=&v"(r) : "v"(voff), "s"(sbase) : "memory"); }
DI void vm_wait12(u32x4& a, u32x4& b, u32x4& c, u32x4& d, u32x4& e, u32x4& f, u32x4& g, u32x4& h, u32x4& i, u32x4& j, u32x4& k, u32x4& l) {
    asm volatile("s_waitcnt vmcnt(0)" : "+v"(a), "+v"(b), "+v"(c), "+v"(d), "+v"(e), "+v"(f), "+v"(g), "+v"(h), "+v"(i), "+v"(j), "+v"(k), "+v"(l) : : "memory"); }

template <class Epi>
DI void gemm_tile256(const bf16_t* __restrict__ A, int lda, const bf16_t* __restrict__ Bt, int ldb, int K, int row0, int col0, char* smem, Epi&& epi) {
    bf16_t* sA = (bf16_t*)smem;
    bf16_t* sB = sA + 256 * 64;
    const int tid = TIDX(), lane = tid & 63, wave = tid >> 6;
    const int wm = wave >> 1, wn = wave & 1, l31 = lane & 31, hh = lane >> 5;
    u32x4 ra[8], rb[4];
    const bf16_t* Ab = uni_ptr(A + (size_t)row0 * lda);
    const bf16_t* Bb = uni_ptr(Bt + (size_t)col0 * ldb);
    const unsigned voa = ((unsigned)(tid >> 3) * (unsigned)lda + (tid & 7) * 8) * 2u;
    const unsigned vob = ((unsigned)(tid >> 3) * (unsigned)ldb + (tid & 7) * 8) * 2u;
    const int wr_off = (tid >> 3) * 64 + (((tid & 7) ^ ((tid >> 4) & 7)) * 8);
    f32x16 acc[4][2];
#pragma unroll
    for (int a = 0; a < 4; ++a)
#pragma unroll
        for (int b = 0; b < 2; ++b)
#pragma unroll
            for (int i = 0; i < 16; ++i) acc[a][b][i] = 0.f;
    const int nk = K >> 6;
#pragma unroll
    for (int i = 0; i < 8; ++i) gld16s(ra[i], voa, Ab + (size_t)i * 32 * lda);
#pragma unroll
    for (int i = 0; i < 4; ++i) gld16s(rb[i], vob, Bb + (size_t)i * 32 * ldb);
    const int sw = (l31 >> 1) & 7;
    const bf16_t* cA = sA + (wm * 128 + l31) * 64;
    const bf16_t* cB = sB + (wn * 64 + l31) * 64;
    for (int kt = 0; kt < nk; ++kt) {
        vm_wait12(ra[0], ra[1], ra[2], ra[3], ra[4], ra[5], ra[6], ra[7], rb[0], rb[1], rb[2], rb[3]);
#pragma unroll
        for (int i = 0; i < 8; ++i) *(u32x4*)(sA + wr_off + i * 2048) = ra[i];
#pragma unroll
        for (int i = 0; i < 4; ++i) *(u32x4*)(sB + wr_off + i * 2048) = rb[i];
        __syncthreads();
        if (kt + 1 < nk) {
            const int k0 = (kt + 1) << 6;
#pragma unroll
            for (int i = 0; i < 8; ++i) gld16s(ra[i], voa, Ab + (size_t)i * 32 * lda + k0);
#pragma unroll
            for (int i = 0; i < 4; ++i) gld16s(rb[i], vob, Bb + (size_t)i * 32 * ldb + k0);
        }
        __builtin_amdgcn_s_setprio(1);
#pragma unroll
        for (int ks = 0; ks < 4; ++ks) {
            const int ch = ((2 * ks + hh) ^ sw) * 8;
            const bf16x8 b0 = *(const bf16x8*)(cB + ch), b1 = *(const bf16x8*)(cB + 32 * 64 + ch);
#pragma unroll
            for (int mi = 0; mi < 4; ++mi) {
                const bf16x8 a = *(const bf16x8*)(cA + mi * 32 * 64 + ch);
                acc[mi][0] = MFMA32(a, b0, acc[mi][0]);
                acc[mi][1] = MFMA32(a, b1, acc[mi][1]);
            }
        }
        __builtin_amdgcn_s_setprio(0);
        __syncthreads();
    }
    epi(acc, row0 + wm * 128, col0 + wn * 64);
}

DI void transpose_store(bf16_t* dst, int K, int n0, int k0, const float* tile) {
    const int kp = TIDX() & 31, nn = TIDX() >> 5;
#pragma unroll
    for (int i = 0; i < 8; ++i) {
        const int n = nn + 8 * i;
        *(unsigned*)(dst + (size_t)(n0 + n) * K + k0 + 2 * kp) = pack2(tile[(2 * kp) * 65 + n], tile[(2 * kp + 1) * 65 + n]);
    }
}
template <class F>
DI void transpose_tile(bf16_t* dst, int K, int tn, int tk, F src, float* tile) {
    const int tx = TIDX() & 63, ty = TIDX() >> 6;
    const int n0 = tn * 64, k0 = tk * 64;
    float v[16];
#pragma unroll
    for (int i = 0; i < 16; ++i) v[i] = src(k0 + ty + 4 * i, n0 + tx);
#pragma unroll
    for (int i = 0; i < 16; ++i) tile[(ty + 4 * i) * 65 + tx] = v[i];
    __syncthreads();
    transpose_store(dst, K, n0, k0, tile);
    __syncthreads();
}
DI void poolfold_tile(bf16_t* dst, int tn, int tk, const float* wi, const float* pw, const float* ps, float* smemf) {
    float* wt = smemf;
    float* pt = smemf + 64 * 65;
    float* ot = pt + 64 * 64;
    const int tx = TIDX() & 63, ty = TIDX() >> 6;
    const int n0 = tn * 64, k0 = tk * 64, g = (n0 - IN_POOL) >> 6;
    const float sc = ps[g * 64 + tx];
#pragma unroll
    for (int i = 0; i < 16; ++i) {
        const int r = ty + 4 * i;
        wt[r * 65 + tx] = wi[(size_t)(k0 + r) * DIN + IN_POOL + g * 64 + tx];
        pt[r * 64 + tx] = pw[g * 4096 + r * 64 + tx] * sc;
    }
    __syncthreads();
    float acc[16];
#pragma unroll
    for (int i = 0; i < 16; ++i) acc[i] = 0.f;
    for (int ii = 0; ii < 64; ++ii) {
        const float pv = pt[ii * 64 + tx];
#pragma unroll
        for (int i = 0; i < 16; ++i) acc[i] += wt[(ty + 4 * i) * 65 + ii] * pv;
    }
#pragma unroll
    for (int i = 0; i < 16; ++i) ot[(ty + 4 * i) * 65 + tx] = acc[i];
    __syncthreads();
    transpose_store(dst, 1024, n0, k0, ot);
    __syncthreads();
}

PH_FN void prep_phase(const KP& p, char* smem) {
    float* tile = (float*)smem;
    bf16_t* W = (bf16_t*)(p.ws + OFF_W);
    const int NTR = 5024;
    const int n_items = 2 * NTR + 288 + 1 + 16;
    for (int it = blockIdx.x; it < n_items; it += gridDim.x) {
        if (it < 2 * NTR) {
            const int l = it / NTR; int r = it % NTR;
            bf16_t* Wl = W + (size_t)l * WL_EL;
            if (r < 2816) {
                const int f = r / 1408; r %= 1408;
                const float* g = p.in[8] + (size_t)(l * 2 + f) * D * FF;
                const float* u = p.in[9] + (size_t)(l * 2 + f) * D * FF;
                transpose_tile(Wl + (f ? WO_GU1 : WO_GU0), 1024, r / 16, r % 16, [&](int k, int n) {
                    const int j = n >> 7, w = n & 127, c = j * 64 + (w >> 6) * 32 + (w & 31);
                    return ((w >> 5) & 1) ? u[(size_t)k * FF + c] : g[(size_t)k * FF + c]; }, tile);
            } else if (r < 2816 + 1408) {
                r -= 2816; const int f = r / 704; r %= 704;
                const float* dn = p.in[10] + (size_t)(l * 2 + f) * FF * D;
                transpose_tile(Wl + (f ? WO_D1 : WO_D0), 2816, r / 44, r % 44, [&](int k, int n) { return dn[(size_t)k * D + n]; }, tile);
            } else if (r < 4224 + 384) {
                r -= 4224;
                const float* wi = p.in[11] + (size_t)l * D * DIN;
                const float* pw = p.in[27] + (size_t)l * 4 * 64 * 64;
                const float* ps = p.in[28] + (size_t)l * 256;
                const int tn = r / 16, tk = r % 16;
                if (tn >= IN_POOL / 64 && tn < IN_CQ / 64) poolfold_tile(Wl + WO_IN, tn, tk, wi, pw, ps, tile);
                else transpose_tile(Wl + WO_IN, 1024, tn, tk, [&](int k, int n) { return n < DIN ? wi[(size_t)k * DIN + n] : 0.f; }, tile);
            } else if (r < 4608 + 320) {
                r -= 4608;
                const float* wo = p.in[12] + (size_t)l * DMIX * D;
                transpose_tile(Wl + WO_OUT, 1280, r / 20, r % 20, [&](int k, int n) { return wo[(size_t)k * D + n]; }, tile);
            } else if (r < 4928 + 48) {
                r -= 4928;
                const float* wq = p.in[30] + (size_t)l * 256 * 768;
                const float* gn = p.in[29] + (size_t)l * 256;
                transpose_tile(Wl + WO_UQ, 256, r / 4, r % 4, [&](int k, int n) { return wq[(size_t)k * 768 + n] * gn[k] * QSCALE; }, tile);
            } else if (r < 4976 + 32) {
                r -= 4976;
                const float* wk = p.in[32] + (size_t)l * 128 * 1024;
                const float* gn = p.in[31] + (size_t)l * 128;
                transpose_tile(Wl + WO_UKV, 128, r / 2, r % 2, [&](int k, int n) { return wk[(size_t)k * 1024 + n] * gn[k]; }, tile);
            } else {
                r -= 5008;
                const float* wg = p.in[21] + (size_t)l * 256 * 256;
                transpose_tile(Wl + WO_GLU, 256, r / 4, r % 4, [&](int k, int n) { return wg[(size_t)k * 256 + n]; }, tile);
            }
        } else if (it < 2 * NTR + 288) {
            const int r = it - 2 * NTR, l = r / 144, n0 = (r % 144) * 64;
            float* sc = (float*)smem;
            float* red = sc + 3072;
            for (int i = TIDX(); i < 3072; i += 256) {
                const int v = i >> 10, k = i & 1023;
                const float cv = v < 2 ? p.in[1][v * 1024 + k] : p.in[3][k];
                sc[i] = cv / (1.f + expf(-cv));
            }
            __syncthreads();
            const int tx = TIDX() & 63, ty = TIDX() >> 6;
            const float* wa = p.in[4] + (size_t)l * D * 9216 + n0 + tx;
            float a0 = 0.f, a1 = 0.f, a2 = 0.f;
#pragma unroll 32
            for (int k = ty * 256; k < ty * 256 + 256; ++k) {
                const float w = wa[(size_t)k * 9216];
                a0 += sc[k] * w; a1 += sc[1024 + k] * w; a2 += sc[2048 + k] * w;
            }
            red[(ty * 3 + 0) * 64 + tx] = a0; red[(ty * 3 + 1) * 64 + tx] = a1; red[(ty * 3 + 2) * 64 + tx] = a2;
            __syncthreads();
            if (TIDX() < 192) {
                const int v = TIDX() >> 6;
                float s = p.in[5][l * 9216 + n0 + tx];
                for (int q = 0; q < 4; ++q) s += red[(q * 3 + v) * 64 + tx];
                ((float*)(p.ws + OFF_MOD))[(size_t)(l * 3 + v) * 9216 + n0 + tx] = s;
            }
            __syncthreads();
        } else if (it == 2 * NTR + 288) {
            float* tab = (float*)(p.ws + OFF_ROPE);
            const int pos = TIDX();
            for (int i = 0; i < 8; ++i) {
                const float inv = powf(10000.f, -(float)(2 * i) / 16.f);
                const float ang = (float)pos * inv;
                tab[(pos * 8 + i) * 2 + 0] = cosf(ang);
                tab[(pos * 8 + i) * 2 + 1] = sinf(ang);
            }
        } else {
            const int idx = (it - (2 * NTR + 289)) * 256 + TIDX();
            const int pp = idx & 63, g = (idx >> 6) & 15, ld = idx >> 10;
            float lr = fminf(p.in[13][idx], -1e-4f), li = p.in[14][idx];
            const float dt = expf(p.in[15][ld * 16 + g]);
            const float mag = expf(lr * dt);
            const float br = mag * cosf(li * dt), bi = mag * sinf(li * dt);
            float tr = br, ti = bi;
            for (int q = 0; q < 6; ++q) { const float nr = tr * tr - ti * ti, ni = 2.f * tr * ti; tr = nr; ti = ni; }
            ((float4*)(p.ws + OFF_LAMB))[idx] = make_float4(br, bi, tr, ti);
            const float nr = br - 1.f, ni = bi, den = 1.f / (lr * lr + li * li);
            const float cr = (nr * lr + ni * li) * den, ci = (ni * lr - nr * li) * den;
            float* bb = (float*)(p.ws + OFF_BBAR) + (size_t)idx * 32;
            const float* sbr = p.in[16] + (size_t)idx * 16; const float* sbi = p.in[17] + (size_t)idx * 16;
            for (int h = 0; h < 16; ++h) { const float xr = sbr[h], xi = sbi[h]; bb[2 * h] = cr * xr - ci * xi; bb[2 * h + 1] = cr * xi + ci * xr; }
            bf16_t* cc = (bf16_t*)(p.ws + OFF_CC) + (size_t)(ld * 16 + g) * 2048;
            const float* scr = p.in[18] + (size_t)(ld * 16 + g) * 1024; const float* sci = p.in[19] + (size_t)(ld * 16 + g) * 1024;
            for (int h = 0; h < 16; ++h) { cc[h * 128 + pp] = f2bf(scr[h * 64 + pp]); cc[h * 128 + 64 + pp] = f2bf(-sci[h * 64 + pp]); }
        }
    }
}

PH_FN void rowop_phase(const KP& p, int l_mod_post, int gate_idx, float coef, const float* gpost, bool has_y,
                    int l_mod_pre, int shift_idx, const float* gpre, bool has_pre, bool first, int nrows = NT) {
    const int lane = TIDX() & 63;
    const int wid = blockIdx.x * 4 + (TIDX() >> 6), nw = gridDim.x * 4;
    bf16_t* HY = (bf16_t*)(p.ws + OFF_HY);
    float* Xc = (float*)(p.ws + OFF_XC);
    const float* MOD = (const float*)(p.ws + OFF_MOD);
    for (int row0 = wid; row0 < nrows; row0 += 2 * nw) {
        int rows[2]; bool ok[2];
        rows[0] = row0; ok[0] = true;
        ok[1] = (row0 + nw) < nrows; rows[1] = ok[1] ? row0 + nw : row0;
        float* xp[2]; int mv[2];
        float4 x[2][4], y[2][4];
        float ssy[2] = {0.f, 0.f};
#pragma unroll
        for (int q = 0; q < 2; ++q) {
            const int row = rows[q];
            mv[q] = row_mod(row);
            xp[q] = row < NL ? p.out + (size_t)row * D : Xc + (size_t)(row - NL) * D;
            const float* xin = first ? (row < NL ? p.in[0] + (size_t)row * D : p.in[2] + (size_t)(row - NL) * D) : xp[q];
#pragma unroll
            for (int i = 0; i < 4; ++i) x[q][i] = *(const float4*)(xin + lane * 4 + 256 * i);
            if (has_y) {
#pragma unroll
                for (int i = 0; i < 4; ++i) {
                    const uint2 raw = *(const uint2*)(HY + (size_t)row * D + lane * 4 + 256 * i);
                    y[q][i].x = __uint_as_float(raw.x << 16); y[q][i].y = __uint_as_float(raw.x & 0xffff0000u);
                    y[q][i].z = __uint_as_float(raw.y << 16); y[q][i].w = __uint_as_float(raw.y & 0xffff0000u);
                    ssy[q] += y[q][i].x * y[q][i].x + y[q][i].y * y[q][i].y + y[q][i].z * y[q][i].z + y[q][i].w * y[q][i].w;
                }
            }
        }
        if (has_y) {
            for (int m = 32; m >= 1; m >>= 1) { ssy[0] += shflx(ssy[0], m); ssy[1] += shflx(ssy[1], m); }
#pragma unroll
            for (int q = 0; q < 2; ++q) {
                const float rstd = rsqrtf(ssy[q] * (1.f / D) + EPS);
                const float* gt = MOD + (size_t)(l_mod_post * 3 + mv[q]) * 9216 + gate_idx * 1024;
#pragma unroll
                for (int i = 0; i < 4; ++i) {
                    const float4 g = *(const float4*)(gt + lane * 4 + 256 * i);
                    const float4 w = *(const float4*)(gpost + lane * 4 + 256 * i);
                    x[q][i].x += coef * g.x * (y[q][i].x * rstd * w.x); x[q][i].y += coef * g.y * (y[q][i].y * rstd * w.y);
                    x[q][i].z += coef * g.z * (y[q][i].z * rstd * w.z); x[q][i].w += coef * g.w * (y[q][i].w * rstd * w.w);
                }
                if (ok[q]) {
#pragma unroll
                    for (int i = 0; i < 4; ++i) *(float4*)(xp[q] + lane * 4 + 256 * i) = x[q][i];
                }
            }
        }
        if (has_pre) {
            float ssx[2];
#pragma unroll
            for (int q = 0; q < 2; ++q) {
                ssx[q] = 0.f;
#pragma unroll
                for (int i = 0; i < 4; ++i) ssx[q] += x[q][i].x * x[q][i].x + x[q][i].y * x[q][i].y + x[q][i].z * x[q][i].z + x[q][i].w * x[q][i].w;
            }
            for (int m = 32; m >= 1; m >>= 1) { ssx[0] += shflx(ssx[0], m); ssx[1] += shflx(ssx[1], m); }
#pragma unroll
            for (int q = 0; q < 2; ++q) {
                const float rstd = rsqrtf(ssx[q] * (1.f / D) + EPS);
                const float* sh = MOD + (size_t)(l_mod_pre * 3 + mv[q]) * 9216 + shift_idx * 1024;
                if (ok[q]) {
#pragma unroll
                    for (int i = 0; i < 4; ++i) {
                        const float4 s0 = *(const float4*)(sh + lane * 4 + 256 * i);
                        const float4 s1 = *(const float4*)(sh + 1024 + lane * 4 + 256 * i);
                        const float4 w = *(const float4*)(gpre + lane * 4 + 256 * i);
                        const float h0 = x[q][i].x * rstd * w.x * (1.f + s1.x) + s0.x, h1 = x[q][i].y * rstd * w.y * (1.f + s1.y) + s0.y;
                        const float h2 = x[q][i].z * rstd * w.z * (1.f + s1.z) + s0.z, h3 = x[q][i].w * rstd * w.w * (1.f + s1.w) + s0.w;
                        uint2 o; o.x = pack2(h0, h1); o.y = pack2(h2, h3);
                        *(uint2*)(HY + (size_t)rows[q] * D + lane * 4 + 256 * i) = o;
                    }
                }
            }
        }
    }
}

template <int MODE = 0>
PH_FN void gemm1_phase(const KP& p, int l, int f, char* smem, int ntm = NT / 256) {
    const bf16_t* H = (const bf16_t*)(p.ws + OFF_HY);
    const bf16_t* W = (const bf16_t*)(p.ws + OFF_W) + (size_t)l * WL_EL + (f ? WO_GU1 : WO_GU0);
    bf16_t* ACT = (bf16_t*)(p.ws + OFF_ACT);
    const int lane = TIDX() & 63, l31 = lane & 31, hh = lane >> 5;
    const int n_items = (NL / 256) * 44;
    const int n_ctx = ntm > NL / 256 ? (NC / 128) * 44 : 0;
    for (int it = vblock(); it < n_ctx; it += gridDim.x) {
        const int mt = it / 44, nt = it - mt * 44;
        gemm_tile(H, D, W, D, D, NL + mt * 128, nt * 128, smem, [&](f32x16 (&acc)[2][2], int r0, int c0) {
            const int col = (c0 >> 7) * 64 + ((c0 >> 6) & 1) * 32 + l31;
#pragma unroll
            for (int mi = 0; mi < 2; ++mi)
#pragma unroll
                for (int i = 0; i < 16; ++i) ACT[(size_t)(r0 + 32 * mi + crow(i, hh)) * FF + col] = f2bf(siluf_(acc[mi][0][i]) * acc[mi][1][i]);
        });
    }
    for (int it = vblock(); it < n_items; it += gridDim.x) {
        int mt, nt; tile_mn(it, NL / 256, 44, mt, nt);
        gemm_tile256(H, D, W, D, D, mt * 256, nt * 128, smem, [&](f32x16 (&acc)[4][2], int r0, int c0) {
            const int col = (c0 >> 7) * 64 + ((c0 >> 6) & 1) * 32 + l31;
#pragma unroll
            for (int mi = 0; mi < 4; ++mi)
#pragma unroll
                for (int i = 0; i < 16; ++i) {
                    const int row = r0 + 32 * mi + crow(i, hh);
                    ACT[(size_t)row * FF + col] = f2bf(siluf_(acc[mi][0][i]) * acc[mi][1][i]);
                }
        });
    }
}

template <int MODE = 0>
PH_FN void gemm_store_phase(const bf16_t* A, int lda, const bf16_t* W, int K, int ntn, bf16_t* C, int ldc, int ncols, char* smem, int ntm = NT / 128) {
    const int lane = TIDX() & 63, l31 = lane & 31, hh = lane >> 5;
    const int n_items = ntm * ntn;
    for (int it = vblock(); it < n_items; it += gridDim.x) {
        int mt, nt; tile_mn(it, ntm, ntn, mt, nt);
        gemm_tile<MODE>(A, lda, W, K, K, mt * 128, nt * 128, smem, [&](f32x16 (&acc)[2][2], int r0, int c0) {
            if (MODE != 0 && acc[0][0][0] != 123456.789f) return;
#pragma unroll
            for (int ni = 0; ni < 2; ++ni) {
                const int col = c0 + 32 * ni + l31;
                if (col < ncols) {
#pragma unroll
                    for (int mi = 0; mi < 2; ++mi)
#pragma unroll
                        for (int i = 0; i < 16; ++i) C[(size_t)(r0 + 32 * mi + crow(i, hh)) * ldc + col] = f2bf(acc[mi][ni][i]);
                }
            }
        });
    }
}

template <int LDC>
PH_FN void gemm_store_phase256(const bf16_t* A, int lda, const bf16_t* W, int K, int ntn, bf16_t* C, char* smem, int ntm, int nctx128) {
    const int lane = TIDX() & 63, l31 = lane & 31, hh = lane >> 5;
    const int n_items = ntm * ntn;
    for (int it = vblock(); it < nctx128 * ntn; it += gridDim.x) {
        const int mt = it / ntn, nt = it - mt * ntn;
        gemm_tile(A, lda, W, K, K, NL + mt * 128, nt * 128, smem, [&](f32x16 (&acc)[2][2], int r0, int c0) {
#pragma unroll
            for (int mi = 0; mi < 2; ++mi) {
                bf16_t* cp = C + (size_t)(r0 + 32 * mi + 4 * hh) * LDC + c0 + l31;
#pragma unroll
                for (int ni = 0; ni < 2; ++ni)
#pragma unroll
                    for (int i = 0; i < 16; ++i) if (LDC == D || c0 + l31 + 32 * ni < LDC) cp[((i & 3) + 8 * (i >> 2)) * LDC + 32 * ni] = f2bf(acc[mi][ni][i]);
            }
        });
    }
    for (int it = vblock(); it < n_items; it += gridDim.x) {
        int mt, nt; tile_mn(it, ntm, ntn, mt, nt);
        gemm_tile256(A, lda, W, K, K, mt * 256, nt * 128, smem, [&](f32x16 (&acc)[4][2], int r0, int c0) {
#pragma unroll
            for (int mi = 0; mi < 4; ++mi) {
                bf16_t* cp = C + (size_t)(r0 + 32 * mi + 4 * hh) * LDC + c0 + l31;
#pragma unroll
                for (int ni = 0; ni < 2; ++ni)
#pragma unroll
                    for (int i = 0; i < 16; ++i) if (LDC == D || c0 + l31 + 32 * ni < LDC) cp[((i & 3) + 8 * (i >> 2)) * LDC + 32 * ni] = f2bf(acc[mi][ni][i]);
                __builtin_amdgcn_sched_barrier(0);
            }
        });
    }
}

PH_FN void glu_phase(const KP& p, int l, char* smem) {
    const bf16_t* S5P = (const bf16_t*)(p.ws + OFF_S5P);
    const bf16_t* W = (const bf16_t*)(p.ws + OFF_W) + (size_t)l * WL_EL + WO_GLU;
    bf16_t* MIX = (bf16_t*)(p.ws + OFF_MIX);
    const float* bg = p.in[22] + l * 256;
    const int lane = TIDX() & 63, l31 = lane & 31, hh = lane >> 5;
    const int n_items = (NT / 128) * 2;
    for (int it = vblock(); it < n_items; it += gridDim.x) {
        const int mt = it >> 1, nt = it & 1;
        gemm_tile(S5P, 256, W, 256, 256, mt * 128, nt * 128, smem, [&](f32x16 (&acc)[2][2], int r0, int c0) {
#pragma unroll
            for (int ni = 0; ni < 2; ++ni) {
                const int col = c0 + 32 * ni + l31;
                const float b = bg[col];
#pragma unroll
                for (int mi = 0; mi < 2; ++mi)
#pragma unroll
                    for (int i = 0; i < 16; ++i) {
                        const int row = r0 + 32 * mi + crow(i, hh);
                        const float y = bf2f(S5P[(size_t)row * 256 + col]);
                        MIX[(size_t)row * DMIX + col] = f2bf(y * sigmoidf_(acc[mi][ni][i] + b));
                        if ((i & 3) == 3) __builtin_amdgcn_sched_barrier(0);
                    }
            }
        });
    }
}

DI void key_pos(int row, int& b, int& pos) {
    if (row < NL) { b = row >= SEQ ? 1 : 0; pos = row - b * SEQ; }
    else { const int r = row - NL; b = r >> 8; pos = SEQ + (r & 255); }
}

DI void qkv_item(const KP& p, int l, int it, char* smem) {
    const bf16_t* Z = (const bf16_t*)(p.ws + OFF_Z);
    const bf16_t* Wl = (const bf16_t*)(p.ws + OFF_W) + (size_t)l * WL_EL;
    bf16_t* Q = (bf16_t*)(p.ws + OFF_Q);
    bf16_t* Kb = (bf16_t*)(p.ws + OFF_K);
    bf16_t* Vt = (bf16_t*)(p.ws + OFF_VT);
    const float* tab = (const float*)(p.ws + OFF_ROPE);
    const int mt = it / 14, sub = it % 14, row0 = mt * 128;
    const int tid = TIDX(), lane = tid & 63, l31 = lane & 31, hh = lane >> 5;
    __shared__ float s_rs[128];
    {
        const int r = tid >> 1, half = tid & 1;
        const bool isq = sub < 6;
        const int n = isq ? 128 : 64;
        const bf16_t* src = Z + (size_t)(row0 + r) * DIN + (isq ? IN_CQ : IN_CKV) + half * n;
        float ss = 0.f;
        for (int i = 0; i < n; i += 8) {
            const uint4 v = *(const uint4*)(src + i);
            const unsigned w[4] = {v.x, v.y, v.z, v.w};
#pragma unroll
            for (int q = 0; q < 4; ++q) { const float a = __uint_as_float(w[q] << 16), b = __uint_as_float(w[q] & 0xffff0000u); ss += a * a + b * b; }
        }
        ss += shflx(ss, 1);
        if (half == 0) s_rs[r] = rsqrtf(ss / (float)(2 * n) + EPS);
    }
    __syncthreads();
    if (sub < 6) {
        gemm_tile(Z + IN_CQ, DIN, Wl + WO_UQ, 256, 256, row0, sub * 128, smem, [&](f32x16 (&acc)[2][2], int r0, int c0) {
#pragma unroll
            for (int ni = 0; ni < 2; ++ni) {
                const int cb = c0 + 32 * ni, col = cb + l31;
                const bool is_rope = ((cb >> 5) % 3) == 2;
                const int axis = l31 >> 4, second = (l31 >> 3) & 1, fi = l31 & 7;
#pragma unroll
                for (int mi = 0; mi < 2; ++mi)
#pragma unroll
                    for (int i = 0; i < 16; ++i) {
                        const int row = r0 + 32 * mi + crow(i, hh);
                        float v = acc[mi][ni][i] * s_rs[row - row0];
                        if (is_rope) {
                            const float pr = shflx(v, 8);
                            if (row < NL) {
                                const int t = row & (SEQ - 1);
                                const int pos = axis ? (t & 63) : (t >> 6);
                                const float cs = tab[(pos * 8 + fi) * 2], sn = tab[(pos * 8 + fi) * 2 + 1];
                                v = second ? (v * cs + pr * sn) : (v * cs - pr * sn);
                            }
                        }
                        Q[(size_t)row * 768 + col] = f2bf(v);
                        if ((i & 3) == 3) __builtin_amdgcn_sched_barrier(0);
                    }
            }
        });
    } else {
        const int head = sub - 6;
        gemm_tile(Z + IN_CKV, DIN, Wl + WO_UKV, 128, 128, row0, head * 128, smem, [&](f32x16 (&acc)[2][2], int r0, int c0) {
            const bool isv = (c0 >> 6) & 1;
#pragma unroll
            for (int ni = 0; ni < 2; ++ni) {
                const int dcol = 32 * ni + l31;
#pragma unroll
                for (int mi = 0; mi < 2; ++mi)
#pragma unroll
                    for (int q = 0; q < 4; ++q) {
                        const int rowb = r0 + 32 * mi + 8 * q + 4 * hh;
                        int b, pos; key_pos(rowb, b, pos);
                        float v[4];
#pragma unroll
                        for (int j = 0; j < 4; ++j) v[j] = acc[mi][ni][4 * q + j] * s_rs[rowb + j - row0];
                        if (isv) {
                            uint2 o; o.x = pack2(v[0], v[1]); o.y = pack2(v[2], v[3]);
                            *(uint2*)(Vt + ((size_t)(b * NH + head) * 64 + dcol) * LK + ((pos & ~12) | ((pos & 4) << 1) | ((pos & 8) >> 1))) = o;
                        } else {
#pragma unroll
                            for (int j = 0; j < 4; ++j) Kb[((size_t)(b * NH + head) * LK + pos + j) * DK + dcol] = f2bf(v[j]);
                        }
                    }
            }
        });
        for (int e = tid; e < 128 * 32; e += 256) {
            const int r = e >> 5, d = e & 31, row = row0 + r;
            const bf16_t* kr = Z + (size_t)row * DIN + IN_KR;
            float v = bf2f(kr[d]);
            if (row < NL) {
                const float pr = bf2f(kr[d ^ 8]);
                const int t = row & (SEQ - 1), axis = d >> 4, second = (d >> 3) & 1, fi = d & 7;
                const int pos = axis ? (t & 63) : (t >> 6);
                const float cs = tab[(pos * 8 + fi) * 2], sn = tab[(pos * 8 + fi) * 2 + 1];
                v = second ? (v * cs + pr * sn) : (v * cs - pr * sn);
            }
            int b, pos; key_pos(row, b, pos);
            Kb[((size_t)(b * NH + head) * LK + pos) * DK + 64 + d] = f2bf(v);
        }
    }
    __syncthreads();
}

DI void convpool_item(const KP& p, int l, int it, char* smem) {
    const bf16_t* Z = (const bf16_t*)(p.ws + OFF_Z);
    bf16_t* MIX = (bf16_t*)(p.ws + OFF_MIX);
    float* hs = (float*)smem;
    int L, rowbase, t0;
    if (it < 1024) { L = SEQ; rowbase = (it >> 9) * SEQ; t0 = (it & 511) * 32; }
    else { const int r = it - 1024; L = CTXL; rowbase = NL + (r >> 3) * CTXL; t0 = (r & 7) * 32; }
    const int c = TIDX(), lane = c & 63, wave = c >> 6;
    {
        const int c4 = (c & 63) * 4, ts = c >> 6;
#pragma unroll 4
        for (int j = ts; j < 62; j += 4) {
            const int t = t0 - 15 + j;
            float4 h = make_float4(0.f, 0.f, 0.f, 0.f);
            if (t >= 0 && t < L) {
                const bf16_t* zr = Z + (size_t)(rowbase + t) * DIN + IN_CONV + c4;
                const uint2 v = *(const uint2*)zr, g = *(const uint2*)(zr + 256);
                h.x = __uint_as_float(v.x << 16) * sigmoidf_(__uint_as_float(g.x << 16));
                h.y = __uint_as_float(v.x & 0xffff0000u) * sigmoidf_(__uint_as_float(g.x & 0xffff0000u));
                h.z = __uint_as_float(v.y << 16) * sigmoidf_(__uint_as_float(g.y << 16));
                h.w = __uint_as_float(v.y & 0xffff0000u) * sigmoidf_(__uint_as_float(g.y & 0xffff0000u));
            }
            *(float4*)(hs + j * 256 + c4) = h;
        }
    }
    __syncthreads();
    float w[31];
#pragma unroll
    for (int k = 0; k < 31; ++k) w[k] = p.in[23][(size_t)(l * 31 + k) * 256 + c];
    const float cb = p.in[24][l * 256 + c];
#pragma unroll 1
    for (int tt = 0; tt < 32; ++tt) {
        float s = cb;
#pragma unroll
        for (int k = 0; k < 31; ++k) s += w[k] * hs[(tt + k) * 256 + c];
        hs[tt * 256 + c] = s;
    }
    __syncthreads();
    {
        const float4 lg = *(const float4*)(p.in[25] + l * 256 + lane * 4);
        const float4 lb = *(const float4*)(p.in[26] + l * 256 + lane * 4);
#pragma unroll 1
        for (int q = 0; q < 8; ++q) {
            const int tt = wave * 8 + q;
            const float4 v = *(const float4*)(hs + tt * 256 + lane * 4);
            const float mean = wave_sum(v.x + v.y + v.z + v.w) * (1.f / 256.f);
            const float d0 = v.x - mean, d1 = v.y - mean, d2 = v.z - mean, d3 = v.w - mean;
            const float var = wave_sum(d0 * d0 + d1 * d1 + d2 * d2 + d3 * d3) * (1.f / 256.f);
            const float rstd = rsqrtf(var + EPS);
            uint2 o;
            o.x = pack2(siluf_(d0 * rstd * lg.x + lb.x), siluf_(d1 * rstd * lg.y + lb.y));
            o.y = pack2(siluf_(d2 * rstd * lg.z + lb.z), siluf_(d3 * rstd * lg.w + lb.w));
            *(uint2*)(MIX + (size_t)(rowbase + t0 + tt) * DMIX + 256 + lane * 4) = o;
        }
    }
    __syncthreads();
    {
        const int c4 = (c & 63) * 4, ts = c >> 6;
#pragma unroll 4
        for (int j = ts; j < 47; j += 4) {
            const int t = t0 - 7 + j;
            float4 h = make_float4(0.f, 0.f, 0.f, 0.f);
            if (t >= 0 && t < L) {
                const uint2 v = *(const uint2*)(Z + (size_t)(rowbase + t) * DIN + IN_POOL + c4);
                h.x = __uint_as_float(v.x << 16); h.y = __uint_as_float(v.x & 0xffff0000u); h.z = __uint_as_float(v.y << 16); h.w = __uint_as_float(v.y & 0xffff0000u);
            }
            *(float4*)(hs + j * 256 + c4) = h;
        }
    }
    __syncthreads();
    {
        const int win = 2 << (c >> 6), wa = (win - 1) >> 1, wb = win >> 1;
#pragma unroll 1
        for (int tt = 0; tt < 32; ++tt) {
            const int t = t0 + tt;
            const int lo = max(t - wa, 0), hi = min(t + wb, L - 1);
            float s = 0.f;
            for (int q = lo; q <= hi; ++q) s += hs[(q - t0 + 7) * 256 + c];
            const float o = s / (float)(hi - lo + 1) - hs[(tt + 7) * 256 + c];
            MIX[(size_t)(rowbase + t) * DMIX + 512 + c] = f2bf(o);
        }
    }
    __syncthreads();
}

DI int chunk_row(int b, int k) { return k < 4 ? NL + b * CTXL + 64 * k : b * SEQ + 64 * (k - 4); }

template <bool FINAL>
DI void s5_item(const KP& p, int l, int it, char* smem) {
    const int g4 = it & 3, k = (it >> 2) % NCHUNK, b = (it >> 2) / NCHUNK;
    const int tid = TIDX(), lane = tid & 63, wave = tid >> 6, g = g4 * 4 + wave;
    const bf16_t* Z = (const bf16_t*)(p.ws + OFF_Z);
    float* Us = (float*)smem + wave * 1024;
    bf16_t* Hs = (bf16_t*)(smem + 16384) + wave * (16 * 136);
    const int rbase = chunk_row(b, k);
    {
        const uint4* src = (const uint4*)(Z + (size_t)(rbase + lane) * DIN + g * 16);
        const uint4 v0 = src[0], v1 = src[1];
        const unsigned w[8] = {v0.x, v0.y, v0.z, v0.w, v1.x, v1.y, v1.z, v1.w};
#pragma unroll
        for (int q = 0; q < 8; ++q) { Us[lane * 16 + 2 * q] = __uint_as_float(w[q] << 16); Us[lane * 16 + 2 * q + 1] = __uint_as_float(w[q] & 0xffff0000u); }
    }
    __syncthreads();
    f32x4 yacc[4];
#pragma unroll
    for (int s = 0; s < 4; ++s) yacc[s] = f32x4{0.f, 0.f, 0.f, 0.f};
#pragma unroll
    for (int dir = 0; dir < 2; ++dir) {
        const int pidx = ((l * 2 + dir) * 16 + g) * 64 + lane;
        const float4 lam = ((const float4*)(p.ws + OFF_LAMB))[pidx];
        float br[16], bi[16];
        {
            const float4* bb = (const float4*)((const float*)(p.ws + OFF_BBAR) + (size_t)pidx * 32);
#pragma unroll
            for (int q = 0; q < 8; ++q) { const float4 v = bb[q]; br[2 * q] = v.x; bi[2 * q] = v.y; br[2 * q + 1] = v.z; bi[2 * q + 1] = v.w; }
        }
        const size_t sidx = ((size_t)((b * 2 + dir) * NCHUNK + k) * 16 + g) * 64 + lane;
        float hr = 0.f, hi = 0.f;
        bf16x8 cfr[4];
        if (FINAL) {
            const float2 s0 = ((const float2*)(p.ws + OFF_S))[sidx];
            hr = s0.x; hi = s0.y;
            const bf16_t* cc = (const bf16_t*)(p.ws + OFF_CC) + (size_t)((l * 2 + dir) * 16 + g) * 2048 + (lane & 15) * 128 + (lane >> 4) * 8;
#pragma unroll
            for (int ks = 0; ks < 4; ++ks) cfr[ks] = *(const bf16x8*)(cc + 32 * ks);
        }
#pragma unroll
        for (int s = 0; s < 4; ++s) {
            const int sb = dir ? 3 - s : s;
#pragma unroll 1
            for (int tt = 0; tt < 16; ++tt) {
                const int tl = dir ? 15 - tt : tt, t = sb * 16 + tl;
                const float4* up = (const float4*)(Us + t * 16);
                float ar = 0.f, ai = 0.f;
#pragma unroll
                for (int q = 0; q < 4; ++q) {
                    const float4 u = up[q];
                    ar += br[4 * q] * u.x + br[4 * q + 1] * u.y + br[4 * q + 2] * u.z + br[4 * q + 3] * u.w;
                    ai += bi[4 * q] * u.x + bi[4 * q + 1] * u.y + bi[4 * q + 2] * u.z + bi[4 * q + 3] * u.w;
                }
                const float nr = lam.x * hr - lam.y * hi + ar, ni = lam.x * hi + lam.y * hr + ai;
                hr = nr; hi = ni;
                if (FINAL) { Hs[tl * 136 + lane] = f2bf(hr); Hs[tl * 136 + 64 + lane] = f2bf(hi); }
            }
            if (FINAL) {
                __syncthreads();
                const bf16_t* hp = Hs + (lane & 15) * 136 + (lane >> 4) * 8;
#pragma unroll
                for (int ks = 0; ks < 4; ++ks) { const bf16x8 a = *(const bf16x8*)(hp + 32 * ks); yacc[sb] = MFMA16(a, cfr[ks], yacc[sb]); }
                __syncthreads();
            }
        }
        if (!FINAL) ((float2*)(p.ws + OFF_E))[sidx] = make_float2(hr, hi);
    }
    if (FINAL) {
        bf16_t* S5P = (bf16_t*)(p.ws + OFF_S5P);
        const int hcol = lane & 15;
        const float dg = p.in[20][l * 256 + g * 16 + hcol];
#pragma unroll
        for (int s = 0; s < 4; ++s)
#pragma unroll
            for (int j = 0; j < 4; ++j) {
                const int t = s * 16 + (lane >> 4) * 4 + j;
                const float y = yacc[s][j] + dg * Us[t * 16 + hcol];
                S5P[(size_t)(rbase + t) * 256 + g * 16 + hcol] = f2bf(gelu_tanh(y));
            }
    }
    __syncthreads();
}

DI void s5_carry(const KP& p, int l, int blk) {
    const int idx = blk * 256 + TIDX();
    const int gp = idx & 1023, dir = (idx >> 10) & 1, b = idx >> 11;
    const float4 lam = ((const float4*)(p.ws + OFF_LAMB))[(l * 2 + dir) * 1024 + gp];
    const float2* E = (const float2*)(p.ws + OFF_E) + (size_t)(b * 2 + dir) * NCHUNK * 1024 + gp;
    float2* S = (float2*)(p.ws + OFF_S) + (size_t)(b * 2 + dir) * NCHUNK * 1024 + gp;
    float sr = 0.f, si = 0.f;
    for (int j0 = 0; j0 < NCHUNK; j0 += 4) {
        const int k0 = dir ? (j0 < 4 ? 3 - j0 : 263 - j0) : j0, stp = dir ? -1 : 1;
        const float2 e0 = E[(size_t)k0 * 1024], e1 = E[(size_t)(k0 + stp) * 1024], e2 = E[(size_t)(k0 + 2 * stp) * 1024], e3 = E[(size_t)(k0 + 3 * stp) * 1024];
        float nr, ni;
        S[(size_t)k0 * 1024] = make_float2(sr, si);
        nr = lam.z * sr - lam.w * si + e0.x; ni = lam.z * si + lam.w * sr + e0.y; sr = nr; si = ni;
        S[(size_t)(k0 + stp) * 1024] = make_float2(sr, si);
        nr = lam.z * sr - lam.w * si + e1.x; ni = lam.z * si + lam.w * sr + e1.y; sr = nr; si = ni;
        S[(size_t)(k0 + 2 * stp) * 1024] = make_float2(sr, si);
        nr = lam.z * sr - lam.w * si + e2.x; ni = lam.z * si + lam.w * sr + e2.y; sr = nr; si = ni;
        S[(size_t)(k0 + 3 * stp) * 1024] = make_float2(sr, si);
        nr = lam.z * sr - lam.w * si + e3.x; ni = lam.z * si + lam.w * sr + e3.y; sr = nr; si = ni;
    }
}

DI void attn_item(const KP& p, int it, char* smem) {
    const bf16_t* Q = (const bf16_t*)(p.ws + OFF_Q);
    const bf16_t* Kg = (const bf16_t*)(p.ws + OFF_K);
    const bf16_t* Vg = (const bf16_t*)(p.ws + OFF_VT);
    bf16_t* MIX = (bf16_t*)(p.ws + OFF_MIX);
    const int tid = TIDX(), lane = tid & 63, wave = tid >> 6, l31 = lane & 31, hh = lane >> 5;
    int bh, qrow0, kt0, T;
    if (it < 1024) { bh = it >> 6; qrow0 = (bh >> 3) * SEQ + (it & 63) * 256; kt0 = 0; T = NCHUNK; }
    else { bh = it - 1024; qrow0 = NL + (bh >> 3) * CTXL; kt0 = SEQ / 64; T = CTXL / 64; }
    const int head = bh & 7;
    const bf16_t* Kb = Kg + (size_t)bh * LK * DK + (size_t)kt0 * 64 * DK;
    const bf16_t* Vb = Vg + (size_t)bh * 64 * LK + kt0 * 64;
    bf16_t* sK = (bf16_t*)smem;
    bf16_t* sV = sK + 2 * 64 * 104;
    const int qrow = qrow0 + wave * 64 + l31;
    bf16x8 qf[2][6];
#pragma unroll
    for (int qb = 0; qb < 2; ++qb)
#pragma unroll
        for (int s = 0; s < 6; ++s) qf[qb][s] = *(const bf16x8*)(Q + (size_t)(qrow + 32 * qb) * 768 + head * 96 + 16 * s + 8 * hh);
    f32x16 o[2][2];
#pragma unroll
    for (int i = 0; i < 16; ++i) { o[0][0][i] = 0.f; o[0][1][i] = 0.f; o[1][0][i] = 0.f; o[1][1][i] = 0.f; }
    float m_run[2] = {-1e30f, -1e30f}, l_run[2] = {0.f, 0.f};
    u32x4 rk0, rk1, rk2, rv0, rv1;
    const int vrow = tid >> 3, vcol = (tid & 7) * 8;
    const int kw0 = (tid / 12) * 104 + (tid % 12) * 8, kw1 = ((tid + 256) / 12) * 104 + ((tid + 256) % 12) * 8, kw2 = ((tid + 512) / 12) * 104 + ((tid + 512) % 12) * 8;
    const bf16_t* cK = sK + l31 * 104 + 8 * hh;
    const bf16_t* cV = sV + l31 * 72 + 8 * hh;
#define ATT_KWRITE(buf_) do { bf16_t* k_ = sK + (buf_) * 64 * 104; *(u32x4*)(k_ + kw0) = rk0; *(u32x4*)(k_ + kw1) = rk1; *(u32x4*)(k_ + kw2) = rk2; } while (0)
#define ATT_VWRITE(buf_) do { bf16_t* v_ = sV + (buf_) * 64 * 72 + vrow * 72 + vcol; *(u32x4*)(v_) = rv0; *(u32x4*)(v_ + 32 * 72) = rv1; } while (0)
    {
        const bf16_t* kp = Kb + tid * 8;
        rk0 = *(const u32x4*)(kp); rk1 = *(const u32x4*)(kp + 2048); rk2 = *(const u32x4*)(kp + 4096);
        const bf16_t* vp = Vb + (size_t)vrow * LK + vcol;
        rv0 = *(const u32x4*)(vp); rv1 = *(const u32x4*)(vp + (size_t)32 * LK);
        ATT_KWRITE(0); ATT_VWRITE(0);
    }
    __syncthreads();
    for (int t = 0; t < T; ++t) {
        const int buf = t & 1;
        const bool more = (t + 1) < T;
        if (more) {
            const bf16_t* kp_ = Kb + (size_t)(t + 1) * 64 * DK + tid * 8; gld16(rk0, kp_); gld16(rk1, kp_ + 2048); gld16(rk2, kp_ + 4096);
            const bf16_t* vp_ = Vb + (size_t)vrow * LK + (t + 1) * 64 + vcol; gld16(rv0, vp_); gld16(rv1, vp_ + (size_t)32 * LK);
        }
#pragma unroll
        for (int kb = 0; kb < 2; ++kb) {
            f32x16 s[2];
#pragma unroll
            for (int i = 0; i < 16; ++i) { s[0][i] = 0.f; s[1][i] = 0.f; }
            bf16x8 kf[6];
#pragma unroll
            for (int ks = 0; ks < 6; ++ks) kf[ks] = *(const bf16x8*)(cK + buf * 64 * 104 + kb * 32 * 104 + 16 * ks);
            __builtin_amdgcn_sched_barrier(0);
            __builtin_amdgcn_s_setprio(1);
#pragma unroll
            for (int ks = 0; ks < 6; ++ks) {
                s[0] = MFMA32(kf[ks], qf[0][ks], s[0]);
                s[1] = MFMA32(kf[ks], qf[1][ks], s[1]);
            }
            __builtin_amdgcn_s_setprio(0);
#pragma unroll
            for (int qb = 0; qb < 2; ++qb) {
                float mx = s[qb][0];
#pragma unroll
                for (int i = 1; i < 16; ++i) mx = fmaxf(mx, s[qb][i]);
                mx = xhalf_max(mx);
                const float m_new = fmaxf(m_run[qb], mx);
                if (__builtin_amdgcn_ballot_w64(m_new > m_run[qb]) != 0ull) {
                    const float alpha = __builtin_amdgcn_exp2f(m_run[qb] - m_new);
                    m_run[qb] = m_new; l_run[qb] *= alpha;
#pragma unroll
                    for (int i = 0; i < 16; ++i) { o[qb][0][i] *= alpha; o[qb][1][i] *= alpha; }
                }
                float ps = 0.f;
#pragma unroll
                for (int i = 0; i < 16; ++i) { s[qb][i] = __builtin_amdgcn_exp2f(s[qb][i] - m_run[qb]); ps += s[qb][i]; }
                l_run[qb] += ps;
            }
            bf16x8 vf[2][2];
#pragma unroll
            for (int u = 0; u < 2; ++u)
#pragma unroll
                for (int dvb = 0; dvb < 2; ++dvb) vf[u][dvb] = *(const bf16x8*)(cV + buf * 64 * 72 + dvb * 32 * 72 + 32 * kb + 16 * u);
            __builtin_amdgcn_sched_barrier(0);
#pragma unroll
            for (int u = 0; u < 2; ++u) {
                const bf16x8 p0 = __builtin_bit_cast(bf16x8, u32x4{pack2(s[0][8 * u], s[0][8 * u + 1]), pack2(s[0][8 * u + 2], s[0][8 * u + 3]), pack2(s[0][8 * u + 4], s[0][8 * u + 5]), pack2(s[0][8 * u + 6], s[0][8 * u + 7])});
                const bf16x8 p1 = __builtin_bit_cast(bf16x8, u32x4{pack2(s[1][8 * u], s[1][8 * u + 1]), pack2(s[1][8 * u + 2], s[1][8 * u + 3]), pack2(s[1][8 * u + 4], s[1][8 * u + 5]), pack2(s[1][8 * u + 6], s[1][8 * u + 7])});
                __builtin_amdgcn_s_setprio(1);
#pragma unroll
                for (int dvb = 0; dvb < 2; ++dvb) {
                    o[0][dvb] = MFMA32(vf[u][dvb], p0, o[0][dvb]);
                    o[1][dvb] = MFMA32(vf[u][dvb], p1, o[1][dvb]);
                }
                __builtin_amdgcn_s_setprio(0);
            }
        }
        if (more) { vm_wait5(rk0, rk1, rk2, rv0, rv1); ATT_KWRITE(buf ^ 1); ATT_VWRITE(buf ^ 1); }
        __syncthreads();
    }
#undef ATT_KWRITE
#undef ATT_VWRITE
#pragma unroll
    for (int qb = 0; qb < 2; ++qb) {
        const float lt = xhalf_sum(l_run[qb]);
        const float inv = 1.f / lt;
#pragma unroll
        for (int dvb = 0; dvb < 2; ++dvb)
#pragma unroll
            for (int q = 0; q < 4; ++q) {
                uint2 ov; ov.x = pack2(o[qb][dvb][4 * q] * inv, o[qb][dvb][4 * q + 1] * inv); ov.y = pack2(o[qb][dvb][4 * q + 2] * inv, o[qb][dvb][4 * q + 3] * inv);
                *(uint2*)(MIX + (size_t)(qrow + 32 * qb) * DMIX + 768 + head * 64 + 32 * dvb + 8 * q + 4 * hh) = ov;
            }
    }
}

PH_FN void misc_phase(const KP& p, int l, char* smem) {
    const int n_qkv = 260 * 14, n_cp = l == 1 ? 1024 : 1040, n_s5 = 2 * NCHUNK * 4;
    const int rot = (blockIdx.x + gridDim.x / 2) % gridDim.x;
    for (int it = vblock(); it < n_qkv; it += gridDim.x) qkv_item(p, l, it, smem);
    for (int it = rot; it < n_cp; it += gridDim.x) convpool_item(p, l, it, smem);
    for (int it = blockIdx.x; it < n_s5; it += gridDim.x) s5_item<false>(p, l, it, smem);
#if MISC_DUP == 1
    for (int it = vblock(); it < n_qkv; it += gridDim.x) qkv_item(p, l, it, smem);
#elif MISC_DUP == 2
    for (int it = rot; it < n_cp; it += gridDim.x) convpool_item(p, l, it, smem);
#elif MISC_DUP == 3
    for (int it = blockIdx.x; it < n_s5; it += gridDim.x) s5_item<false>(p, l, it, smem);
#endif
}
PH_FN void attn_phase(const KP& p, int l, char* smem) {
    const int n_att = l == 1 ? 1024 : 1024 + 16;
    if (blockIdx.x < 16) s5_carry(p, l, blockIdx.x);
    for (int it = vblock(); it < n_att; it += gridDim.x) attn_item(p, it, smem);
}
PH_FN void s5fin_phase(const KP& p, int l, char* smem) {
    for (int it = blockIdx.x; it < 2 * NCHUNK * 4; it += gridDim.x) s5_item<true>(p, l, it, smem);
}

DI void run_phase(const KP& p, int ph, char* smem) {
    if (ph == 0) { prep_phase(p, smem); return; }
    if (ph == 27) {
        rowop_phase(p, 1, 8, 0.5f, p.in[7] + (1 * 3 + 2) * D, true, 0, 0, nullptr, false, false, NL);
        return;
    }
    const int l = (ph - 1) / 13, s = (ph - 1) % 13;
    const bf16_t* Wl = (const bf16_t*)(p.ws + OFF_W) + (size_t)l * WL_EL;
    const float* npre = p.in[6] + (size_t)l * 3 * D;
    const float* npost = p.in[7] + (size_t)l * 3 * D;
    const bool lastl = l == 1;
    switch (s) {
    case 0:
        if (l == 0) rowop_phase(p, 0, 0, 0.f, nullptr, false, 0, 0, npre, true, true);
        else rowop_phase(p, l - 1, 8, 0.5f, p.in[7] + ((l - 1) * 3 + 2) * D, true, l, 0, npre, true, false);
        break;
    case 1: case 11: gemm1_phase(p, l, s == 11, smem, (lastl && s == 11) ? NL / 256 : NT / 256); break;
    case 2: case 9: case 12: {
        const bool isout = s == 9;
        const bf16_t* Ag = (const bf16_t*)(p.ws + (isout ? OFF_MIX : OFF_ACT));
        const bf16_t* Wg = Wl + (isout ? WO_OUT : (s == 12 ? WO_D1 : WO_D0));
        const int Kg = isout ? DMIX : FF;
        gemm_store_phase256<D>(Ag, Kg, Wg, Kg, 8, (bf16_t*)(p.ws + OFF_HY), smem, NL / 256, (lastl && s != 2) ? 0 : NC / 128);
    } break;
    case 3: rowop_phase(p, l, 2, 0.5f, npost, true, l, 3, npre + D, true, l == 0); break;
    case 4: gemm_store_phase256<DIN>((const bf16_t*)(p.ws + OFF_HY), D, Wl + WO_IN, D, 12, (bf16_t*)(p.ws + OFF_Z), smem, NL / 256, NC / 128); break;
    case 5: misc_phase(p, l, smem); break;
    case 6: attn_phase(p, l, smem); break;
    case 7: s5fin_phase(p, l, smem); break;
    case 8: glu_phase(p, l, smem); break;
    case 10: rowop_phase(p, l, 5, 1.0f, npost + D, true, l, 6, npre + 2 * D, true, false, lastl ? NL : NT); break;
    }
}

constexpr int N_PHASES = 28;

__global__ void __launch_bounds__(256, 2) mega_kernel(KP p, int ph_lo, int ph_hi) {
    __shared__ __attribute__((aligned(16))) char smem[65536];
    __shared__ KP s_kp;
    if (TIDX() < 33) s_kp.in[TIDX()] = p.in[TIDX()];
    if (TIDX() == 33) s_kp.out = p.out;
    if (TIDX() == 34) s_kp.ws = p.ws;
    __shared__ uint4 xb_words;
    if (TIDX() == 0) xb_words = make_uint4(0u, 0u, 0u, 0u);
    __syncthreads();
    XcdBarrier xb = xcd_barrier_post((unsigned*)(p.ws + OFF_BAR), (volatile LAS unsigned*)&xb_words);
    for (int ph = ph_lo; ph < ph_hi; ++ph) {
        run_phase(p, ph, smem);
        if (DUP_MASK) {
            const int sbit = ph == 0 ? 13 : (ph == 27 ? 14 : (ph - 1) % 13);
            if ((DUP_MASK >> sbit) & 1) { xcd_barrier(xb); run_phase(p, ph, smem); }
        }
#if PROBE_MODE
        {
            const int sb = ph == 0 || ph == 27 ? -1 : (ph - 1) % 13, pl = (ph - 1) / 13;
            const bf16_t* Wl = (const bf16_t*)(s_kp.ws + OFF_W) + (size_t)pl * WL_EL;
            if (sb == 1 || sb == 11) { cg::this_grid().sync(); gemm1_phase<PROBE_MODE>(s_kp, pl, sb == 11, smem); }
            if (sb == 2 || sb == 12) { cg::this_grid().sync(); gemm_store_phase<PROBE_MODE>((const bf16_t*)(s_kp.ws + OFF_ACT), FF, Wl + (sb == 12 ? WO_D1 : WO_D0), FF, 8, (bf16_t*)(s_kp.ws + OFF_HY), D, D, smem); }
        }
#endif
        if (EXTRA_SYNCS) { xcd_barrier(xb); xcd_barrier(xb); }
        if (ph + 1 < ph_hi) { if (ph_hi < 0) cg::this_grid().sync(); else xcd_barrier(xb); }
    }
}

extern "C" void kernel_launch(void* const* d_in, const int* in_sizes, int n_in, void* d_out, int out_size, void* d_ws, size_t ws_size, hipStream_t stream) {
    static int grid = 0;
    if (grid == 0) {
        if (n_in != 33 || ws_size < WS_END) { fprintf(stderr, "kernel_launch: unexpected n_in %d or ws_size %zu < %zu\n", n_in, ws_size, (size_t)WS_END); grid = -1; return; }
        int dev = 0, cus = 0, per_cu = 0;
        hipGetDevice(&dev);
        hipDeviceGetAttribute(&cus, hipDeviceAttributeMultiprocessorCount, dev);
        hipOccupancyMaxActiveBlocksPerMultiprocessor(&per_cu, (const void*)mega_kernel, 256, 0);
        if (per_cu < 1) per_cu = 1;
        if (per_cu > 2) per_cu = 2;
        grid = cus * per_cu;
    }
    if (grid < 0) return;
    KP p{};
    for (int i = 0; i < 33; ++i) p.in[i] = (const float*)d_in[i];
    p.out = (float*)d_out; p.ws = (char*)d_ws;
    if (hipMemsetAsync((char*)d_ws + OFF_BAR, 0, 3456 * 4, stream) != hipSuccess) { fprintf(stderr, "kernel_launch: memset of barrier words failed\n"); return; }
#if ONE_LAUNCH
    int lo = 0, hi = N_PHASES;
    void* args[] = {&p, &lo, &hi};
    hipError_t e = hipLaunchCooperativeKernel((const void*)mega_kernel, dim3(grid), dim3(256), args, 0, stream);
    if (e != hipSuccess) fprintf(stderr, "cooperative launch failed: %s (grid %d)\n", hipGetErrorString(e), grid);
#else
    for (int ph = 0; ph < N_PHASES; ++ph) hipLaunchKernelGGL(mega_kernel, dim3(grid), dim3(256), 0, stream, p, ph, ph + 1);
#endif
}
```

```cpp
#include <hip/hip_runtime.h>
#include <hip/hip_cooperative_groups.h>
#include <cstdio>
#include <cstdint>
namespace cg = cooperative_groups;

#ifndef ONE_LAUNCH
#define ONE_LAUNCH 1
#endif
#define PROBE_MODE 0
#define EXTRA_SYNCS 0
#define MISC_DUP 0
#define ATT_PROBE 0
#define DUP_MASK 0

#define DI __device__ __forceinline__
#define PH_FN __device__ __forceinline__
typedef unsigned short bf16_t;
using bf16x8 = __attribute__((ext_vector_type(8))) short;
using f32x16 = __attribute__((ext_vector_type(16))) float;
using f32x4 = __attribute__((ext_vector_type(4))) float;
typedef unsigned u32x4 __attribute__((ext_vector_type(4)));
typedef __bf16 bf16x2_t __attribute__((ext_vector_type(2)));
typedef float f2_t __attribute__((ext_vector_type(2)));

constexpr int D = 1024, SEQ = 16384, NB = 2, CTXL = 256;
constexpr int NL = NB * SEQ, NC = NB * CTXL, NT = NL + NC;
constexpr int FF = 2816, DIN = 1440, DMIX = 1280;
constexpr int NH = 8, DK = 96, LK = SEQ + CTXL;
constexpr int IN_CONV = 256, IN_POOL = 768, IN_CQ = 1024, IN_CKV = 1280, IN_KR = 1408;
constexpr int NCHUNK = LK / 64;
constexpr float EPS = 1e-6f;
constexpr float QSCALE = 0.10206207261596575f * 1.4426950408889634f;

constexpr size_t EL_GU = 5632ull * 1024, EL_D = 1024ull * 2816, EL_IN = 1536ull * 1024, EL_OUT = 1024ull * 1280,
                 EL_UQ = 768ull * 256, EL_UKV = 1024ull * 128, EL_GLU = 256ull * 256;
constexpr size_t WO_GU0 = 0, WO_GU1 = EL_GU, WO_D0 = 2 * EL_GU, WO_D1 = WO_D0 + EL_D, WO_IN = WO_D1 + EL_D,
                 WO_OUT = WO_IN + EL_IN, WO_UQ = WO_OUT + EL_OUT, WO_UKV = WO_UQ + EL_UQ, WO_GLU = WO_UKV + EL_UKV,
                 WL_EL = WO_GLU + EL_GLU;
constexpr size_t al256(size_t x) { return (x + 255) & ~(size_t)255; }
constexpr size_t OFF_W = 0;
constexpr size_t OFF_MOD = al256(OFF_W + 2 * WL_EL * 2);
constexpr size_t OFF_ROPE = al256(OFF_MOD + 2ull * 3 * 9216 * 4);
constexpr size_t OFF_LAMB = al256(OFF_ROPE + 256ull * 8 * 2 * 4);
constexpr size_t OFF_BBAR = al256(OFF_LAMB + 2ull * 2048 * 16);
constexpr size_t OFF_CC = al256(OFF_BBAR + 2ull * 2048 * 32 * 4);
constexpr size_t OFF_XC = al256(OFF_CC + 2ull * 32 * 2048 * 2);
constexpr size_t OFF_HY = al256(OFF_XC + (size_t)NC * D * 4);
constexpr size_t OFF_BIG = al256(OFF_HY + (size_t)NT * D * 2);
constexpr size_t OFF_ACT = OFF_BIG;
constexpr size_t OFF_Z = OFF_BIG;
constexpr size_t OFF_Q = al256(OFF_Z + (size_t)NT * DIN * 2);
constexpr size_t OFF_K = al256(OFF_Q + (size_t)NT * 768 * 2);
constexpr size_t OFF_VT = al256(OFF_K + (size_t)NB * NH * LK * 96 * 2);
constexpr size_t OFF_MIX = al256(OFF_VT + (size_t)NB * NH * 64 * LK * 2);
constexpr size_t OFF_S5P = al256(OFF_MIX + (size_t)NT * DMIX * 2);
constexpr size_t OFF_E = al256(OFF_S5P + (size_t)NT * 256 * 2);
constexpr size_t OFF_S = al256(OFF_E + 2ull * 2 * NCHUNK * 1024 * 8);
constexpr size_t OFF_BAR = al256(OFF_S + 2ull * 2 * NCHUNK * 1024 * 8);
constexpr size_t WS_END = al256(OFF_BAR + 3456 * 4);
static_assert(OFF_ACT + (size_t)NT * FF * 2 <= WS_END, "act fits");

struct KP { const float* in[33]; float* out; char* ws; };

DI int TIDX() { int t = threadIdx.x; asm volatile("" : "+v"(t)); return t; }
DI float bf2f(bf16_t b) { return __uint_as_float((unsigned)b << 16); }
DI unsigned pack2(float a, float b) { f2_t v = {a, b}; bf16x2_t r = __builtin_convertvector(v, bf16x2_t); return __builtin_bit_cast(unsigned, r); }
DI bf16_t f2bf(float a) { return (bf16_t)(pack2(a, 0.f) & 0xffffu); }
DI float fast_exp(float x) { return __builtin_amdgcn_exp2f(x * 1.4426950408889634f); }
DI float sigmoidf_(float x) { return __builtin_amdgcn_rcpf(1.f + fast_exp(-x)); }
DI float siluf_(float x) { return x * sigmoidf_(x); }
DI float gelu_tanh(float x) { float u = 0.7978845608028654f * (x + 0.044715f * x * x * x); float t = 1.f - 2.f * __builtin_amdgcn_rcpf(1.f + fast_exp(2.f * u)); return 0.5f * x * (1.f + t); }
DI float shflx(float v, int m) { const int idx = ((TIDX() & 63) ^ m) << 2; return __int_as_float(__builtin_amdgcn_ds_bpermute(idx, __float_as_int(v))); }
DI float xhalf_max(float v) { const auto r = __builtin_amdgcn_permlane32_swap(__float_as_uint(v), __float_as_uint(v), false, false); return fmaxf(__uint_as_float(r[0]), __uint_as_float(r[1])); }
DI float xhalf_sum(float v) { const auto r = __builtin_amdgcn_permlane32_swap(__float_as_uint(v), __float_as_uint(v), false, false); return __uint_as_float(r[0]) + __uint_as_float(r[1]); }
DI float wave_sum(float v) { for (int m = 32; m >= 1; m >>= 1) v += shflx(v, m); return v; }
DI int crow(int i, int hh) { return (i & 3) + 8 * (i >> 2) + 4 * hh; }
DI int row_mod(int row) { return row < NL ? (row >= SEQ ? 1 : 0) : 2; }
DI int vblock() { const int G = gridDim.x, b = blockIdx.x; return (G & 7) ? b : (G >> 3) * (b & 7) + (b >> 3); }
DI void tile_mn(int it, int TM, int TN, int& mt, int& nt) {
    const int band = it / (8 * TN), within = it - band * 8 * TN;
    const int gm = min(8, TM - 8 * band);
    nt = within / gm; mt = 8 * band + (within - nt * gm);
}
DI void gld16(u32x4& r, const void* p) { asm volatile("global_load_dwordx4 %0, %1, off" : "=&v"(r) : "v"(p) : "memory"); }
DI void vm_wait8(u32x4& a, u32x4& b, u32x4& c, u32x4& d, u32x4& e, u32x4& f, u32x4& g, u32x4& h) {
    asm volatile("s_waitcnt vmcnt(0)" : "+v"(a), "+v"(b), "+v"(c), "+v"(d), "+v"(e), "+v"(f), "+v"(g), "+v"(h) : : "memory"); }
DI void vm_wait5(u32x4& a, u32x4& b, u32x4& c, u32x4& d, u32x4& e) {
    asm volatile("s_waitcnt vmcnt(0)" : "+v"(a), "+v"(b), "+v"(c), "+v"(d), "+v"(e) : : "memory"); }
#define MFMA32(a, b, c) __builtin_amdgcn_mfma_f32_32x32x16_bf16((a), (b), (c), 0, 0, 0)
#define MFMA16(a, b, c) __builtin_amdgcn_mfma_f32_16x16x32_bf16((a), (b), (c), 0, 0, 0)

#define XB_TMO      128
#define XB_XCNT(j)  (256  + 64 * (j))
#define XB_XSUB(j)  (1280 + 64 * (j))
#define XB_XGEN(j)  (2304 + 64 * (j))
#define XB_TOP      3328
#define XB_TOPGEN   3392
#define XCD_BAR_WORDS 3456
#define XB_SPIN_CAP (1u << 18)
#define LAS __attribute__((address_space(3)))

__device__ __forceinline__ unsigned xb_ld(unsigned* p)              { return __hip_atomic_load(p, __ATOMIC_RELAXED, __HIP_MEMORY_SCOPE_AGENT); }
__device__ __forceinline__ unsigned xb_add(unsigned* p, unsigned v) { return __hip_atomic_fetch_add(p, v, __ATOMIC_RELAXED, __HIP_MEMORY_SCOPE_AGENT); }
__device__ __forceinline__ unsigned xb_xcc_id() { return (unsigned)__builtin_amdgcn_s_getreg((3 << 11) | 20) & 0xFu; }
#define XB_SPIN(cond, bar) do { unsigned _sp = 0; while (cond) { __builtin_amdgcn_s_sleep(1); \
    if ((++_sp & 255u) == 0u) { if (xb_ld(&(bar)[XB_TMO])) break; if (_sp > XB_SPIN_CAP) { atomicAdd(&(bar)[XB_TMO], 1u); break; } } } } while (0)

struct XcdBarrier {
    unsigned* bar; unsigned x;
    volatile LAS unsigned* st;
};

__device__ __forceinline__ XcdBarrier xcd_barrier_post(unsigned* bar, volatile LAS unsigned* st) {
    XcdBarrier b; b.bar = bar; b.x = xb_xcc_id(); b.st = st;
    if (TIDX() == 0) (void)xb_add(&bar[XB_XCNT(b.x)], 1u);
    return b;
}
__device__ __forceinline__ void xcd_barrier_complete(unsigned* bar, unsigned x, unsigned& nloc, unsigned& nx) {
    const unsigned G = gridDim.x * gridDim.y * gridDim.z;
    unsigned sum, cnt, mine, sp = 0u;
    for (;;) {
        sum = 0u; cnt = 0u; mine = 0u;
#pragma unroll
        for (unsigned j = 0; j < 16; ++j) { const unsigned c = xb_ld(&bar[XB_XCNT(j)]); sum += c; cnt += (c > 0u) ? 1u : 0u; mine = (j == x) ? c : mine; }
        if (sum == G) break;
        __builtin_amdgcn_s_sleep(1);
        if ((++sp & 255u) == 0u) { if (xb_ld(&bar[XB_TMO])) break; if (sp > XB_SPIN_CAP) { atomicAdd(&bar[XB_TMO], 1u); break; } }
    }
    nloc = mine > 0u ? mine : 1u; nx = cnt > 0u ? cnt : 1u;
}

__device__ __forceinline__ void xcd_barrier(const XcdBarrier& b) {
    asm volatile("s_waitcnt vmcnt(0)" ::: "memory");
    __syncthreads();
    if (TIDX() == 0) {
        unsigned* bar = b.bar;
        __builtin_amdgcn_s_waitcnt(0);
        unsigned nloc = b.st[0], nx = b.st[1];
        if (nloc == 0u) { xcd_barrier_complete(bar, b.x, nloc, nx); b.st[0] = nloc; b.st[1] = nx; }
        const unsigned old = xb_add(&bar[XB_XSUB(b.x)], 1u);
        const unsigned gen = old / nloc;
        if (old + 1u == (gen + 1u) * nloc) {
            __builtin_amdgcn_fence(__ATOMIC_RELEASE, "agent");
            asm volatile("s_waitcnt vmcnt(0)" ::: "memory");
            const unsigned og = xb_add(&bar[XB_TOP], 1u);
            const unsigned tg = og / nx;
            if (og + 1u == (tg + 1u) * nx) xb_add(&bar[XB_TOPGEN], 1u);
            else XB_SPIN(xb_ld(&bar[XB_TOPGEN]) == tg, bar);
            __builtin_amdgcn_fence(__ATOMIC_ACQUIRE, "agent");
            xb_add(&bar[XB_XGEN(b.x)], 1u);
            asm volatile("s_waitcnt vmcnt(0)" ::: "memory");
        } else {
            XB_SPIN(xb_ld(&bar[XB_XGEN(b.x)]) == gen, bar);
            __builtin_amdgcn_fence(__ATOMIC_ACQUIRE, "agent");
            asm volatile("s_waitcnt vmcnt(0)" ::: "memory");
        }
    }
    __syncthreads();
}


DI void vm_wait_sel(u32x4& a, u32x4& b, u32x4& c, u32x4& d, u32x4& e, u32x4& f, u32x4& g, u32x4& h, int all) {
    asm volatile("s_cmp_lg_u32 %8, 0\n\ts_cbranch_scc1 1f\n\ts_waitcnt vmcnt(8)\n\ts_branch 2f\n1:\n\ts_waitcnt vmcnt(0)\n2:"
                 : "+v"(a), "+v"(b), "+v"(c), "+v"(d), "+v"(e), "+v"(f), "+v"(g), "+v"(h) : "s"(all) : "memory", "scc"); }

template <int MODE = 0, class Epi>
DI void gemm_tile(const bf16_t* __restrict__ A, int lda, const bf16_t* __restrict__ Bt, int ldb, int K, int row0, int col0, char* smem, Epi&& epi) {
    bf16_t* sA = (bf16_t*)smem;
    bf16_t* sB = sA + 2 * 8192;
    const int tid = TIDX(), lane = tid & 63, wave = tid >> 6;
    const int wm = wave >> 1, wn = wave & 1, l31 = lane & 31, hh = lane >> 5;
    u32x4 r0a[4], r0b[4], r1a[4], r1b[4];
    const bf16_t* Ap = A + (size_t)(row0 + (tid >> 3)) * lda + (tid & 7) * 8;
    const bf16_t* Bp = Bt + (size_t)(col0 + (tid >> 3)) * ldb + (tid & 7) * 8;
    const int wr_off = (tid >> 3) * 64 + (((tid & 7) ^ ((tid >> 4) & 7)) * 8);
    f32x16 acc[2][2];
#pragma unroll
    for (int a = 0; a < 2; ++a)
#pragma unroll
        for (int b = 0; b < 2; ++b)
#pragma unroll
            for (int i = 0; i < 16; ++i) acc[a][b][i] = 0.f;
    const int nk = K >> 6;
#pragma unroll
    for (int i = 0; i < 4; ++i) { r0a[i] = *(const u32x4*)(Ap + (size_t)i * 32 * lda); r0b[i] = *(const u32x4*)(Bp + (size_t)i * 32 * ldb); }
#pragma unroll
    for (int i = 0; i < 4; ++i) { *(u32x4*)(sA + wr_off + i * 2048) = r0a[i]; *(u32x4*)(sB + wr_off + i * 2048) = r0b[i]; }
#pragma unroll
    for (int i = 0; i < 4; ++i) { gld16(r1a[i], Ap + (size_t)i * 32 * lda + 64); gld16(r1b[i], Bp + (size_t)i * 32 * ldb + 64); }
    __syncthreads();
    const int sw = (l31 >> 1) & 7;
    const bf16_t* cA = sA + (wm * 64 + l31) * 64;
    const bf16_t* cB = sB + (wn * 64 + l31) * 64;
#define GEMM_LDFRAG(buf_, ks_, a0_, a1_, b0_, b1_) do { const int ch = ((2 * (ks_) + hh) ^ sw) * 8; \
            a0_ = *(const bf16x8*)(cA + (buf_) * 8192 + ch); a1_ = *(const bf16x8*)(cA + (buf_) * 8192 + 32 * 64 + ch); \
            b0_ = *(const bf16x8*)(cB + (buf_) * 8192 + ch); b1_ = *(const bf16x8*)(cB + (buf_) * 8192 + 32 * 64 + ch); } while (0)
#define GEMM_MMA(a0_, a1_, b0_, b1_) do { acc[0][0] = MFMA32(a0_, b0_, acc[0][0]); acc[0][1] = MFMA32(a0_, b1_, acc[0][1]); \
            acc[1][0] = MFMA32(a1_, b0_, acc[1][0]); acc[1][1] = MFMA32(a1_, b1_, acc[1][1]); } while (0)
#define SB_ __builtin_amdgcn_sched_barrier(0)
#define GEMM_COMPUTE(buf_) do { bf16x8 pa0, pa1, pb0, pb1, qa0, qa1, qb0, qb1; \
            GEMM_LDFRAG(buf_, 0, pa0, pa1, pb0, pb1); GEMM_LDFRAG(buf_, 1, qa0, qa1, qb0, qb1); SB_; GEMM_MMA(pa0, pa1, pb0, pb1); SB_; \
            GEMM_LDFRAG(buf_, 2, pa0, pa1, pb0, pb1); SB_; GEMM_MMA(qa0, qa1, qb0, qb1); SB_; \
            GEMM_LDFRAG(buf_, 3, qa0, qa1, qb0, qb1); SB_; GEMM_MMA(pa0, pa1, pb0, pb1); SB_; GEMM_MMA(qa0, qa1, qb0, qb1); SB_; } while (0)
    for (int kt = 0; kt < nk; kt += 2) {
        const bool m2 = (kt + 2) < nk, m3 = (kt + 3) < nk;
        if (m2 && MODE == 0) {
            const int k0 = (kt + 2) << 6;
#pragma unroll
            for (int i = 0; i < 4; ++i) { gld16(r0a[i], Ap + (size_t)i * 32 * lda + k0); gld16(r0b[i], Bp + (size_t)i * 32 * ldb + k0); }
        }
        GEMM_COMPUTE(0);
        vm_wait_sel(r1a[0], r1a[1], r1a[2], r1a[3], r1b[0], r1b[1], r1b[2], r1b[3], __builtin_amdgcn_readfirstlane((m2 && MODE == 0) ? 0 : 1));
        if (MODE < 2)
#pragma unroll
        for (int i = 0; i < 4; ++i) { *(u32x4*)(sA + 8192 + wr_off + i * 2048) = r1a[i]; *(u32x4*)(sB + 8192 + wr_off + i * 2048) = r1b[i]; }
        __syncthreads();
        if (m3 && MODE == 0) {
            const int k0 = (kt + 3) << 6;
#pragma unroll
            for (int i = 0; i < 4; ++i) { gld16(r1a[i], Ap + (size_t)i * 32 * lda + k0); gld16(r1b[i], Bp + (size_t)i * 32 * ldb + k0); }
        }
        GEMM_COMPUTE(1);
        if (m2) {
            vm_wait_sel(r0a[0], r0a[1], r0a[2], r0a[3], r0b[0], r0b[1], r0b[2], r0b[3], __builtin_amdgcn_readfirstlane((m3 && MODE == 0) ? 0 : 1));
            if (MODE < 2)
#pragma unroll
            for (int i = 0; i < 4; ++i) { *(u32x4*)(sA + wr_off + i * 2048) = r0a[i]; *(u32x4*)(sB + wr_off + i * 2048) = r0b[i]; }
        }
        __syncthreads();
    }
#undef GEMM_COMPUTE
#undef GEMM_LDFRAG
#undef GEMM_MMA
    epi(acc, row0 + wm * 64, col0 + wn * 64);
}

DI const bf16_t* uni_ptr(const bf16_t* p) {
    const unsigned long long v = (unsigned long long)p;
    const unsigned lo = __builtin_amdgcn_readfirstlane((unsigned)v), hi = __builtin_amdgcn_readfirstlane((unsigned)(v >> 32));
    return (const bf16_t*)(((unsigned long long)hi << 32) | lo); }
DI void gld16s(u32x4& r, unsigned voff, const void* sbase) { asm volatile("global_load_dwordx4 %0, %1, %2" : "=&v"(r) : "v"(voff), "s"(sbase) : "memory"); }
DI void vm_wait12(u32x4& a, u32x4& b, u32x4& c, u32x4& d, u32x4& e, u32x4& f, u32x4& g, u32x4& h, u32x4& i, u32x4& j, u32x4& k, u32x4& l) {
    asm volatile("s_waitcnt vmcnt(0)" : "+v"(a), "+v"(b), "+v"(c), "+v"(d), "+v"(e), "+v"(f), "+v"(g), "+v"(h), "+v"(i), "+v"(j), "+v"(k), "+v"(l) : : "memory"); }

template <class Epi>
DI void gemm_tile256(const bf16_t* __restrict__ A, int lda, const bf16_t* __restrict__ Bt, int ldb, int K, int row0, int col0, char* smem, Epi&& epi) {
    bf16_t* sA = (bf16_t*)smem;
    bf16_t* sB = sA + 256 * 64;
    const int tid = TIDX(), lane = tid & 63, wave = tid >> 6;
    const int wm = wave >> 1, wn = wave & 1, l31 = lane & 31, hh = lane >> 5;
    u32x4 ra[8], rb[4];
    const bf16_t* Ab = uni_ptr(A + (size_t)row0 * lda);
    const bf16_t* Bb = uni_ptr(Bt + (size_t)col0 * ldb);
    const unsigned voa = ((unsigned)(tid >> 3) * (unsigned)lda + (tid & 7) * 8) * 2u;
    const unsigned vob = ((unsigned)(tid >> 3) * (unsigned)ldb + (tid & 7) * 8) * 2u;
    const int wr_off = (tid >> 3) * 64 + (((tid & 7) ^ ((tid >> 4) & 7)) * 8);
    f32x16 acc[4][2];
#pragma unroll
    for (int a = 0; a < 4; ++a)
#pragma unroll
        for (int b = 0; b < 2; ++b)
#pragma unroll
            for (int i = 0; i < 16; ++i) acc[a][b][i] = 0.f;
    const int nk = K >> 6;
#pragma unroll
    for (int i = 0; i < 8; ++i) gld16s(ra[i], voa, Ab + (size_t)i * 32 * lda);
#pragma unroll
    for (int i = 0; i < 4; ++i) gld16s(rb[i], vob, Bb + (size_t)i * 32 * ldb);
    const int sw = (l31 >> 1) & 7;
    const bf16_t* cA = sA + (wm * 128 + l31) * 64;
    const bf16_t* cB = sB + (wn * 64 + l31) * 64;
    for (int kt = 0; kt < nk; ++kt) {
        vm_wait12(ra[0], ra[1], ra[2], ra[3], ra[4], ra[5], ra[6], ra[7], rb[0], rb[1], rb[2], rb[3]);
#pragma unroll
        for (int i = 0; i < 8; ++i) *(u32x4*)(sA + wr_off + i * 2048) = ra[i];
#pragma unroll
        for (int i = 0; i < 4; ++i) *(u32x4*)(sB + wr_off + i * 2048) = rb[i];
        __syncthreads();
        if (kt + 1 < nk) {
            const int k0 = (kt + 1) << 6;
#pragma unroll
            for (int i = 0; i < 8; ++i) gld16s(ra[i], voa, Ab + (size_t)i * 32 * lda + k0);
#pragma unroll
            for (int i = 0; i < 4; ++i) gld16s(rb[i], vob, Bb + (size_t)i * 32 * ldb + k0);
        }
        __builtin_amdgcn_s_setprio(1);
#pragma unroll
        for (int ks = 0; ks < 4; ++ks) {
            const int ch = ((2 * ks + hh) ^ sw) * 8;
            const bf16x8 b0 = *(const bf16x8*)(cB + ch), b1 = *(const bf16x8*)(cB + 32 * 64 + ch);
#pragma unroll
            for (int mi = 0; mi < 4; ++mi) {
                const bf16x8 a = *(const bf16x8*)(cA + mi * 32 * 64 + ch);
                acc[mi][0] = MFMA32(a, b0, acc[mi][0]);
                acc[mi][1] = MFMA32(a, b1, acc[mi][1]);
            }
        }
        __builtin_amdgcn_s_setprio(0);
        __syncthreads();
    }
    epi(acc, row0 + wm * 128, col0 + wn * 64);
}

DI void transpose_store(bf16_t* dst, int K, int n0, int k0, const float* tile) {
    const int kp = TIDX() & 31, nn = TIDX() >> 5;
#pragma unroll
    for (int i = 0; i < 8; ++i) {
        const int n = nn + 8 * i;
        *(unsigned*)(dst + (size_t)(n0 + n) * K + k0 + 2 * kp) = pack2(tile[(2 * kp) * 65 + n], tile[(2 * kp + 1) * 65 + n]);
    }
}
template <class F>
DI void transpose_tile(bf16_t* dst, int K, int tn, int tk, F src, float* tile) {
    const int tx = TIDX() & 63, ty = TIDX() >> 6;
    const int n0 = tn * 64, k0 = tk * 64;
    float v[16];
#pragma unroll
    for (int i = 0; i < 16; ++i) v[i] = src(k0 + ty + 4 * i, n0 + tx);
#pragma unroll
    for (int i = 0; i < 16; ++i) tile[(ty + 4 * i) * 65 + tx] = v[i];
    __syncthreads();
    transpose_store(dst, K, n0, k0, tile);
    __syncthreads();
}
DI void poolfold_tile(bf16_t* dst, int tn, int tk, const float* wi, const float* pw, const float* ps, float* smemf) {
    float* wt = smemf;
    float* pt = smemf + 64 * 65;
    float* ot = pt + 64 * 64;
    const int tx = TIDX() & 63, ty = TIDX() >> 6;
    const int n0 = tn * 64, k0 = tk * 64, g = (n0 - IN_POOL) >> 6;
    const float sc = ps[g * 64 + tx];
#pragma unroll
    for (int i = 0; i < 16; ++i) {
        const int r = ty + 4 * i;
        wt[r * 65 + tx] = wi[(size_t)(k0 + r) * DIN + IN_POOL + g * 64 + tx];
        pt[r * 64 + tx] = pw[g * 4096 + r * 64 + tx] * sc;
    }
    __syncthreads();
    float acc[16];
#pragma unroll
    for (int i = 0; i < 16; ++i) acc[i] = 0.f;
    for (int ii = 0; ii < 64; ++ii) {
        const float pv = pt[ii * 64 + tx];
#pragma unroll
        for (int i = 0; i < 16; ++i) acc[i] += wt[(ty + 4 * i) * 65 + ii] * pv;
    }
#pragma unroll
    for (int i = 0; i < 16; ++i) ot[(ty + 4 * i) * 65 + tx] = acc[i];
    __syncthreads();
    transpose_store(dst, 1024, n0, k0, ot);
    __syncthreads();
}

PH_FN void prep_phase(const KP& p, char* smem) {
    float* tile = (float*)smem;
    bf16_t* W = (bf16_t*)(p.ws + OFF_W);
    const int NTR = 5024;
    const int n_items = 2 * NTR + 288 + 1 + 16;
    for (int it = blockIdx.x; it < n_items; it += gridDim.x) {
        if (it < 2 * NTR) {
            const int l = it / NTR; int r = it % NTR;
            bf16_t* Wl = W + (size_t)l * WL_EL;
            if (r < 2816) {
                const int f = r / 1408; r %= 1408;
                const float* g = p.in[8] + (size_t)(l * 2 + f) * D * FF;
                const float* u = p.in[9] + (size_t)(l * 2 + f) * D * FF;
                transpose_tile(Wl + (f ? WO_GU1 : WO_GU0), 1024, r / 16, r % 16, [&](int k, int n) {
                    const int j = n >> 7, w = n & 127, c = j * 64 + (w >> 6) * 32 + (w & 31);
                    return ((w >> 5) & 1) ? u[(size_t)k * FF + c] : g[(size_t)k * FF + c]; }, tile);
            } else if (r < 2816 + 1408) {
                r -= 2816; const int f = r / 704; r %= 704;
                const float* dn = p.in[10] + (size_t)(l * 2 + f) * FF * D;
                transpose_tile(Wl + (f ? WO_D1 : WO_D0), 2816, r / 44, r % 44, [&](int k, int n) { return dn[(size_t)k * D + n]; }, tile);
            } else if (r < 4224 + 384) {
                r -= 4224;
                const float* wi = p.in[11] + (size_t)l * D * DIN;
                const float* pw = p.in[27] + (size_t)l * 4 * 64 * 64;
                const float* ps = p.in[28] + (size_t)l * 256;
                const int tn = r / 16, tk = r % 16;
                if (tn >= IN_POOL / 64 && tn < IN_CQ / 64) poolfold_tile(Wl + WO_IN, tn, tk, wi, pw, ps, tile);
                else transpose_tile(Wl + WO_IN, 1024, tn, tk, [&](int k, int n) { return n < DIN ? wi[(size_t)k * DIN + n] : 0.f; }, tile);
            } else if (r < 4608 + 320) {
                r -= 4608;
                const float* wo = p.in[12] + (size_t)l * DMIX * D;
                transpose_tile(Wl + WO_OUT, 1280, r / 20, r % 20, [&](int k, int n) { return wo[(size_t)k * D + n]; }, tile);
            } else if (r < 4928 + 48) {
                r -= 4928;
                const float* wq = p.in[30] + (size_t)l * 256 * 768;
                const float* gn = p.in[29] + (size_t)l * 256;
                transpose_tile(Wl + WO_UQ, 256, r / 4, r % 4, [&](int k, int n) { return wq[(size_t)k * 768 + n] * gn[k] * QSCALE; }, tile);
            } else if (r < 4976 + 32) {
                r -= 4976;
                const float* wk = p.in[32] + (size_t)l * 128 * 1024;
                const float* gn = p.in[31] + (size_t)l * 128;
                transpose_tile(Wl + WO_UKV, 128, r / 2, r % 2, [&](int k, int n) { return wk[(size_t)k * 1024 + n] * gn[k]; }, tile);
            } else {
                r -= 5008;
                const float* wg = p.in[21] + (size_t)l * 256 * 256;
                transpose_tile(Wl + WO_GLU, 256, r / 4, r % 4, [&](int k, int n) { return wg[(size_t)k * 256 + n]; }, tile);
            }
        } else if (it < 2 * NTR + 288) {
            const int r = it - 2 * NTR, l = r / 144, n0 = (r % 144) * 64;
            float* sc = (float*)smem;
            float* red = sc + 3072;
            for (int i = TIDX(); i < 3072; i += 256) {
                const int v = i >> 10, k = i & 1023;
                const float cv = v < 2 ? p.in[1][v * 1024 + k] : p.in[3][k];
                sc[i] = cv / (1.f + expf(-cv));
            }
            __syncthreads();
            const int tx = TIDX() & 63, ty = TIDX() >> 6;
            const float* wa = p.in[4] + (size_t)l * D * 9216 + n0 + tx;
            float a0 = 0.f, a1 = 0.f, a2 = 0.f;
#pragma unroll 32
            for (int k = ty * 256; k < ty * 256 + 256; ++k) {
                const float w = wa[(size_t)k * 9216];
                a0 += sc[k] * w; a1 += sc[1024 + k] * w; a2 += sc[2048 + k] * w;
            }
            red[(ty * 3 + 0) * 64 + tx] = a0; red[(ty * 3 + 1) * 64 + tx] = a1; red[(ty * 3 + 2) * 64 + tx] = a2;
            __syncthreads();
            if (TIDX() < 192) {
                const int v = TIDX() >> 6;
                float s = p.in[5][l * 9216 + n0 + tx];
                for (int q = 0; q < 4; ++q) s += red[(q * 3 + v) * 64 + tx];
                ((float*)(p.ws + OFF_MOD))[(size_t)(l * 3 + v) * 9216 + n0 + tx] = s;
            }
            __syncthreads();
        } else if (it == 2 * NTR + 288) {
            float* tab = (float*)(p.ws + OFF_ROPE);
            const int pos = TIDX();
            for (int i = 0; i < 8; ++i) {
                const float inv = powf(10000.f, -(float)(2 * i) / 16.f);
                const float ang = (float)pos * inv;
                tab[(pos * 8 + i) * 2 + 0] = cosf(ang);
                tab[(pos * 8 + i) * 2 + 1] = sinf(ang);
            }
        } else {
            const int idx = (it - (2 * NTR + 289)) * 256 + TIDX();
            const int pp = idx & 63, g = (idx >> 6) & 15, ld = idx >> 10;
            float lr = fminf(p.in[13][idx], -1e-4f), li = p.in[14][idx];
            const float dt = expf(p.in[15][ld * 16 + g]);
            const float mag = expf(lr * dt);
            const float br = mag * cosf(li * dt), bi = mag * sinf(li * dt);
            float tr = br, ti = bi;
            for (int q = 0; q < 6; ++q) { const float nr = tr * tr - ti * ti, ni = 2.f * tr * ti; tr = nr; ti = ni; }
            ((float4*)(p.ws + OFF_LAMB))[idx] = make_float4(br, bi, tr, ti);
            const float nr = br - 1.f, ni = bi, den = 1.f / (lr * lr + li * li);
            const float cr = (nr * lr + ni * li) * den, ci = (ni * lr - nr * li) * den;
            float* bb = (float*)(p.ws + OFF_BBAR) + (size_t)idx * 32;
            const float* sbr = p.in[16] + (size_t)idx * 16; const float* sbi = p.in[17] + (size_t)idx * 16;
            for (int h = 0; h < 16; ++h) { const float xr = sbr[h], xi = sbi[h]; bb[2 * h] = cr * xr - ci * xi; bb[2 * h + 1] = cr * xi + ci * xr; }
            bf16_t* cc = (bf16_t*)(p.ws + OFF_CC) + (size_t)(ld * 16 + g) * 2048;
            const float* scr = p.in[18] + (size_t)(ld * 16 + g) * 1024; const float* sci = p.in[19] + (size_t)(ld * 16 + g) * 1024;
            for (int h = 0; h < 16; ++h) { cc[h * 128 + pp] = f2bf(scr[h * 64 + pp]); cc[h * 128 + 64 + pp] = f2bf(-sci[h * 64 + pp]); }
        }
    }
}

PH_FN void rowop_phase(const KP& p, int l_mod_post, int gate_idx, float coef, const float* gpost, bool has_y,
                    int l_mod_pre, int shift_idx, const float* gpre, bool has_pre, bool first, int nrows = NT) {
    const int lane = TIDX() & 63;
    const int wid = blockIdx.x * 4 + (TIDX() >> 6), nw = gridDim.x * 4;
    bf16_t* HY = (bf16_t*)(p.ws + OFF_HY);
    float* Xc = (float*)(p.ws + OFF_XC);
    const float* MOD = (const float*)(p.ws + OFF_MOD);
    for (int row0 = wid; row0 < nrows; row0 += 2 * nw) {
        int rows[2]; bool ok[2];
        rows[0] = row0; ok[0] = true;
        ok[1] = (row0 + nw) < nrows; rows[1] = ok[1] ? row0 + nw : row0;
        float* xp[2]; int mv[2];
        float4 x[2][4], y[2][4];
        float ssy[2] = {0.f, 0.f};
#pragma unroll
        for (int q = 0; q < 2; ++q) {
            const int row = rows[q];
            mv[q] = row_mod(row);
            xp[q] = row < NL ? p.out + (size_t)row * D : Xc + (size_t)(row - NL) * D;
            const float* xin = first ? (row < NL ? p.in[0] + (size_t)row * D : p.in[2] + (size_t)(row - NL) * D) : xp[q];
#pragma unroll
            for (int i = 0; i < 4; ++i) x[q][i] = *(const float4*)(xin + lane * 4 + 256 * i);
            if (has_y) {
#pragma unroll
                for (int i = 0; i < 4; ++i) {
                    const uint2 raw = *(const uint2*)(HY + (size_t)row * D + lane * 4 + 256 * i);
                    y[q][i].x = __uint_as_float(raw.x << 16); y[q][i].y = __uint_as_float(raw.x & 0xffff0000u);
                    y[q][i].z = __uint_as_float(raw.y << 16); y[q][i].w = __uint_as_float(raw.y & 0xffff0000u);
                    ssy[q] += y[q][i].x * y[q][i].x + y[q][i].y * y[q][i].y + y[q][i].z * y[q][i].z + y[q][i].w * y[q][i].w;
                }
            }
        }
        if (has_y) {
            for (int m = 32; m >= 1; m >>= 1) { ssy[0] += shflx(ssy[0], m); ssy[1] += shflx(ssy[1], m); }
#pragma unroll
            for (int q = 0; q < 2; ++q) {
                const float rstd = rsqrtf(ssy[q] * (1.f / D) + EPS);
                const float* gt = MOD + (size_t)(l_mod_post * 3 + mv[q]) * 9216 + gate_idx * 1024;
#pragma unroll
                for (int i = 0; i < 4; ++i) {
                    const float4 g = *(const float4*)(gt + lane * 4 + 256 * i);
                    const float4 w = *(const float4*)(gpost + lane * 4 + 256 * i);
                    x[q][i].x += coef * g.x * (y[q][i].x * rstd * w.x); x[q][i].y += coef * g.y * (y[q][i].y * rstd * w.y);
                    x[q][i].z += coef * g.z * (y[q][i].z * rstd * w.z); x[q][i].w += coef * g.w * (y[q][i].w * rstd * w.w);
                }
                if (ok[q]) {
#pragma unroll
                    for (int i = 0; i < 4; ++i) *(float4*)(xp[q] + lane * 4 + 256 * i) = x[q][i];
                }
            }
        }
        if (has_pre) {
            float ssx[2];
#pragma unroll
            for (int q = 0; q < 2; ++q) {
                ssx[q] = 0.f;
#pragma unroll
                for (int i = 0; i < 4; ++i) ssx[q] += x[q][i].x * x[q][i].x + x[q][i].y * x[q][i].y + x[q][i].z * x[q][i].z + x[q][i].w * x[q][i].w;
            }
            for (int m = 32; m >= 1; m >>= 1) { ssx[0] += shflx(ssx[0], m); ssx[1] += shflx(ssx[1], m); }
#pragma unroll
            for (int q = 0; q < 2; ++q) {
                const float rstd = rsqrtf(ssx[q] * (1.f / D) + EPS);
                const float* sh = MOD + (size_t)(l_mod_pre * 3 + mv[q]) * 9216 + shift_idx * 1024;
                if (ok[q]) {
#pragma unroll
                    for (int i = 0; i < 4; ++i) {
                        const float4 s0 = *(const float4*)(sh + lane * 4 + 256 * i);
                        const float4 s1 = *(const float4*)(sh + 1024 + lane * 4 + 256 * i);
                        const float4 w = *(const float4*)(gpre + lane * 4 + 256 * i);
                        const float h0 = x[q][i].x * rstd * w.x * (1.f + s1.x) + s0.x, h1 = x[q][i].y * rstd * w.y * (1.f + s1.y) + s0.y;
                        const float h2 = x[q][i].z * rstd * w.z * (1.f + s1.z) + s0.z, h3 = x[q][i].w * rstd * w.w * (1.f + s1.w) + s0.w;
                        uint2 o; o.x = pack2(h0, h1); o.y = pack2(h2, h3);
                        *(uint2*)(HY + (size_t)rows[q] * D + lane * 4 + 256 * i) = o;
                    }
                }
            }
        }
    }
}

template <int MODE = 0>
PH_FN void gemm1_phase(const KP& p, int l, int f, char* smem, int ntm = NT / 256) {
    const bf16_t* H = (const bf16_t*)(p.ws + OFF_HY);
    const bf16_t* W = (const bf16_t*)(p.ws + OFF_W) + (size_t)l * WL_EL + (f ? WO_GU1 : WO_GU0);
    bf16_t* ACT = (bf16_t*)(p.ws + OFF_ACT);
    const int lane = TIDX() & 63, l31 = lane & 31, hh = lane >> 5;
    const int n_items = (NL / 256) * 44;
    const int n_ctx = ntm > NL / 256 ? (NC / 128) * 44 : 0;
    for (int it = vblock(); it < n_ctx; it += gridDim.x) {
        const int mt = it / 44, nt = it - mt * 44;
        gemm_tile(H, D, W, D, D, NL + mt * 128, nt * 128, smem, [&](f32x16 (&acc)[2][2], int r0, int c0) {
            const int col = (c0 >> 7) * 64 + ((c0 >> 6) & 1) * 32 + l31;
#pragma unroll
            for (int mi = 0; mi < 2; ++mi)
#pragma unroll
                for (int i = 0; i < 16; ++i) ACT[(size_t)(r0 + 32 * mi + crow(i, hh)) * FF + col] = f2bf(siluf_(acc[mi][0][i]) * acc[mi][1][i]);
        });
    }
    for (int it = vblock(); it < n_items; it += gridDim.x) {
        int mt, nt; tile_mn(it, NL / 256, 44, mt, nt);
        gemm_tile256(H, D, W, D, D, mt * 256, nt * 128, smem, [&](f32x16 (&acc)[4][2], int r0, int c0) {
            const int col = (c0 >> 7) * 64 + ((c0 >> 6) & 1) * 32 + l31;
#pragma unroll
            for (int mi = 0; mi < 4; ++mi)
#pragma unroll
                for (int i = 0; i < 16; ++i) {
                    const int row = r0 + 32 * mi + crow(i, hh);
                    ACT[(size_t)row * FF + col] = f2bf(siluf_(acc[mi][0][i]) * acc[mi][1][i]);
                }
        });
    }
}

template <int MODE = 0>
PH_FN void gemm_store_phase(const bf16_t* A, int lda, const bf16_t* W, int K, int ntn, bf16_t* C, int ldc, int ncols, char* smem, int ntm = NT / 128) {
    const int lane = TIDX() & 63, l31 = lane & 31, hh = lane >> 5;
    const int n_items = ntm * ntn;
    for (int it = vblock(); it < n_items; it += gridDim.x) {
        int mt, nt; tile_mn(it, ntm, ntn, mt, nt);
        gemm_tile<MODE>(A, lda, W, K, K, mt * 128, nt * 128, smem, [&](f32x16 (&acc)[2][2], int r0, int c0) {
            if (MODE != 0 && acc[0][0][0] != 123456.789f) return;
#pragma unroll
            for (int ni = 0; ni < 2; ++ni) {
                const int col = c0 + 32 * ni + l31;
                if (col < ncols) {
#pragma unroll
                    for (int mi = 0; mi < 2; ++mi)
#pragma unroll
                        for (int i = 0; i < 16; ++i) C[(size_t)(r0 + 32 * mi + crow(i, hh)) * ldc + col] = f2bf(acc[mi][ni][i]);
                }
            }
        });
    }
}

template <int LDC>
PH_FN void gemm_store_phase256(const bf16_t* A, int lda, const bf16_t* W, int K, int ntn, bf16_t* C, char* smem, int ntm, int nctx128) {
    const int lane = TIDX() & 63, l31 = lane & 31, hh = lane >> 5;
    const int n_items = ntm * ntn;
    for (int it = vblock(); it < nctx128 * ntn; it += gridDim.x) {
        const int mt = it / ntn, nt = it - mt * ntn;
        gemm_tile(A, lda, W, K, K, NL + mt * 128, nt * 128, smem, [&](f32x16 (&acc)[2][2], int r0, int c0) {
#pragma unroll
            for (int mi = 0; mi < 2; ++mi) {
                bf16_t* cp = C + (size_t)(r0 + 32 * mi + 4 * hh) * LDC + c0 + l31;
#pragma unroll
                for (int ni = 0; ni < 2; ++ni)
#pragma unroll
                    for (int i = 0; i < 16; ++i) if (LDC == D || c0 + l31 + 32 * ni < LDC) cp[((i & 3) + 8 * (i >> 2)) * LDC + 32 * ni] = f2bf(acc[mi][ni][i]);
            }
        });
    }
    for (int it = vblock(); it < n_items; it += gridDim.x) {
        int mt, nt; tile_mn(it, ntm, ntn, mt, nt);
        gemm_tile256(A, lda, W, K, K, mt * 256, nt * 128, smem, [&](f32x16 (&acc)[4][2], int r0, int c0) {
#pragma unroll
            for (int mi = 0; mi < 4; ++mi) {
                bf16_t* cp = C + (size_t)(r0 + 32 * mi + 4 * hh) * LDC + c0 + l31;
#pragma unroll
                for (int ni = 0; ni < 2; ++ni)
#pragma unroll
                    for (int i = 0; i < 16; ++i) if (LDC == D || c0 + l31 + 32 * ni < LDC) cp[((i & 3) + 8 * (i >> 2)) * LDC + 32 * ni] = f2bf(acc[mi][ni][i]);
                __builtin_amdgcn_sched_barrier(0);
            }
        });
    }
}

PH_FN void glu_phase(const KP& p, int l, char* smem) {
    const bf16_t* S5P = (const bf16_t*)(p.ws + OFF_S5P);
    const bf16_t* W = (const bf16_t*)(p.ws + OFF_W) + (size_t)l * WL_EL + WO_GLU;
    bf16_t* MIX = (bf16_t*)(p.ws + OFF_MIX);
    const float* bg = p.in[22] + l * 256;
    const int lane = TIDX() & 63, l31 = lane & 31, hh = lane >> 5;
    const int n_items = (NT / 128) * 2;
    for (int it = vblock(); it < n_items; it += gridDim.x) {
        const int mt = it >> 1, nt = it & 1;
        gemm_tile(S5P, 256, W, 256, 256, mt * 128, nt * 128, smem, [&](f32x16 (&acc)[2][2], int r0, int c0) {
#pragma unroll
            for (int ni = 0; ni < 2; ++ni) {
                const int col = c0 + 32 * ni + l31;
                const float b = bg[col];
#pragma unroll
                for (int mi = 0; mi < 2; ++mi)
#pragma unroll
                    for (int i = 0; i < 16; ++i) {
                        const int row = r0 + 32 * mi + crow(i, hh);
                        const float y = bf2f(S5P[(size_t)row * 256 + col]);
                        MIX[(size_t)row * DMIX + col] = f2bf(y * sigmoidf_(acc[mi][ni][i] + b));
                        if ((i & 3) == 3) __builtin_amdgcn_sched_barrier(0);
                    }
            }
        });
    }
}

DI void key_pos(int row, int& b, int& pos) {
    if (row < NL) { b = row >= SEQ ? 1 : 0; pos = row - b * SEQ; }
    else { const int r = row - NL; b = r >> 8; pos = SEQ + (r & 255); }
}

DI void qkv_item(const KP& p, int l, int it, char* smem) {
    const bf16_t* Z = (const bf16_t*)(p.ws + OFF_Z);
    const bf16_t* Wl = (const bf16_t*)(p.ws + OFF_W) + (size_t)l * WL_EL;
    bf16_t* Q = (bf16_t*)(p.ws + OFF_Q);
    bf16_t* Kb = (bf16_t*)(p.ws + OFF_K);
    bf16_t* Vt = (bf16_t*)(p.ws + OFF_VT);
    const float* tab = (const float*)(p.ws + OFF_ROPE);
    const int mt = it / 14, sub = it % 14, row0 = mt * 128;
    const int tid = TIDX(), lane = tid & 63, l31 = lane & 31, hh = lane >> 5;
    __shared__ float s_rs[128];
    {
        const int r = tid >> 1, half = tid & 1;
        const bool isq = sub < 6;
        const int n = isq ? 128 : 64;
        const bf16_t* src = Z + (size_t)(row0 + r) * DIN + (isq ? IN_CQ : IN_CKV) + half * n;
        float ss = 0.f;
        auto sq8 = [&](const u32x4& v) {
#pragma unroll
            for (int q = 0; q < 4; ++q) { const float a = __uint_as_float(v[q] << 16), b = __uint_as_float(v[q] & 0xffff0000u); ss += a * a + b * b; }
        };
        if (isq) {
            u32x4 v[16];
#pragma unroll
            for (int i = 0; i < 16; ++i) v[i] = *(const u32x4*)(src + 8 * i);
#pragma unroll
            for (int i = 0; i < 16; ++i) sq8(v[i]);
        } else {
            u32x4 v[8];
#pragma unroll
            for (int i = 0; i < 8; ++i) v[i] = *(const u32x4*)(src + 8 * i);
#pragma unroll
            for (int i = 0; i < 8; ++i) sq8(v[i]);
        }
        ss += shflx(ss, 1);
        if (half == 0) s_rs[r] = rsqrtf(ss / (float)(2 * n) + EPS);
    }
    __syncthreads();
    if (sub < 6) {
        gemm_tile(Z + IN_CQ, DIN, Wl + WO_UQ, 256, 256, row0, sub * 128, smem, [&](f32x16 (&acc)[2][2], int r0, int c0) {
#pragma unroll
            for (int ni = 0; ni < 2; ++ni) {
                const int cb = c0 + 32 * ni, col = cb + l31;
                const bool is_rope = ((cb >> 5) % 3) == 2;
                const int axis = l31 >> 4, second = (l31 >> 3) & 1, fi = l31 & 7;
#pragma unroll
                for (int mi = 0; mi < 2; ++mi)
#pragma unroll
                    for (int i = 0; i < 16; ++i) {
                        const int row = r0 + 32 * mi + crow(i, hh);
                        float v = acc[mi][ni][i] * s_rs[row - row0];
                        if (is_rope) {
                            const float pr = shflx(v, 8);
                            if (row < NL) {
                                const int t = row & (SEQ - 1);
                                const int pos = axis ? (t & 63) : (t >> 6);
                                const float cs = tab[(pos * 8 + fi) * 2], sn = tab[(pos * 8 + fi) * 2 + 1];
                                v = second ? (v * cs + pr * sn) : (v * cs - pr * sn);
                            }
                        }
                        Q[(size_t)row * 768 + col] = f2bf(v);
                        if ((i & 3) == 3) __builtin_amdgcn_sched_barrier(0);
                    }
            }
        });
    } else {
        const int head = sub - 6;
        gemm_tile(Z + IN_CKV, DIN, Wl + WO_UKV, 128, 128, row0, head * 128, smem, [&](f32x16 (&acc)[2][2], int r0, int c0) {
            const bool isv = (c0 >> 6) & 1;
#pragma unroll
            for (int ni = 0; ni < 2; ++ni) {
                const int dcol = 32 * ni + l31;
#pragma unroll
                for (int mi = 0; mi < 2; ++mi)
#pragma unroll
                    for (int q = 0; q < 4; ++q) {
                        const int rowb = r0 + 32 * mi + 8 * q + 4 * hh;
                        int b, pos; key_pos(rowb, b, pos);
                        float v[4];
#pragma unroll
                        for (int j = 0; j < 4; ++j) v[j] = acc[mi][ni][4 * q + j] * s_rs[rowb + j - row0];
                        if (isv) {
                            uint2 o; o.x = pack2(v[0], v[1]); o.y = pack2(v[2], v[3]);
                            *(uint2*)(Vt + ((size_t)(b * NH + head) * 64 + dcol) * LK + ((pos & ~12) | ((pos & 4) << 1) | ((pos & 8) >> 1))) = o;
                        } else {
#pragma unroll
                            for (int j = 0; j < 4; ++j) Kb[((size_t)(b * NH + head) * LK + pos + j) * DK + dcol] = f2bf(v[j]);
                        }
                    }
            }
        });
        for (int e = tid; e < 128 * 32; e += 256) {
            const int r = e >> 5, d = e & 31, row = row0 + r;
            const bf16_t* kr = Z + (size_t)row * DIN + IN_KR;
            float v = bf2f(kr[d]);
            if (row < NL) {
                const float pr = bf2f(kr[d ^ 8]);
                const int t = row & (SEQ - 1), axis = d >> 4, second = (d >> 3) & 1, fi = d & 7;
                const int pos = axis ? (t & 63) : (t >> 6);
                const float cs = tab[(pos * 8 + fi) * 2], sn = tab[(pos * 8 + fi) * 2 + 1];
                v = second ? (v * cs + pr * sn) : (v * cs - pr * sn);
            }
            int b, pos; key_pos(row, b, pos);
            Kb[((size_t)(b * NH + head) * LK + pos) * DK + 64 + d] = f2bf(v);
        }
    }
    __syncthreads();
}

DI void convpool_item(const KP& p, int l, int it, char* smem) {
    const bf16_t* Z = (const bf16_t*)(p.ws + OFF_Z);
    bf16_t* MIX = (bf16_t*)(p.ws + OFF_MIX);
    float* hs = (float*)smem;
    int L, rowbase, t0;
    if (it < 1024) { L = SEQ; rowbase = (it >> 9) * SEQ; t0 = (it & 511) * 32; }
    else { const int r = it - 1024; L = CTXL; rowbase = NL + (r >> 3) * CTXL; t0 = (r & 7) * 32; }
    const int c = TIDX(), lane = c & 63, wave = c >> 6;
    {
        const int c4 = (c & 63) * 4, ts = c >> 6;
#pragma unroll 4
        for (int j = ts; j < 62; j += 4) {
            const int t = t0 - 15 + j;
            float4 h = make_float4(0.f, 0.f, 0.f, 0.f);
            if (t >= 0 && t < L) {
                const bf16_t* zr = Z + (size_t)(rowbase + t) * DIN + IN_CONV + c4;
                const uint2 v = *(const uint2*)zr, g = *(const uint2*)(zr + 256);
                h.x = __uint_as_float(v.x << 16) * sigmoidf_(__uint_as_float(g.x << 16));
                h.y = __uint_as_float(v.x & 0xffff0000u) * sigmoidf_(__uint_as_float(g.x & 0xffff0000u));
                h.z = __uint_as_float(v.y << 16) * sigmoidf_(__uint_as_float(g.y << 16));
                h.w = __uint_as_float(v.y & 0xffff0000u) * sigmoidf_(__uint_as_float(g.y & 0xffff0000u));
            }
            *(float4*)(hs + j * 256 + c4) = h;
        }
    }
    __syncthreads();
    float w[31];
#pragma unroll
    for (int k = 0; k < 31; ++k) w[k] = p.in[23][(size_t)(l * 31 + k) * 256 + c];
    const float cb = p.in[24][l * 256 + c];
#pragma unroll 1
    for (int tt = 0; tt < 32; ++tt) {
        float s = cb;
#pragma unroll
        for (int k = 0; k < 31; ++k) s += w[k] * hs[(tt + k) * 256 + c];
        hs[tt * 256 + c] = s;
    }
    __syncthreads();
    {
        const float4 lg = *(const float4*)(p.in[25] + l * 256 + lane * 4);
        const float4 lb = *(const float4*)(p.in[26] + l * 256 + lane * 4);
#pragma unroll 1
        for (int q = 0; q < 8; ++q) {
            const int tt = wave * 8 + q;
            const float4 v = *(const float4*)(hs + tt * 256 + lane * 4);
            const float mean = wave_sum(v.x + v.y + v.z + v.w) * (1.f / 256.f);
            const float d0 = v.x - mean, d1 = v.y - mean, d2 = v.z - mean, d3 = v.w - mean;
            const float var = wave_sum(d0 * d0 + d1 * d1 + d2 * d2 + d3 * d3) * (1.f / 256.f);
            const float rstd = rsqrtf(var + EPS);
            uint2 o;
            o.x = pack2(siluf_(d0 * rstd * lg.x + lb.x), siluf_(d1 * rstd * lg.y + lb.y));
            o.y = pack2(siluf_(d2 * rstd * lg.z + lb.z), siluf_(d3 * rstd * lg.w + lb.w));
            *(uint2*)(MIX + (size_t)(rowbase + t0 + tt) * DMIX + 256 + lane * 4) = o;
        }
    }
    __syncthreads();
    {
        const int c4 = (c & 63) * 4, ts = c >> 6;
#pragma unroll 4
        for (int j = ts; j < 47; j += 4) {
            const int t = t0 - 7 + j;
            float4 h = make_float4(0.f, 0.f, 0.f, 0.f);
            if (t >= 0 && t < L) {
                const uint2 v = *(const uint2*)(Z + (size_t)(rowbase + t) * DIN + IN_POOL + c4);
                h.x = __uint_as_float(v.x << 16); h.y = __uint_as_float(v.x & 0xffff0000u); h.z = __uint_as_float(v.y << 16); h.w = __uint_as_float(v.y & 0xffff0000u);
            }
            *(float4*)(hs + j * 256 + c4) = h;
        }
    }
    __syncthreads();
    {
        const int win = 2 << (c >> 6), wa = (win - 1) >> 1, wb = win >> 1;
#pragma unroll 1
        for (int tt = 0; tt < 32; ++tt) {
            const int t = t0 + tt;
            const int lo = max(t - wa, 0), hi = min(t + wb, L - 1);
            float s = 0.f;
            for (int q = lo; q <= hi; ++q) s += hs[(q - t0 + 7) * 256 + c];
            const float o = s / (float)(hi - lo + 1) - hs[(tt + 7) * 256 + c];
            MIX[(size_t)(rowbase + t) * DMIX + 512 + c] = f2bf(o);
        }
    }
    __syncthreads();
}

DI int chunk_row(int b, int k) { return k < 4 ? NL + b * CTXL + 64 * k : b * SEQ + 64 * (k - 4); }

template <bool FINAL>
DI void s5_item(const KP& p, int l, int it, char* smem) {
    const int g4 = it & 3, k = (it >> 2) % NCHUNK, b = (it >> 2) / NCHUNK;
    const int tid = TIDX(), lane = tid & 63, wave = tid >> 6, g = g4 * 4 + wave;
    const bf16_t* Z = (const bf16_t*)(p.ws + OFF_Z);
    float* Us = (float*)smem + wave * 1024;
    bf16_t* Hs = (bf16_t*)(smem + 16384) + wave * (16 * 136);
    const int rbase = chunk_row(b, k);
    {
        const uint4* src = (const uint4*)(Z + (size_t)(rbase + lane) * DIN + g * 16);
        const uint4 v0 = src[0], v1 = src[1];
        const unsigned w[8] = {v0.x, v0.y, v0.z, v0.w, v1.x, v1.y, v1.z, v1.w};
#pragma unroll
        for (int q = 0; q < 8; ++q) { Us[lane * 16 + 2 * q] = __uint_as_float(w[q] << 16); Us[lane * 16 + 2 * q + 1] = __uint_as_float(w[q] & 0xffff0000u); }
    }
    __syncthreads();
    f32x4 yacc[4];
#pragma unroll
    for (int s = 0; s < 4; ++s) yacc[s] = f32x4{0.f, 0.f, 0.f, 0.f};
#pragma unroll
    for (int dir = 0; dir < 2; ++dir) {
        const int pidx = ((l * 2 + dir) * 16 + g) * 64 + lane;
        const float4 lam = ((const float4*)(p.ws + OFF_LAMB))[pidx];
        float br[16], bi[16];
        {
            const float4* bb = (const float4*)((const float*)(p.ws + OFF_BBAR) + (size_t)pidx * 32);
#pragma unroll
            for (int q = 0; q < 8; ++q) { const float4 v = bb[q]; br[2 * q] = v.x; bi[2 * q] = v.y; br[2 * q + 1] = v.z; bi[2 * q + 1] = v.w; }
        }
        const size_t sidx = ((size_t)((b * 2 + dir) * NCHUNK + k) * 16 + g) * 64 + lane;
        float hr = 0.f, hi = 0.f;
        bf16x8 cfr[4];
        if (FINAL) {
            const float2 s0 = ((const float2*)(p.ws + OFF_S))[sidx];
            hr = s0.x; hi = s0.y;
            const bf16_t* cc = (const bf16_t*)(p.ws + OFF_CC) + (size_t)((l * 2 + dir) * 16 + g) * 2048 + (lane & 15) * 128 + (lane >> 4) * 8;
#pragma unroll
            for (int ks = 0; ks < 4; ++ks) cfr[ks] = *(const bf16x8*)(cc + 32 * ks);
        }
#pragma unroll
        for (int s = 0; s < 4; ++s) {
            const int sb = dir ? 3 - s : s;
#pragma unroll 1
            for (int tt = 0; tt < 16; ++tt) {
                const int tl = dir ? 15 - tt : tt, t = sb * 16 + tl;
                const float4* up = (const float4*)(Us + t * 16);
                float ar = 0.f, ai = 0.f;
#pragma unroll
                for (int q = 0; q < 4; ++q) {
                    const float4 u = up[q];
                    ar += br[4 * q] * u.x + br[4 * q + 1] * u.y + br[4 * q + 2] * u.z + br[4 * q + 3] * u.w;
                    ai += bi[4 * q] * u.x + bi[4 * q + 1] * u.y + bi[4 * q + 2] * u.z + bi[4 * q + 3] * u.w;
                }
                const float nr = lam.x * hr - lam.y * hi + ar, ni = lam.x * hi + lam.y * hr + ai;
                hr = nr; hi = ni;
                if (FINAL) { Hs[tl * 136 + lane] = f2bf(hr); Hs[tl * 136 + 64 + lane] = f2bf(hi); }
            }
            if (FINAL) {
                __syncthreads();
                const bf16_t* hp = Hs + (lane & 15) * 136 + (lane >> 4) * 8;
#pragma unroll
                for (int ks = 0; ks < 4; ++ks) { const bf16x8 a = *(const bf16x8*)(hp + 32 * ks); yacc[sb] = MFMA16(a, cfr[ks], yacc[sb]); }
                __syncthreads();
            }
        }
        if (!FINAL) ((float2*)(p.ws + OFF_E))[sidx] = make_float2(hr, hi);
    }
    if (FINAL) {
        bf16_t* S5P = (bf16_t*)(p.ws + OFF_S5P);
        const int hcol = lane & 15;
        const float dg = p.in[20][l * 256 + g * 16 + hcol];
#pragma unroll
        for (int s = 0; s < 4; ++s)
#pragma unroll
            for (int j = 0; j < 4; ++j) {
                const int t = s * 16 + (lane >> 4) * 4 + j;
                const float y = yacc[s][j] + dg * Us[t * 16 + hcol];
                S5P[(size_t)(rbase + t) * 256 + g * 16 + hcol] = f2bf(gelu_tanh(y));
            }
    }
    __syncthreads();
}

DI void s5_carry(const KP& p, int l, int blk) {
    const int idx = blk * 256 + TIDX();
    const int gp = idx & 1023, dir = (idx >> 10) & 1, b = idx >> 11;
    const float4 lam = ((const float4*)(p.ws + OFF_LAMB))[(l * 2 + dir) * 1024 + gp];
    const float2* E = (const float2*)(p.ws + OFF_E) + (size_t)(b * 2 + dir) * NCHUNK * 1024 + gp;
    float2* S = (float2*)(p.ws + OFF_S) + (size_t)(b * 2 + dir) * NCHUNK * 1024 + gp;
    float sr = 0.f, si = 0.f;
    for (int j0 = 0; j0 < NCHUNK; j0 += 4) {
        const int k0 = dir ? (j0 < 4 ? 3 - j0 : 263 - j0) : j0, stp = dir ? -1 : 1;
        const float2 e0 = E[(size_t)k0 * 1024], e1 = E[(size_t)(k0 + stp) * 1024], e2 = E[(size_t)(k0 + 2 * stp) * 1024], e3 = E[(size_t)(k0 + 3 * stp) * 1024];
        float nr, ni;
        S[(size_t)k0 * 1024] = make_float2(sr, si);
        nr = lam.z * sr - lam.w * si + e0.x; ni = lam.z * si + lam.w * sr + e0.y; sr = nr; si = ni;
        S[(size_t)(k0 + stp) * 1024] = make_float2(sr, si);
        nr = lam.z * sr - lam.w * si + e1.x; ni = lam.z * si + lam.w * sr + e1.y; sr = nr; si = ni;
        S[(size_t)(k0 + 2 * stp) * 1024] = make_float2(sr, si);
        nr = lam.z * sr - lam.w * si + e2.x; ni = lam.z * si + lam.w * sr + e2.y; sr = nr; si = ni;
        S[(size_t)(k0 + 3 * stp) * 1024] = make_float2(sr, si);
        nr = lam.z * sr - lam.w * si + e3.x; ni = lam.z * si + lam.w * sr + e3.y; sr = nr; si = ni;
    }
}

DI void attn_item(const KP& p, int it, char* smem) {
    const bf16_t* Q = (const bf16_t*)(p.ws + OFF_Q);
    const bf16_t* Kg = (const bf16_t*)(p.ws + OFF_K);
    const bf16_t* Vg = (const bf16_t*)(p.ws + OFF_VT);
    bf16_t* MIX = (bf16_t*)(p.ws + OFF_MIX);
    const int tid = TIDX(), lane = tid & 63, wave = tid >> 6, l31 = lane & 31, hh = lane >> 5;
    int bh, qrow0, kt0, T;
    if (it < 1024) { bh = it >> 6; qrow0 = (bh >> 3) * SEQ + (it & 63) * 256; kt0 = 0; T = NCHUNK; }
    else { bh = it - 1024; qrow0 = NL + (bh >> 3) * CTXL; kt0 = SEQ / 64; T = CTXL / 64; }
    const int head = bh & 7;
    const bf16_t* Kb = Kg + (size_t)bh * LK * DK + (size_t)kt0 * 64 * DK;
    const bf16_t* Vb = Vg + (size_t)bh * 64 * LK + kt0 * 64;
    bf16_t* sK = (bf16_t*)smem;
    bf16_t* sV = sK + 2 * 64 * 104;
    const int qrow = qrow0 + wave * 64 + l31;
    bf16x8 qf[2][6];
#pragma unroll
    for (int qb = 0; qb < 2; ++qb)
#pragma unroll
        for (int s = 0; s < 6; ++s) qf[qb][s] = *(const bf16x8*)(Q + (size_t)(qrow + 32 * qb) * 768 + head * 96 + 16 * s + 8 * hh);
    f32x16 o[2][2];
#pragma unroll
    for (int i = 0; i < 16; ++i) { o[0][0][i] = 0.f; o[0][1][i] = 0.f; o[1][0][i] = 0.f; o[1][1][i] = 0.f; }
    float m_run[2] = {-1e30f, -1e30f}, l_run[2] = {0.f, 0.f};
    u32x4 rk0, rk1, rk2, rv0, rv1;
    const int vrow = tid >> 3, vcol = (tid & 7) * 8;
    const int kw0 = (tid / 12) * 104 + (tid % 12) * 8, kw1 = ((tid + 256) / 12) * 104 + ((tid + 256) % 12) * 8, kw2 = ((tid + 512) / 12) * 104 + ((tid + 512) % 12) * 8;
    const bf16_t* cK = sK + l31 * 104 + 8 * hh;
    const bf16_t* cV = sV + l31 * 72 + 8 * hh;
#define ATT_KWRITE(buf_) do { bf16_t* k_ = sK + (buf_) * 64 * 104; *(u32x4*)(k_ + kw0) = rk0; *(u32x4*)(k_ + kw1) = rk1; *(u32x4*)(k_ + kw2) = rk2; } while (0)
#define ATT_VWRITE(buf_) do { bf16_t* v_ = sV + (buf_) * 64 * 72 + vrow * 72 + vcol; *(u32x4*)(v_) = rv0; *(u32x4*)(v_ + 32 * 72) = rv1; } while (0)
    {
        const bf16_t* kp = Kb + tid * 8;
        rk0 = *(const u32x4*)(kp); rk1 = *(const u32x4*)(kp + 2048); rk2 = *(const u32x4*)(kp + 4096);
        const bf16_t* vp = Vb + (size_t)vrow * LK + vcol;
        rv0 = *(const u32x4*)(vp); rv1 = *(const u32x4*)(vp + (size_t)32 * LK);
        ATT_KWRITE(0); ATT_VWRITE(0);
    }
    __syncthreads();
    for (int t = 0; t < T; ++t) {
        const int buf = t & 1;
        const bool more = (t + 1) < T;
        if (more) {
            const bf16_t* kp_ = Kb + (size_t)(t + 1) * 64 * DK + tid * 8; gld16(rk0, kp_); gld16(rk1, kp_ + 2048); gld16(rk2, kp_ + 4096);
            const bf16_t* vp_ = Vb + (size_t)vrow * LK + (t + 1) * 64 + vcol; gld16(rv0, vp_); gld16(rv1, vp_ + (size_t)32 * LK);
        }
#pragma unroll
        for (int kb = 0; kb < 2; ++kb) {
            f32x16 s[2];
#pragma unroll
            for (int i = 0; i < 16; ++i) { s[0][i] = 0.f; s[1][i] = 0.f; }
            bf16x8 kf[6];
#pragma unroll
            for (int ks = 0; ks < 6; ++ks) kf[ks] = *(const bf16x8*)(cK + buf * 64 * 104 + kb * 32 * 104 + 16 * ks);
            __builtin_amdgcn_sched_barrier(0);
            __builtin_amdgcn_s_setprio(1);
#pragma unroll
            for (int ks = 0; ks < 6; ++ks) {
                s[0] = MFMA32(kf[ks], qf[0][ks], s[0]);
                s[1] = MFMA32(kf[ks], qf[1][ks], s[1]);
            }
            __builtin_amdgcn_s_setprio(0);
#pragma unroll
            for (int qb = 0; qb < 2; ++qb) {
                float mx = s[qb][0];
#pragma unroll
                for (int i = 1; i < 16; ++i) mx = fmaxf(mx, s[qb][i]);
                mx = xhalf_max(mx);
                const float m_new = fmaxf(m_run[qb], mx);
                if (__builtin_amdgcn_ballot_w64(m_new > m_run[qb]) != 0ull) {
                    const float alpha = __builtin_amdgcn_exp2f(m_run[qb] - m_new);
                    m_run[qb] = m_new; l_run[qb] *= alpha;
#pragma unroll
                    for (int i = 0; i < 16; ++i) { o[qb][0][i] *= alpha; o[qb][1][i] *= alpha; }
                }
                float ps = 0.f;
#pragma unroll
                for (int i = 0; i < 16; ++i) { s[qb][i] = __builtin_amdgcn_exp2f(s[qb][i] - m_run[qb]); ps += s[qb][i]; }
                l_run[qb] += ps;
            }
            bf16x8 vf[2][2];
#pragma unroll
            for (int u = 0; u < 2; ++u)
#pragma unroll
                for (int dvb = 0; dvb < 2; ++dvb) vf[u][dvb] = *(const bf16x8*)(cV + buf * 64 * 72 + dvb * 32 * 72 + 32 * kb + 16 * u);
            __builtin_amdgcn_sched_barrier(0);
#pragma unroll
            for (int u = 0; u < 2; ++u) {
                const bf16x8 p0 = __builtin_bit_cast(bf16x8, u32x4{pack2(s[0][8 * u], s[0][8 * u + 1]), pack2(s[0][8 * u + 2], s[0][8 * u + 3]), pack2(s[0][8 * u + 4], s[0][8 * u + 5]), pack2(s[0][8 * u + 6], s[0][8 * u + 7])});
                const bf16x8 p1 = __builtin_bit_cast(bf16x8, u32x4{pack2(s[1][8 * u], s[1][8 * u + 1]), pack2(s[1][8 * u + 2], s[1][8 * u + 3]), pack2(s[1][8 * u + 4], s[1][8 * u + 5]), pack2(s[1][8 * u + 6], s[1][8 * u + 7])});
                __builtin_amdgcn_s_setprio(1);
#pragma unroll
                for (int dvb = 0; dvb < 2; ++dvb) {
                    o[0][dvb] = MFMA32(vf[u][dvb], p0, o[0][dvb]);
                    o[1][dvb] = MFMA32(vf[u][dvb], p1, o[1][dvb]);
                }
                __builtin_amdgcn_s_setprio(0);
            }
        }
        if (more) { vm_wait5(rk0, rk1, rk2, rv0, rv1); ATT_KWRITE(buf ^ 1); ATT_VWRITE(buf ^ 1); }
        __syncthreads();
    }
#undef ATT_KWRITE
#undef ATT_VWRITE
#pragma unroll
    for (int qb = 0; qb < 2; ++qb) {
        const float lt = xhalf_sum(l_run[qb]);
        const float inv = 1.f / lt;
#pragma unroll
        for (int dvb = 0; dvb < 2; ++dvb)
#pragma unroll
            for (int q = 0; q < 4; ++q) {
                uint2 ov; ov.x = pack2(o[qb][dvb][4 * q] * inv, o[qb][dvb][4 * q + 1] * inv); ov.y = pack2(o[qb][dvb][4 * q + 2] * inv, o[qb][dvb][4 * q + 3] * inv);
                *(uint2*)(MIX + (size_t)(qrow + 32 * qb) * DMIX + 768 + head * 64 + 32 * dvb + 8 * q + 4 * hh) = ov;
            }
    }
}

PH_FN void misc_phase(const KP& p, int l, char* smem) {
    const int n_qkv = 260 * 14, n_cp = l == 1 ? 1024 : 1040, n_s5 = 2 * NCHUNK * 4;
    const int rot = (blockIdx.x + gridDim.x / 2) % gridDim.x;
    for (int it = vblock(); it < n_qkv; it += gridDim.x) qkv_item(p, l, it, smem);
    for (int it = rot; it < n_cp; it += gridDim.x) convpool_item(p, l, it, smem);
    for (int it = blockIdx.x; it < n_s5; it += gridDim.x) s5_item<false>(p, l, it, smem);
#if MISC_DUP == 1
    for (int it = vblock(); it < n_qkv; it += gridDim.x) qkv_item(p, l, it, smem);
#elif MISC_DUP == 2
    for (int it = rot; it < n_cp; it += gridDim.x) convpool_item(p, l, it, smem);
#elif MISC_DUP == 3
    for (int it = blockIdx.x; it < n_s5; it += gridDim.x) s5_item<false>(p, l, it, smem);
#endif
}
PH_FN void attn_phase(const KP& p, int l, char* smem) {
    const int n_att = l == 1 ? 1024 : 1024 + 16;
    if (blockIdx.x < 16) s5_carry(p, l, blockIdx.x);
    for (int it = vblock(); it < n_att; it += gridDim.x) attn_item(p, it, smem);
}
PH_FN void s5fin_phase(const KP& p, int l, char* smem) {
    for (int it = blockIdx.x; it < 2 * NCHUNK * 4; it += gridDim.x) s5_item<true>(p, l, it, smem);
}

DI void run_phase(const KP& p, int ph, char* smem) {
    if (ph == 0) { prep_phase(p, smem); return; }
    if (ph == 27) {
        rowop_phase(p, 1, 8, 0.5f, p.in[7] + (1 * 3 + 2) * D, true, 0, 0, nullptr, false, false, NL);
        return;
    }
    const int l = (ph - 1) / 13, s = (ph - 1) % 13;
    const bf16_t* Wl = (const bf16_t*)(p.ws + OFF_W) + (size_t)l * WL_EL;
    const float* npre = p.in[6] + (size_t)l * 3 * D;
    const float* npost = p.in[7] + (size_t)l * 3 * D;
    const bool lastl = l == 1;
    switch (s) {
    case 0:
        if (l == 0) rowop_phase(p, 0, 0, 0.f, nullptr, false, 0, 0, npre, true, true);
        else rowop_phase(p, l - 1, 8, 0.5f, p.in[7] + ((l - 1) * 3 + 2) * D, true, l, 0, npre, true, false);
        break;
    case 1: case 11: gemm1_phase(p, l, s == 11, smem, (lastl && s == 11) ? NL / 256 : NT / 256); break;
    case 2: case 9: case 12: {
        const bool isout = s == 9;
        const bf16_t* Ag = (const bf16_t*)(p.ws + (isout ? OFF_MIX : OFF_ACT));
        const bf16_t* Wg = Wl + (isout ? WO_OUT : (s == 12 ? WO_D1 : WO_D0));
        const int Kg = isout ? DMIX : FF;
        gemm_store_phase256<D>(Ag, Kg, Wg, Kg, 8, (bf16_t*)(p.ws + OFF_HY), smem, NL / 256, (lastl && s != 2) ? 0 : NC / 128);
    } break;
    case 3: rowop_phase(p, l, 2, 0.5f, npost, true, l, 3, npre + D, true, l == 0); break;
    case 4: gemm_store_phase256<DIN>((const bf16_t*)(p.ws + OFF_HY), D, Wl + WO_IN, D, 12, (bf16_t*)(p.ws + OFF_Z), smem, NL / 256, NC / 128); break;
    case 5: misc_phase(p, l, smem); break;
    case 6: attn_phase(p, l, smem); break;
    case 7: s5fin_phase(p, l, smem); break;
    case 8: glu_phase(p, l, smem); break;
    case 10: rowop_phase(p, l, 5, 1.0f, npost + D, true, l, 6, npre + 2 * D, true, false, lastl ? NL : NT); break;
    }
}

constexpr int N_PHASES = 28;

__global__ void __launch_bounds__(256, 2) mega_kernel(KP p, int ph_lo, int ph_hi) {
    __shared__ __attribute__((aligned(16))) char smem[65536];
    __shared__ KP s_kp;
    if (TIDX() < 33) s_kp.in[TIDX()] = p.in[TIDX()];
    if (TIDX() == 33) s_kp.out = p.out;
    if (TIDX() == 34) s_kp.ws = p.ws;
    __shared__ uint4 xb_words;
    if (TIDX() == 0) xb_words = make_uint4(0u, 0u, 0u, 0u);
    __syncthreads();
    XcdBarrier xb = xcd_barrier_post((unsigned*)(p.ws + OFF_BAR), (volatile LAS unsigned*)&xb_words);
    for (int ph = ph_lo; ph < ph_hi; ++ph) {
        run_phase(p, ph, smem);
        if (DUP_MASK) {
            const int sbit = ph == 0 ? 13 : (ph == 27 ? 14 : (ph - 1) % 13);
            if ((DUP_MASK >> sbit) & 1) { xcd_barrier(xb); run_phase(p, ph, smem); }
        }
#if PROBE_MODE
        {
            const int sb = ph == 0 || ph == 27 ? -1 : (ph - 1) % 13, pl = (ph - 1) / 13;
            const bf16_t* Wl = (const bf16_t*)(s_kp.ws + OFF_W) + (size_t)pl * WL_EL;
            if (sb == 1 || sb == 11) { cg::this_grid().sync(); gemm1_phase<PROBE_MODE>(s_kp, pl, sb == 11, smem); }
            if (sb == 2 || sb == 12) { cg::this_grid().sync(); gemm_store_phase<PROBE_MODE>((const bf16_t*)(s_kp.ws + OFF_ACT), FF, Wl + (sb == 12 ? WO_D1 : WO_D0), FF, 8, (bf16_t*)(s_kp.ws + OFF_HY), D, D, smem); }
        }
#endif
        if (EXTRA_SYNCS) { xcd_barrier(xb); xcd_barrier(xb); }
        if (ph + 1 < ph_hi) { if (ph_hi < 0) cg::this_grid().sync(); else xcd_barrier(xb); }
    }
}

extern "C" void kernel_launch(void* const* d_in, const int* in_sizes, int n_in, void* d_out, int out_size, void* d_ws, size_t ws_size, hipStream_t stream) {
    static int grid = 0;
    if (grid == 0) {
        if (n_in != 33 || ws_size < WS_END) { fprintf(stderr, "kernel_launch: unexpected n_in %d or ws_size %zu < %zu\n", n_in, ws_size, (size_t)WS_END); grid = -1; return; }
        int dev = 0, cus = 0, per_cu = 0;
        hipGetDevice(&dev);
        hipDeviceGetAttribute(&cus, hipDeviceAttributeMultiprocessorCount, dev);
        hipOccupancyMaxActiveBlocksPerMultiprocessor(&per_cu, (const void*)mega_kernel, 256, 0);
        if (per_cu < 1) per_cu = 1;
        if (per_cu > 2) per_cu = 2;
        grid = cus * per_cu;
    }
    if (grid < 0) return;
    KP p{};
    for (int i = 0; i < 33; ++i) p.in[i] = (const float*)d_in[i];
    p.out = (float*)d_out; p.ws = (char*)d_ws;
    if (hipMemsetAsync((char*)d_ws + OFF_BAR, 0, 3456 * 4, stream) != hipSuccess) { fprintf(stderr, "kernel_launch: memset of barrier words failed\n"); return; }
#if ONE_LAUNCH
    int lo = 0, hi = N_PHASES;
    void* args[] = {&p, &lo, &hi};
    hipError_t e = hipLaunchCooperativeKernel((const void*)mega_kernel, dim3(grid), dim3(256), args, 0, stream);
    if (e != hipSuccess) fprintf(stderr, "cooperative launch failed: %s (grid %d)\n", hipGetErrorString(e), grid);
#else
    for (int ph = 0; ph < N_PHASES; ++ph) hipLaunchKernelGGL(mega_kernel, dim3(grid), dim3(256), 0, stream, p, ph, ph + 1);
#endif
}
```

```cpp
#include <hip/hip_runtime.h>
#include <hip/hip_cooperative_groups.h>
#include <cstdio>
#include <cstdint>
namespace cg = cooperative_groups;

#ifndef ONE_LAUNCH
#define ONE_LAUNCH 1
#endif
#define PROBE_MODE 0
#define EXTRA_SYNCS 0
#define MISC_DUP 0
#define ATT_PROBE 0
#define DUP_MASK 0

#define DI __device__ __forceinline__
#define PH_FN __device__ __forceinline__
typedef unsigned short bf16_t;
using bf16x8 = __attribute__((ext_vector_type(8))) short;
using f32x16 = __attribute__((ext_vector_type(16))) float;
using f32x4 = __attribute__((ext_vector_type(4))) float;
typedef unsigned u32x4 __attribute__((ext_vector_type(4)));
typedef __bf16 bf16x2_t __attribute__((ext_vector_type(2)));
typedef float f2_t __attribute__((ext_vector_type(2)));
typedef float f4_t __attribute__((ext_vector_type(4)));
typedef unsigned u2_t __attribute__((ext_vector_type(2)));

constexpr int D = 1024, SEQ = 16384, NB = 2, CTXL = 256;
constexpr int NL = NB * SEQ, NC = NB * CTXL, NT = NL + NC;
constexpr int FF = 2816, DIN = 1440, DMIX = 1280;
constexpr int NH = 8, DK = 96, LK = SEQ + CTXL;
constexpr int IN_CONV = 256, IN_POOL = 768, IN_CQ = 1024, IN_CKV = 1280, IN_KR = 1408;
constexpr int NCHUNK = LK / 64;
constexpr float EPS = 1e-6f;
constexpr float QSCALE = 0.10206207261596575f * 1.4426950408889634f;

constexpr size_t EL_GU = 5632ull * 1024, EL_D = 1024ull * 2816, EL_IN = 1536ull * 1024, EL_OUT = 1024ull * 1280,
                 EL_UQ = 768ull * 256, EL_UKV = 1024ull * 128, EL_GLU = 256ull * 256;
constexpr size_t WO_GU0 = 0, WO_GU1 = EL_GU, WO_D0 = 2 * EL_GU, WO_D1 = WO_D0 + EL_D, WO_IN = WO_D1 + EL_D,
                 WO_OUT = WO_IN + EL_IN, WO_UQ = WO_OUT + EL_OUT, WO_UKV = WO_UQ + EL_UQ, WO_GLU = WO_UKV + EL_UKV,
                 WL_EL = WO_GLU + EL_GLU;
constexpr size_t al256(size_t x) { return (x + 255) & ~(size_t)255; }
constexpr size_t OFF_W = 0;
constexpr size_t OFF_MOD = al256(OFF_W + 2 * WL_EL * 2);
constexpr size_t OFF_ROPE = al256(OFF_MOD + 2ull * 3 * 9216 * 4);
constexpr size_t OFF_LAMB = al256(OFF_ROPE + 256ull * 8 * 2 * 4);
constexpr size_t OFF_BBAR = al256(OFF_LAMB + 2ull * 2048 * 16);
constexpr size_t OFF_CC = al256(OFF_BBAR + 2ull * 2048 * 32 * 4);
constexpr size_t OFF_XC = al256(OFF_CC + 2ull * 32 * 2048 * 2);
constexpr size_t OFF_HY = al256(OFF_XC + (size_t)NC * D * 4);
constexpr size_t OFF_BIG = al256(OFF_HY + (size_t)NT * D * 2);
constexpr size_t OFF_ACT = OFF_BIG;
constexpr size_t OFF_Z = OFF_BIG;
constexpr size_t OFF_Q = al256(OFF_Z + (size_t)NT * DIN * 2);
constexpr size_t OFF_K = al256(OFF_Q + (size_t)NT * 768 * 2);
constexpr size_t OFF_VT = al256(OFF_K + (size_t)NB * NH * LK * 96 * 2);
constexpr size_t OFF_MIX = al256(OFF_VT + (size_t)NB * NH * 64 * LK * 2);
constexpr size_t OFF_S5P = al256(OFF_MIX + (size_t)NT * DMIX * 2);
constexpr size_t OFF_E = al256(OFF_S5P + (size_t)NT * 256 * 2);
constexpr size_t OFF_S = al256(OFF_E + 2ull * 2 * NCHUNK * 1024 * 8);
constexpr size_t OFF_BAR = al256(OFF_S + 2ull * 2 * NCHUNK * 1024 * 8);
constexpr size_t WS_END = al256(OFF_BAR + 3456 * 4);
static_assert(OFF_ACT + (size_t)NT * FF * 2 <= WS_END, "act fits");

struct KP { const float* in[33]; float* out; char* ws; };

DI int TIDX() { int t = threadIdx.x; asm volatile("" : "+v"(t)); return t; }
DI float bf2f(bf16_t b) { return __uint_as_float((unsigned)b << 16); }
DI unsigned pack2(float a, float b) { f2_t v = {a, b}; bf16x2_t r = __builtin_convertvector(v, bf16x2_t); return __builtin_bit_cast(unsigned, r); }
DI bf16_t f2bf(float a) { return (bf16_t)(pack2(a, 0.f) & 0xffffu); }
DI float fast_exp(float x) { return __builtin_amdgcn_exp2f(x * 1.4426950408889634f); }
DI float sigmoidf_(float x) { return __builtin_amdgcn_rcpf(1.f + fast_exp(-x)); }
DI float siluf_(float x) { return x * sigmoidf_(x); }
DI float gelu_tanh(float x) { float u = 0.7978845608028654f * (x + 0.044715f * x * x * x); float t = 1.f - 2.f * __builtin_amdgcn_rcpf(1.f + fast_exp(2.f * u)); return 0.5f * x * (1.f + t); }
DI float shflx(float v, int m) { const int idx = ((TIDX() & 63) ^ m) << 2; return __int_as_float(__builtin_amdgcn_ds_bpermute(idx, __float_as_int(v))); }
DI float xhalf_max(float v) { const auto r = __builtin_amdgcn_permlane32_swap(__float_as_uint(v), __float_as_uint(v), false, false); return fmaxf(__uint_as_float(r[0]), __uint_as_float(r[1])); }
DI float xhalf_sum(float v) { const auto r = __builtin_amdgcn_permlane32_swap(__float_as_uint(v), __float_as_uint(v), false, false); return __uint_as_float(r[0]) + __uint_as_float(r[1]); }
DI float wave_sum(float v) { for (int m = 32; m >= 1; m >>= 1) v += shflx(v, m); return v; }
DI int crow(int i, int hh) { return (i & 3) + 8 * (i >> 2) + 4 * hh; }
DI int row_mod(int row) { return row < NL ? (row >= SEQ ? 1 : 0) : 2; }
DI int vblock() { const int G = gridDim.x, b = blockIdx.x; return (G & 7) ? b : (G >> 3) * (b & 7) + (b >> 3); }
DI void tile_mn(int it, int TM, int TN, int& mt, int& nt) {
    const int band = it / (8 * TN), within = it - band * 8 * TN;
    const int gm = min(8, TM - 8 * band);
    nt = within / gm; mt = 8 * band + (within - nt * gm);
}
DI void gld16(u32x4& r, const void* p) { asm volatile("global_load_dwordx4 %0, %1, off" : "=&v"(r) : "v"(p) : "memory"); }
DI void vm_wait8(u32x4& a, u32x4& b, u32x4& c, u32x4& d, u32x4& e, u32x4& f, u32x4& g, u32x4& h) {
    asm volatile("s_waitcnt vmcnt(0)" : "+v"(a), "+v"(b), "+v"(c), "+v"(d), "+v"(e), "+v"(f), "+v"(g), "+v"(h) : : "memory"); }
DI void vm_wait5(u32x4& a, u32x4& b, u32x4& c, u32x4& d, u32x4& e) {
    asm volatile("s_waitcnt vmcnt(0)" : "+v"(a), "+v"(b), "+v"(c), "+v"(d), "+v"(e) : : "memory"); }
#define MFMA32(a, b, c) __builtin_amdgcn_mfma_f32_32x32x16_bf16((a), (b), (c), 0, 0, 0)
#define MFMA16(a, b, c) __builtin_amdgcn_mfma_f32_16x16x32_bf16((a), (b), (c), 0, 0, 0)

#define XB_TMO      128
#define XB_XCNT(j)  (256  + 64 * (j))
#define XB_XSUB(j)  (1280 + 64 * (j))
#define XB_XGEN(j)  (2304 + 64 * (j))
#define XB_TOP      3328
#define XB_TOPGEN   3392
#define XCD_BAR_WORDS 3456
#define XB_SPIN_CAP (1u << 18)
#define LAS __attribute__((address_space(3)))

__device__ __forceinline__ unsigned xb_ld(unsigned* p)              { return __hip_atomic_load(p, __ATOMIC_RELAXED, __HIP_MEMORY_SCOPE_AGENT); }
__device__ __forceinline__ unsigned xb_add(unsigned* p, unsigned v) { return __hip_atomic_fetch_add(p, v, __ATOMIC_RELAXED, __HIP_MEMORY_SCOPE_AGENT); }
__device__ __forceinline__ unsigned xb_xcc_id() { return (unsigned)__builtin_amdgcn_s_getreg((3 << 11) | 20) & 0xFu; }
#define XB_SPIN(cond, bar) do { unsigned _sp = 0; while (cond) { __builtin_amdgcn_s_sleep(1); \
    if ((++_sp & 255u) == 0u) { if (xb_ld(&(bar)[XB_TMO])) break; if (_sp > XB_SPIN_CAP) { atomicAdd(&(bar)[XB_TMO], 1u); break; } } } } while (0)

struct XcdBarrier {
    unsigned* bar; unsigned x;
    volatile LAS unsigned* st;
};

__device__ __forceinline__ XcdBarrier xcd_barrier_post(unsigned* bar, volatile LAS unsigned* st) {
    XcdBarrier b; b.bar = bar; b.x = xb_xcc_id(); b.st = st;
    if (TIDX() == 0) (void)xb_add(&bar[XB_XCNT(b.x)], 1u);
    return b;
}
__device__ __forceinline__ void xcd_barrier_complete(unsigned* bar, unsigned x, unsigned& nloc, unsigned& nx) {
    const unsigned G = gridDim.x * gridDim.y * gridDim.z;
    unsigned sum, cnt, mine, sp = 0u;
    for (;;) {
        sum = 0u; cnt = 0u; mine = 0u;
#pragma unroll
        for (unsigned j = 0; j < 16; ++j) { const unsigned c = xb_ld(&bar[XB_XCNT(j)]); sum += c; cnt += (c > 0u) ? 1u : 0u; mine = (j == x) ? c : mine; }
        if (sum == G) break;
        __builtin_amdgcn_s_sleep(1);
        if ((++sp & 255u) == 0u) { if (xb_ld(&bar[XB_TMO])) break; if (sp > XB_SPIN_CAP) { atomicAdd(&bar[XB_TMO], 1u); break; } }
    }
    nloc = mine > 0u ? mine : 1u; nx = cnt > 0u ? cnt : 1u;
}

__device__ __forceinline__ void xcd_barrier(const XcdBarrier& b) {
    asm volatile("s_waitcnt vmcnt(0)" ::: "memory");
    __syncthreads();
    if (TIDX() == 0) {
        unsigned* bar = b.bar;
        __builtin_amdgcn_s_waitcnt(0);
        unsigned nloc = b.st[0], nx = b.st[1];
        if (nloc == 0u) { xcd_barrier_complete(bar, b.x, nloc, nx); b.st[0] = nloc; b.st[1] = nx; }
        const unsigned old = xb_add(&bar[XB_XSUB(b.x)], 1u);
        const unsigned gen = old / nloc;
        if (old + 1u == (gen + 1u) * nloc) {
            __builtin_amdgcn_fence(__ATOMIC_RELEASE, "agent");
            asm volatile("s_waitcnt vmcnt(0)" ::: "memory");
            const unsigned og = xb_add(&bar[XB_TOP], 1u);
            const unsigned tg = og / nx;
            if (og + 1u == (tg + 1u) * nx) xb_add(&bar[XB_TOPGEN], 1u);
            else XB_SPIN(xb_ld(&bar[XB_TOPGEN]) == tg, bar);
            __builtin_amdgcn_fence(__ATOMIC_ACQUIRE, "agent");
            xb_add(&bar[XB_XGEN(b.x)], 1u);
            asm volatile("s_waitcnt vmcnt(0)" ::: "memory");
        } else {
            XB_SPIN(xb_ld(&bar[XB_XGEN(b.x)]) == gen, bar);
            __builtin_amdgcn_fence(__ATOMIC_ACQUIRE, "agent");
            asm volatile("s_waitcnt vmcnt(0)" ::: "memory");
        }
    }
    __syncthreads();
}


DI void vm_wait_sel(u32x4& a, u32x4& b, u32x4& c, u32x4& d, u32x4& e, u32x4& f, u32x4& g, u32x4& h, int all) {
    asm volatile("s_cmp_lg_u32 %8, 0\n\ts_cbranch_scc1 1f\n\ts_waitcnt vmcnt(8)\n\ts_branch 2f\n1:\n\ts_waitcnt vmcnt(0)\n2:"
                 : "+v"(a), "+v"(b), "+v"(c), "+v"(d), "+v"(e), "+v"(f), "+v"(g), "+v"(h) : "s"(all) : "memory", "scc"); }

template <int MODE = 0, class Epi>
DI void gemm_tile(const bf16_t* __restrict__ A, int lda, const bf16_t* __restrict__ Bt, int ldb, int K, int row0, int col0, char* smem, Epi&& epi) {
    bf16_t* sA = (bf16_t*)smem;
    bf16_t* sB = sA + 2 * 8192;
    const int tid = TIDX(), lane = tid & 63, wave = tid >> 6;
    const int wm = wave >> 1, wn = wave & 1, l31 = lane & 31, hh = lane >> 5;
    u32x4 r0a[4], r0b[4], r1a[4], r1b[4];
    const bf16_t* Ap = A + (size_t)(row0 + (tid >> 3)) * lda + (tid & 7) * 8;
    const bf16_t* Bp = Bt + (size_t)(col0 + (tid >> 3)) * ldb + (tid & 7) * 8;
    const int wr_off = (tid >> 3) * 64 + (((tid & 7) ^ ((tid >> 4) & 7)) * 8);
    f32x16 acc[2][2];
#pragma unroll
    for (int a = 0; a < 2; ++a)
#pragma unroll
        for (int b = 0; b < 2; ++b)
#pragma unroll
            for (int i = 0; i < 16; ++i) acc[a][b][i] = 0.f;
    const int nk = K >> 6;
#pragma unroll
    for (int i = 0; i < 4; ++i) { r0a[i] = *(const u32x4*)(Ap + (size_t)i * 32 * lda); r0b[i] = *(const u32x4*)(Bp + (size_t)i * 32 * ldb); }
#pragma unroll
    for (int i = 0; i < 4; ++i) { *(u32x4*)(sA + wr_off + i * 2048) = r0a[i]; *(u32x4*)(sB + wr_off + i * 2048) = r0b[i]; }
#pragma unroll
    for (int i = 0; i < 4; ++i) { gld16(r1a[i], Ap + (size_t)i * 32 * lda + 64); gld16(r1b[i], Bp + (size_t)i * 32 * ldb + 64); }
    __syncthreads();
    const int sw = (l31 >> 1) & 7;
    const bf16_t* cA = sA + (wm * 64 + l31) * 64;
    const bf16_t* cB = sB + (wn * 64 + l31) * 64;
#define GEMM_LDFRAG(buf_, ks_, a0_, a1_, b0_, b1_) do { const int ch = ((2 * (ks_) + hh) ^ sw) * 8; \
            a0_ = *(const bf16x8*)(cA + (buf_) * 8192 + ch); a1_ = *(const bf16x8*)(cA + (buf_) * 8192 + 32 * 64 + ch); \
            b0_ = *(const bf16x8*)(cB + (buf_) * 8192 + ch); b1_ = *(const bf16x8*)(cB + (buf_) * 8192 + 32 * 64 + ch); } while (0)
#define GEMM_MMA(a0_, a1_, b0_, b1_) do { acc[0][0] = MFMA32(a0_, b0_, acc[0][0]); acc[0][1] = MFMA32(a0_, b1_, acc[0][1]); \
            acc[1][0] = MFMA32(a1_, b0_, acc[1][0]); acc[1][1] = MFMA32(a1_, b1_, acc[1][1]); } while (0)
#define SB_ __builtin_amdgcn_sched_barrier(0)
#define GEMM_COMPUTE(buf_) do { bf16x8 pa0, pa1, pb0, pb1, qa0, qa1, qb0, qb1; \
            GEMM_LDFRAG(buf_, 0, pa0, pa1, pb0, pb1); GEMM_LDFRAG(buf_, 1, qa0, qa1, qb0, qb1); SB_; GEMM_MMA(pa0, pa1, pb0, pb1); SB_; \
            GEMM_LDFRAG(buf_, 2, pa0, pa1, pb0, pb1); SB_; GEMM_MMA(qa0, qa1, qb0, qb1); SB_; \
            GEMM_LDFRAG(buf_, 3, qa0, qa1, qb0, qb1); SB_; GEMM_MMA(pa0, pa1, pb0, pb1); SB_; GEMM_MMA(qa0, qa1, qb0, qb1); SB_; } while (0)
    for (int kt = 0; kt < nk; kt += 2) {
        const bool m2 = (kt + 2) < nk, m3 = (kt + 3) < nk;
        if (m2 && MODE == 0) {
            const int k0 = (kt + 2) << 6;
#pragma unroll
            for (int i = 0; i < 4; ++i) { gld16(r0a[i], Ap + (size_t)i * 32 * lda + k0); gld16(r0b[i], Bp + (size_t)i * 32 * ldb + k0); }
        }
        GEMM_COMPUTE(0);
        vm_wait_sel(r1a[0], r1a[1], r1a[2], r1a[3], r1b[0], r1b[1], r1b[2], r1b[3], __builtin_amdgcn_readfirstlane((m2 && MODE == 0) ? 0 : 1));
        if (MODE < 2)
#pragma unroll
        for (int i = 0; i < 4; ++i) { *(u32x4*)(sA + 8192 + wr_off + i * 2048) = r1a[i]; *(u32x4*)(sB + 8192 + wr_off + i * 2048) = r1b[i]; }
        __syncthreads();
        if (m3 && MODE == 0) {
            const int k0 = (kt + 3) << 6;
#pragma unroll
            for (int i = 0; i < 4; ++i) { gld16(r1a[i], Ap + (size_t)i * 32 * lda + k0); gld16(r1b[i], Bp + (size_t)i * 32 * ldb + k0); }
        }
        GEMM_COMPUTE(1);
        if (m2) {
            vm_wait_sel(r0a[0], r0a[1], r0a[2], r0a[3], r0b[0], r0b[1], r0b[2], r0b[3], __builtin_amdgcn_readfirstlane((m3 && MODE == 0) ? 0 : 1));
            if (MODE < 2)
#pragma unroll
            for (int i = 0; i < 4; ++i) { *(u32x4*)(sA + wr_off + i * 2048) = r0a[i]; *(u32x4*)(sB + wr_off + i * 2048) = r0b[i]; }
        }
        __syncthreads();
    }
#undef GEMM_COMPUTE
#undef GEMM_LDFRAG
#undef GEMM_MMA
    epi(acc, row0 + wm * 64, col0 + wn * 64);
}

DI const bf16_t* uni_ptr(const bf16_t* p) {
    const unsigned long long v = (unsigned long long)p;
    const unsigned lo = __builtin_amdgcn_readfirstlane((unsigned)v), hi = __builtin_amdgcn_readfirstlane((unsigned)(v >> 32));
    return (const bf16_t*)(((unsigned long long)hi << 32) | lo); }
DI void gld16s(u32x4& r, unsigned voff, const void* sbase) { asm volatile("global_load_dwordx4 %0, %1, %2" : "=&v"(r) : "v"(voff), "s"(sbase) : "memory"); }
DI void vm_wait12(u32x4& a, u32x4& b, u32x4& c, u32x4& d, u32x4& e, u32x4& f, u32x4& g, u32x4& h, u32x4& i, u32x4& j, u32x4& k, u32x4& l) {
    asm volatile("s_waitcnt vmcnt(0)" : "+v"(a), "+v"(b), "+v"(c), "+v"(d), "+v"(e), "+v"(f), "+v"(g), "+v"(h), "+v"(i), "+v"(j), "+v"(k), "+v"(l) : : "memory"); }

template <class Epi>
DI void gemm_tile256(const bf16_t* __restrict__ A, int lda, const bf16_t* __restrict__ Bt, int ldb, int K, int row0, int col0, char* smem, Epi&& epi) {
    bf16_t* sA = (bf16_t*)smem;
    bf16_t* sB = sA + 256 * 64;
    const int tid = TIDX(), lane = tid & 63, wave = tid >> 6;
    const int wm = wave >> 1, wn = wave & 1, l31 = lane & 31, hh = lane >> 5;
    u32x4 ra[8], rb[4];
    const bf16_t* Ab = uni_ptr(A + (size_t)row0 * lda);
    const bf16_t* Bb = uni_ptr(Bt + (size_t)col0 * ldb);
    const unsigned voa = ((unsigned)(tid >> 3) * (unsigned)lda + (tid & 7) * 8) * 2u;
    const unsigned vob = ((unsigned)(tid >> 3) * (unsigned)ldb + (tid & 7) * 8) * 2u;
    const int wr_off = (tid >> 3) * 64 + (((tid & 7) ^ ((tid >> 4) & 7)) * 8);
    f32x16 acc[4][2];
#pragma unroll
    for (int a = 0; a < 4; ++a)
#pragma unroll
        for (int b = 0; b < 2; ++b)
#pragma unroll
            for (int i = 0; i < 16; ++i) acc[a][b][i] = 0.f;
    const int nk = K >> 6;
#pragma unroll
    for (int i = 0; i < 8; ++i) gld16s(ra[i], voa, Ab + (size_t)i * 32 * lda);
#pragma unroll
    for (int i = 0; i < 4; ++i) gld16s(rb[i], vob, Bb + (size_t)i * 32 * ldb);
    const int sw = (l31 >> 1) & 7;
    const bf16_t* cA = sA + (wm * 128 + l31) * 64;
    const bf16_t* cB = sB + (wn * 64 + l31) * 64;
    for (int kt = 0; kt < nk; ++kt) {
        vm_wait12(ra[0], ra[1], ra[2], ra[3], ra[4], ra[5], ra[6], ra[7], rb[0], rb[1], rb[2], rb[3]);
#pragma unroll
        for (int i = 0; i < 8; ++i) *(u32x4*)(sA + wr_off + i * 2048) = ra[i];
#pragma unroll
        for (int i = 0; i < 4; ++i) *(u32x4*)(sB + wr_off + i * 2048) = rb[i];
        __syncthreads();
        if (kt + 1 < nk) {
            const int k0 = (kt + 1) << 6;
#pragma unroll
            for (int i = 0; i < 8; ++i) gld16s(ra[i], voa, Ab + (size_t)i * 32 * lda + k0);
#pragma unroll
            for (int i = 0; i < 4; ++i) gld16s(rb[i], vob, Bb + (size_t)i * 32 * ldb + k0);
        }
        __builtin_amdgcn_s_setprio(1);
#pragma unroll
        for (int ks = 0; ks < 4; ++ks) {
            const int ch = ((2 * ks + hh) ^ sw) * 8;
            const bf16x8 b0 = *(const bf16x8*)(cB + ch), b1 = *(const bf16x8*)(cB + 32 * 64 + ch);
#pragma unroll
            for (int mi = 0; mi < 4; ++mi) {
                const bf16x8 a = *(const bf16x8*)(cA + mi * 32 * 64 + ch);
                acc[mi][0] = MFMA32(a, b0, acc[mi][0]);
                acc[mi][1] = MFMA32(a, b1, acc[mi][1]);
            }
        }
        __builtin_amdgcn_s_setprio(0);
        __syncthreads();
    }
    epi(acc, row0 + wm * 128, col0 + wn * 64);
}

DI void transpose_store(bf16_t* dst, int K, int n0, int k0, const float* tile) {
    const int kp = TIDX() & 31, nn = TIDX() >> 5;
#pragma unroll
    for (int i = 0; i < 8; ++i) {
        const int n = nn + 8 * i;
        *(unsigned*)(dst + (size_t)(n0 + n) * K + k0 + 2 * kp) = pack2(tile[(2 * kp) * 65 + n], tile[(2 * kp + 1) * 65 + n]);
    }
}
template <class F>
DI void transpose_tile(bf16_t* dst, int K, int tn, int tk, F src, float* tile) {
    const int tx = TIDX() & 63, ty = TIDX() >> 6;
    const int n0 = tn * 64, k0 = tk * 64;
    float v[16];
#pragma unroll
    for (int i = 0; i < 16; ++i) v[i] = src(k0 + ty + 4 * i, n0 + tx);
#pragma unroll
    for (int i = 0; i < 16; ++i) tile[(ty + 4 * i) * 65 + tx] = v[i];
    __syncthreads();
    transpose_store(dst, K, n0, k0, tile);
    __syncthreads();
}
DI void poolfold_tile(bf16_t* dst, int tn, int tk, const float* wi, const float* pw, const float* ps, float* smemf) {
    float* wt = smemf;
    float* pt = smemf + 64 * 65;
    float* ot = pt + 64 * 64;
    const int tx = TIDX() & 63, ty = TIDX() >> 6;
    const int n0 = tn * 64, k0 = tk * 64, g = (n0 - IN_POOL) >> 6;
    const float sc = ps[g * 64 + tx];
#pragma unroll
    for (int i = 0; i < 16; ++i) {
        const int r = ty + 4 * i;
        wt[r * 65 + tx] = wi[(size_t)(k0 + r) * DIN + IN_POOL + g * 64 + tx];
        pt[r * 64 + tx] = pw[g * 4096 + r * 64 + tx] * sc;
    }
    __syncthreads();
    float acc[16];
#pragma unroll
    for (int i = 0; i < 16; ++i) acc[i] = 0.f;
    for (int ii = 0; ii < 64; ++ii) {
        const float pv = pt[ii * 64 + tx];
#pragma unroll
        for (int i = 0; i < 16; ++i) acc[i] += wt[(ty + 4 * i) * 65 + ii] * pv;
    }
#pragma unroll
    for (int i = 0; i < 16; ++i) ot[(ty + 4 * i) * 65 + tx] = acc[i];
    __syncthreads();
    transpose_store(dst, 1024, n0, k0, ot);
    __syncthreads();
}

PH_FN void prep_phase(const KP& p, char* smem) {
    float* tile = (float*)smem;
    bf16_t* W = (bf16_t*)(p.ws + OFF_W);
    const int NTR = 5024;
    const int n_items = 2 * NTR + 288 + 1 + 16;
    for (int it = blockIdx.x; it < n_items; it += gridDim.x) {
        if (it < 2 * NTR) {
            const int l = it / NTR; int r = it % NTR;
            bf16_t* Wl = W + (size_t)l * WL_EL;
            if (r < 2816) {
                const int f = r / 1408; r %= 1408;
                const float* g = p.in[8] + (size_t)(l * 2 + f) * D * FF;
                const float* u = p.in[9] + (size_t)(l * 2 + f) * D * FF;
                transpose_tile(Wl + (f ? WO_GU1 : WO_GU0), 1024, r / 16, r % 16, [&](int k, int n) {
                    const int j = n >> 7, w = n & 127, c = j * 64 + (w >> 6) * 32 + (w & 31);
                    return ((w >> 5) & 1) ? u[(size_t)k * FF + c] : g[(size_t)k * FF + c]; }, tile);
            } else if (r < 2816 + 1408) {
                r -= 2816; const int f = r / 704; r %= 704;
                const float* dn = p.in[10] + (size_t)(l * 2 + f) * FF * D;
                transpose_tile(Wl + (f ? WO_D1 : WO_D0), 2816, r / 44, r % 44, [&](int k, int n) { return dn[(size_t)k * D + n]; }, tile);
            } else if (r < 4224 + 384) {
                r -= 4224;
                const float* wi = p.in[11] + (size_t)l * D * DIN;
                const float* pw = p.in[27] + (size_t)l * 4 * 64 * 64;
                const float* ps = p.in[28] + (size_t)l * 256;
                const int tn = r / 16, tk = r % 16;
                if (tn >= IN_POOL / 64 && tn < IN_CQ / 64) poolfold_tile(Wl + WO_IN, tn, tk, wi, pw, ps, tile);
                else transpose_tile(Wl + WO_IN, 1024, tn, tk, [&](int k, int n) { return n < DIN ? wi[(size_t)k * DIN + n] : 0.f; }, tile);
            } else if (r < 4608 + 320) {
                r -= 4608;
                const float* wo = p.in[12] + (size_t)l * DMIX * D;
                transpose_tile(Wl + WO_OUT, 1280, r / 20, r % 20, [&](int k, int n) { return wo[(size_t)k * D + n]; }, tile);
            } else if (r < 4928 + 48) {
                r -= 4928;
                const float* wq = p.in[30] + (size_t)l * 256 * 768;
                const float* gn = p.in[29] + (size_t)l * 256;
                transpose_tile(Wl + WO_UQ, 256, r / 4, r % 4, [&](int k, int n) { return wq[(size_t)k * 768 + n] * gn[k] * QSCALE; }, tile);
            } else if (r < 4976 + 32) {
                r -= 4976;
                const float* wk = p.in[32] + (size_t)l * 128 * 1024;
                const float* gn = p.in[31] + (size_t)l * 128;
                transpose_tile(Wl + WO_UKV, 128, r / 2, r % 2, [&](int k, int n) { return wk[(size_t)k * 1024 + n] * gn[k]; }, tile);
            } else {
                r -= 5008;
                const float* wg = p.in[21] + (size_t)l * 256 * 256;
                transpose_tile(Wl + WO_GLU, 256, r / 4, r % 4, [&](int k, int n) { return wg[(size_t)k * 256 + n]; }, tile);
            }
        } else if (it < 2 * NTR + 288) {
            const int r = it - 2 * NTR, l = r / 144, n0 = (r % 144) * 64;
            float* sc = (float*)smem;
            float* red = sc + 3072;
            for (int i = TIDX(); i < 3072; i += 256) {
                const int v = i >> 10, k = i & 1023;
                const float cv = v < 2 ? p.in[1][v * 1024 + k] : p.in[3][k];
                sc[i] = cv / (1.f + expf(-cv));
            }
            __syncthreads();
            const int tx = TIDX() & 63, ty = TIDX() >> 6;
            const float* wa = p.in[4] + (size_t)l * D * 9216 + n0 + tx;
            float a0 = 0.f, a1 = 0.f, a2 = 0.f;
#pragma unroll 32
            for (int k = ty * 256; k < ty * 256 + 256; ++k) {
                const float w = wa[(size_t)k * 9216];
                a0 += sc[k] * w; a1 += sc[1024 + k] * w; a2 += sc[2048 + k] * w;
            }
            red[(ty * 3 + 0) * 64 + tx] = a0; red[(ty * 3 + 1) * 64 + tx] = a1; red[(ty * 3 + 2) * 64 + tx] = a2;
            __syncthreads();
            if (TIDX() < 192) {
                const int v = TIDX() >> 6;
                float s = p.in[5][l * 9216 + n0 + tx];
                for (int q = 0; q < 4; ++q) s += red[(q * 3 + v) * 64 + tx];
                ((float*)(p.ws + OFF_MOD))[(size_t)(l * 3 + v) * 9216 + n0 + tx] = s;
            }
            __syncthreads();
        } else if (it == 2 * NTR + 288) {
            float* tab = (float*)(p.ws + OFF_ROPE);
            const int pos = TIDX();
            for (int i = 0; i < 8; ++i) {
                const float inv = powf(10000.f, -(float)(2 * i) / 16.f);
                const float ang = (float)pos * inv;
                tab[(pos * 8 + i) * 2 + 0] = cosf(ang);
                tab[(pos * 8 + i) * 2 + 1] = sinf(ang);
            }
        } else {
            const int idx = (it - (2 * NTR + 289)) * 256 + TIDX();
            const int pp = idx & 63, g = (idx >> 6) & 15, ld = idx >> 10;
            float lr = fminf(p.in[13][idx], -1e-4f), li = p.in[14][idx];
            const float dt = expf(p.in[15][ld * 16 + g]);
            const float mag = expf(lr * dt);
            const float br = mag * cosf(li * dt), bi = mag * sinf(li * dt);
            float tr = br, ti = bi;
            for (int q = 0; q < 6; ++q) { const float nr = tr * tr - ti * ti, ni = 2.f * tr * ti; tr = nr; ti = ni; }
            ((float4*)(p.ws + OFF_LAMB))[idx] = make_float4(br, bi, tr, ti);
            const float nr = br - 1.f, ni = bi, den = 1.f / (lr * lr + li * li);
            const float cr = (nr * lr + ni * li) * den, ci = (ni * lr - nr * li) * den;
            float* bb = (float*)(p.ws + OFF_BBAR) + (size_t)idx * 32;
            const float* sbr = p.in[16] + (size_t)idx * 16; const float* sbi = p.in[17] + (size_t)idx * 16;
            for (int h = 0; h < 16; ++h) { const float xr = sbr[h], xi = sbi[h]; bb[2 * h] = cr * xr - ci * xi; bb[2 * h + 1] = cr * xi + ci * xr; }
            bf16_t* cc = (bf16_t*)(p.ws + OFF_CC) + (size_t)(ld * 16 + g) * 2048;
            const float* scr = p.in[18] + (size_t)(ld * 16 + g) * 1024; const float* sci = p.in[19] + (size_t)(ld * 16 + g) * 1024;
            for (int h = 0; h < 16; ++h) { cc[h * 128 + pp] = f2bf(scr[h * 64 + pp]); cc[h * 128 + 64 + pp] = f2bf(-sci[h * 64 + pp]); }
        }
    }
}

PH_FN void rowop_phase(const KP& p, int l_mod_post, int gate_idx, float coef, const float* gpost, bool has_y,
                    int l_mod_pre, int shift_idx, const float* gpre, bool has_pre, bool first, int nrows = NT) {
    const int lane = TIDX() & 63;
    const int wid = blockIdx.x * 4 + (TIDX() >> 6), nw = gridDim.x * 4;
    bf16_t* HY = (bf16_t*)(p.ws + OFF_HY);
    float* Xc = (float*)(p.ws + OFF_XC);
    const float* MOD = (const float*)(p.ws + OFF_MOD);
    for (int row0 = wid; row0 < nrows; row0 += 2 * nw) {
        int rows[2]; bool ok[2];
        rows[0] = row0; ok[0] = true;
        ok[1] = (row0 + nw) < nrows; rows[1] = ok[1] ? row0 + nw : row0;
        float* xp[2]; int mv[2];
        f4_t x[2][4], y[2][4];
        float ssy[2] = {0.f, 0.f};
#pragma unroll
        for (int q = 0; q < 2; ++q) {
            const int row = rows[q];
            mv[q] = row_mod(row);
            xp[q] = row < NL ? p.out + (size_t)row * D : Xc + (size_t)(row - NL) * D;
            const float* xin = first ? (row < NL ? p.in[0] + (size_t)row * D : p.in[2] + (size_t)(row - NL) * D) : xp[q];
#pragma unroll
            for (int i = 0; i < 4; ++i) x[q][i] = __builtin_nontemporal_load((const f4_t*)(xin + lane * 4 + 256 * i));
            if (has_y) {
#pragma unroll
                for (int i = 0; i < 4; ++i) {
                    const u2_t raw = __builtin_nontemporal_load((const u2_t*)(HY + (size_t)row * D + lane * 4 + 256 * i));
                    y[q][i].x = __uint_as_float(raw.x << 16); y[q][i].y = __uint_as_float(raw.x & 0xffff0000u);
                    y[q][i].z = __uint_as_float(raw.y << 16); y[q][i].w = __uint_as_float(raw.y & 0xffff0000u);
                    ssy[q] += y[q][i].x * y[q][i].x + y[q][i].y * y[q][i].y + y[q][i].z * y[q][i].z + y[q][i].w * y[q][i].w;
                }
            }
        }
        if (has_y) {
            for (int m = 32; m >= 1; m >>= 1) { ssy[0] += shflx(ssy[0], m); ssy[1] += shflx(ssy[1], m); }
#pragma unroll
            for (int q = 0; q < 2; ++q) {
                const float rstd = rsqrtf(ssy[q] * (1.f / D) + EPS);
                const float* gt = MOD + (size_t)(l_mod_post * 3 + mv[q]) * 9216 + gate_idx * 1024;
#pragma unroll
                for (int i = 0; i < 4; ++i) {
                    const float4 g = *(const float4*)(gt + lane * 4 + 256 * i);
                    const float4 w = *(const float4*)(gpost + lane * 4 + 256 * i);
                    x[q][i].x += coef * g.x * (y[q][i].x * rstd * w.x); x[q][i].y += coef * g.y * (y[q][i].y * rstd * w.y);
                    x[q][i].z += coef * g.z * (y[q][i].z * rstd * w.z); x[q][i].w += coef * g.w * (y[q][i].w * rstd * w.w);
                }
                if (ok[q]) {
#pragma unroll
                    for (int i = 0; i < 4; ++i) __builtin_nontemporal_store(x[q][i], (f4_t*)(xp[q] + lane * 4 + 256 * i));
                }
            }
        }
        if (has_pre) {
            float ssx[2];
#pragma unroll
            for (int q = 0; q < 2; ++q) {
                ssx[q] = 0.f;
#pragma unroll
                for (int i = 0; i < 4; ++i) ssx[q] += x[q][i].x * x[q][i].x + x[q][i].y * x[q][i].y + x[q][i].z * x[q][i].z + x[q][i].w * x[q][i].w;
            }
            for (int m = 32; m >= 1; m >>= 1) { ssx[0] += shflx(ssx[0], m); ssx[1] += shflx(ssx[1], m); }
#pragma unroll
            for (int q = 0; q < 2; ++q) {
                const float rstd = rsqrtf(ssx[q] * (1.f / D) + EPS);
                const float* sh = MOD + (size_t)(l_mod_pre * 3 + mv[q]) * 9216 + shift_idx * 1024;
                if (ok[q]) {
#pragma unroll
                    for (int i = 0; i < 4; ++i) {
                        const float4 s0 = *(const float4*)(sh + lane * 4 + 256 * i);
                        const float4 s1 = *(const float4*)(sh + 1024 + lane * 4 + 256 * i);
                        const float4 w = *(const float4*)(gpre + lane * 4 + 256 * i);
                        const float h0 = x[q][i].x * rstd * w.x * (1.f + s1.x) + s0.x, h1 = x[q][i].y * rstd * w.y * (1.f + s1.y) + s0.y;
                        const float h2 = x[q][i].z * rstd * w.z * (1.f + s1.z) + s0.z, h3 = x[q][i].w * rstd * w.w * (1.f + s1.w) + s0.w;
                        uint2 o; o.x = pack2(h0, h1); o.y = pack2(h2, h3);
                        *(uint2*)(HY + (size_t)rows[q] * D + lane * 4 + 256 * i) = o;
                    }
                }
            }
        }
    }
}

template <int MODE = 0>
PH_FN void gemm1_phase(const KP& p, int l, int f, char* smem, int ntm = NT / 256) {
    const bf16_t* H = (const bf16_t*)(p.ws + OFF_HY);
    const bf16_t* W = (const bf16_t*)(p.ws + OFF_W) + (size_t)l * WL_EL + (f ? WO_GU1 : WO_GU0);
    bf16_t* ACT = (bf16_t*)(p.ws + OFF_ACT);
    const int lane = TIDX() & 63, l31 = lane & 31, hh = lane >> 5;
    const int n_items = (NL / 256) * 44;
    const int n_ctx = ntm > NL / 256 ? (NC / 128) * 44 : 0;
    for (int it = vblock(); it < n_ctx; it += gridDim.x) {
        const int mt = it / 44, nt = it - mt * 44;
        gemm_tile(H, D, W, D, D, NL + mt * 128, nt * 128, smem, [&](f32x16 (&acc)[2][2], int r0, int c0) {
            const int col = (c0 >> 7) * 64 + ((c0 >> 6) & 1) * 32 + l31;
#pragma unroll
            for (int mi = 0; mi < 2; ++mi)
#pragma unroll
                for (int i = 0; i < 16; ++i) ACT[(size_t)(r0 + 32 * mi + crow(i, hh)) * FF + col] = f2bf(siluf_(acc[mi][0][i]) * acc[mi][1][i]);
        });
    }
    for (int it = vblock(); it < n_items; it += gridDim.x) {
        int mt, nt; tile_mn(it, NL / 256, 44, mt, nt);
        gemm_tile256(H, D, W, D, D, mt * 256, nt * 128, smem, [&](f32x16 (&acc)[4][2], int r0, int c0) {
            const int col = (c0 >> 7) * 64 + ((c0 >> 6) & 1) * 32 + l31;
#pragma unroll
            for (int mi = 0; mi < 4; ++mi)
#pragma unroll
                for (int i = 0; i < 16; ++i) {
                    const int row = r0 + 32 * mi + crow(i, hh);
                    ACT[(size_t)row * FF + col] = f2bf(siluf_(acc[mi][0][i]) * acc[mi][1][i]);
                }
        });
    }
}

template <int MODE = 0>
PH_FN void gemm_store_phase(const bf16_t* A, int lda, const bf16_t* W, int K, int ntn, bf16_t* C, int ldc, int ncols, char* smem, int ntm = NT / 128) {
    const int lane = TIDX() & 63, l31 = lane & 31, hh = lane >> 5;
    const int n_items = ntm * ntn;
    for (int it = vblock(); it < n_items; it += gridDim.x) {
        int mt, nt; tile_mn(it, ntm, ntn, mt, nt);
        gemm_tile<MODE>(A, lda, W, K, K, mt * 128, nt * 128, smem, [&](f32x16 (&acc)[2][2], int r0, int c0) {
            if (MODE != 0 && acc[0][0][0] != 123456.789f) return;
#pragma unroll
            for (int ni = 0; ni < 2; ++ni) {
                const int col = c0 + 32 * ni + l31;
                if (col < ncols) {
#pragma unroll
                    for (int mi = 0; mi < 2; ++mi)
#pragma unroll
                        for (int i = 0; i < 16; ++i) C[(size_t)(r0 + 32 * mi + crow(i, hh)) * ldc + col] = f2bf(acc[mi][ni][i]);
                }
            }
        });
    }
}

template <int LDC>
PH_FN void gemm_store_phase256(const bf16_t* A, int lda, const bf16_t* W, int K, int ntn, bf16_t* C, char* smem, int ntm, int nctx128) {
    const int lane = TIDX() & 63, l31 = lane & 31, hh = lane >> 5;
    const int n_items = ntm * ntn;
    for (int it = vblock(); it < nctx128 * ntn; it += gridDim.x) {
        const int mt = it / ntn, nt = it - mt * ntn;
        gemm_tile(A, lda, W, K, K, NL + mt * 128, nt * 128, smem, [&](f32x16 (&acc)[2][2], int r0, int c0) {
#pragma unroll
            for (int mi = 0; mi < 2; ++mi) {
                bf16_t* cp = C + (size_t)(r0 + 32 * mi + 4 * hh) * LDC + c0 + l31;
#pragma unroll
                for (int ni = 0; ni < 2; ++ni)
#pragma unroll
                    for (int i = 0; i < 16; ++i) if (LDC == D || c0 + l31 + 32 * ni < LDC) cp[((i & 3) + 8 * (i >> 2)) * LDC + 32 * ni] = f2bf(acc[mi][ni][i]);
            }
        });
    }
    for (int it = vblock(); it < n_items; it += gridDim.x) {
        int mt, nt; tile_mn(it, ntm, ntn, mt, nt);
        gemm_tile256(A, lda, W, K, K, mt * 256, nt * 128, smem, [&](f32x16 (&acc)[4][2], int r0, int c0) {
#pragma unroll
            for (int mi = 0; mi < 4; ++mi) {
                bf16_t* cp = C + (size_t)(r0 + 32 * mi + 4 * hh) * LDC + c0 + l31;
#pragma unroll
                for (int ni = 0; ni < 2; ++ni)
#pragma unroll
                    for (int i = 0; i < 16; ++i) if (LDC == D || c0 + l31 + 32 * ni < LDC) cp[((i & 3) + 8 * (i >> 2)) * LDC + 32 * ni] = f2bf(acc[mi][ni][i]);
                __builtin_amdgcn_sched_barrier(0);
            }
        });
    }
}

PH_FN void glu_phase(const KP& p, int l, char* smem) {
    const bf16_t* S5P = (const bf16_t*)(p.ws + OFF_S5P);
    const bf16_t* W = (const bf16_t*)(p.ws + OFF_W) + (size_t)l * WL_EL + WO_GLU;
    bf16_t* MIX = (bf16_t*)(p.ws + OFF_MIX);
    const float* bg = p.in[22] + l * 256;
    const int lane = TIDX() & 63, l31 = lane & 31, hh = lane >> 5;
    const int n_items = (NT / 128) * 2;
    for (int it = vblock(); it < n_items; it += gridDim.x) {
        const int mt = it >> 1, nt = it & 1;
        gemm_tile(S5P, 256, W, 256, 256, mt * 128, nt * 128, smem, [&](f32x16 (&acc)[2][2], int r0, int c0) {
#pragma unroll
            for (int ni = 0; ni < 2; ++ni) {
                const int col = c0 + 32 * ni + l31;
                const float b = bg[col];
#pragma unroll
                for (int mi = 0; mi < 2; ++mi)
#pragma unroll
                    for (int i = 0; i < 16; ++i) {
                        const int row = r0 + 32 * mi + crow(i, hh);
                        const float y = bf2f(S5P[(size_t)row * 256 + col]);
                        MIX[(size_t)row * DMIX + col] = f2bf(y * sigmoidf_(acc[mi][ni][i] + b));
                        if ((i & 3) == 3) __builtin_amdgcn_sched_barrier(0);
                    }
            }
        });
    }
}

DI void key_pos(int row, int& b, int& pos) {
    if (row < NL) { b = row >= SEQ ? 1 : 0; pos = row - b * SEQ; }
    else { const int r = row - NL; b = r >> 8; pos = SEQ + (r & 255); }
}

DI void qkv_item(const KP& p, int l, int it, char* smem) {
    const bf16_t* Z = (const bf16_t*)(p.ws + OFF_Z);
    const bf16_t* Wl = (const bf16_t*)(p.ws + OFF_W) + (size_t)l * WL_EL;
    bf16_t* Q = (bf16_t*)(p.ws + OFF_Q);
    bf16_t* Kb = (bf16_t*)(p.ws + OFF_K);
    bf16_t* Vt = (bf16_t*)(p.ws + OFF_VT);
    const float* tab = (const float*)(p.ws + OFF_ROPE);
    const int mt = it / 14, sub = it % 14, row0 = mt * 128;
    const int tid = TIDX(), lane = tid & 63, l31 = lane & 31, hh = lane >> 5;
    __shared__ float s_rs[128];
    {
        const int r = tid >> 1, half = tid & 1;
        const bool isq = sub < 6;
        const int n = isq ? 128 : 64;
        const bf16_t* src = Z + (size_t)(row0 + r) * DIN + (isq ? IN_CQ : IN_CKV) + half * n;
        float ss = 0.f;
        auto sq8 = [&](const u32x4& v) {
#pragma unroll
            for (int q = 0; q < 4; ++q) { const float a = __uint_as_float(v[q] << 16), b = __uint_as_float(v[q] & 0xffff0000u); ss += a * a + b * b; }
        };
        if (isq) {
            u32x4 v[16];
#pragma unroll
            for (int i = 0; i < 16; ++i) v[i] = *(const u32x4*)(src + 8 * i);
#pragma unroll
            for (int i = 0; i < 16; ++i) sq8(v[i]);
        } else {
            u32x4 v[8];
#pragma unroll
            for (int i = 0; i < 8; ++i) v[i] = *(const u32x4*)(src + 8 * i);
#pragma unroll
            for (int i = 0; i < 8; ++i) sq8(v[i]);
        }
        ss += shflx(ss, 1);
        if (half == 0) s_rs[r] = rsqrtf(ss / (float)(2 * n) + EPS);
    }
    __syncthreads();
    if (sub < 6) {
        gemm_tile(Z + IN_CQ, DIN, Wl + WO_UQ, 256, 256, row0, sub * 128, smem, [&](f32x16 (&acc)[2][2], int r0, int c0) {
#pragma unroll
            for (int ni = 0; ni < 2; ++ni) {
                const int cb = c0 + 32 * ni, col = cb + l31;
                const bool is_rope = ((cb >> 5) % 3) == 2;
                const int axis = l31 >> 4, second = (l31 >> 3) & 1, fi = l31 & 7;
#pragma unroll
                for (int mi = 0; mi < 2; ++mi)
#pragma unroll
                    for (int i = 0; i < 16; ++i) {
                        const int row = r0 + 32 * mi + crow(i, hh);
                        float v = acc[mi][ni][i] * s_rs[row - row0];
                        if (is_rope) {
                            const float pr = shflx(v, 8);
                            if (row < NL) {
                                const int t = row & (SEQ - 1);
                                const int pos = axis ? (t & 63) : (t >> 6);
                                const float cs = tab[(pos * 8 + fi) * 2], sn = tab[(pos * 8 + fi) * 2 + 1];
                                v = second ? (v * cs + pr * sn) : (v * cs - pr * sn);
                            }
                        }
                        Q[(size_t)row * 768 + col] = f2bf(v);
                        if ((i & 3) == 3) __builtin_amdgcn_sched_barrier(0);
                    }
            }
        });
    } else {
        const int head = sub - 6;
        gemm_tile(Z + IN_CKV, DIN, Wl + WO_UKV, 128, 128, row0, head * 128, smem, [&](f32x16 (&acc)[2][2], int r0, int c0) {
            const bool isv = (c0 >> 6) & 1;
#pragma unroll
            for (int ni = 0; ni < 2; ++ni) {
                const int dcol = 32 * ni + l31;
#pragma unroll
                for (int mi = 0; mi < 2; ++mi)
#pragma unroll
                    for (int q = 0; q < 4; ++q) {
                        const int rowb = r0 + 32 * mi + 8 * q + 4 * hh;
                        int b, pos; key_pos(rowb, b, pos);
                        float v[4];
#pragma unroll
                        for (int j = 0; j < 4; ++j) v[j] = acc[mi][ni][4 * q + j] * s_rs[rowb + j - row0];
                        if (isv) {
                            uint2 o; o.x = pack2(v[0], v[1]); o.y = pack2(v[2], v[3]);
                            *(uint2*)(Vt + ((size_t)(b * NH + head) * 64 + dcol) * LK + ((pos & ~12) | ((pos & 4) << 1) | ((pos & 8) >> 1))) = o;
                        } else {
#pragma unroll
                            for (int j = 0; j < 4; ++j) Kb[((size_t)(b * NH + head) * LK + pos + j) * DK + dcol] = f2bf(v[j]);
                        }
                    }
            }
        });
        for (int e = tid; e < 128 * 32; e += 256) {
            const int r = e >> 5, d = e & 31, row = row0 + r;
            const bf16_t* kr = Z + (size_t)row * DIN + IN_KR;
            float v = bf2f(kr[d]);
            if (row < NL) {
                const float pr = bf2f(kr[d ^ 8]);
                const int t = row & (SEQ - 1), axis = d >> 4, second = (d >> 3) & 1, fi = d & 7;
                const int pos = axis ? (t & 63) : (t >> 6);
                const float cs = tab[(pos * 8 + fi) * 2], sn = tab[(pos * 8 + fi) * 2 + 1];
                v = second ? (v * cs + pr * sn) : (v * cs - pr * sn);
            }
            int b, pos; key_pos(row, b, pos);
            Kb[((size_t)(b * NH + head) * LK + pos) * DK + 64 + d] = f2bf(v);
        }
    }
    __syncthreads();
}

DI void convpool_item(const KP& p, int l, int it, char* smem) {
    const bf16_t* Z = (const bf16_t*)(p.ws + OFF_Z);
    bf16_t* MIX = (bf16_t*)(p.ws + OFF_MIX);
    float* hs = (float*)smem;
    int L, rowbase, t0;
    if (it < 1024) { L = SEQ; rowbase = (it >> 9) * SEQ; t0 = (it & 511) * 32; }
    else { const int r = it - 1024; L = CTXL; rowbase = NL + (r >> 3) * CTXL; t0 = (r & 7) * 32; }
    const int c = TIDX(), lane = c & 63, wave = c >> 6;
    {
        const int c4 = (c & 63) * 4, ts = c >> 6;
#pragma unroll 4
        for (int j = ts; j < 62; j += 4) {
            const int t = t0 - 15 + j;
            float4 h = make_float4(0.f, 0.f, 0.f, 0.f);
            if (t >= 0 && t < L) {
                const bf16_t* zr = Z + (size_t)(rowbase + t) * DIN + IN_CONV + c4;
                const uint2 v = *(const uint2*)zr, g = *(const uint2*)(zr + 256);
                h.x = __uint_as_float(v.x << 16) * sigmoidf_(__uint_as_float(g.x << 16));
                h.y = __uint_as_float(v.x & 0xffff0000u) * sigmoidf_(__uint_as_float(g.x & 0xffff0000u));
                h.z = __uint_as_float(v.y << 16) * sigmoidf_(__uint_as_float(g.y << 16));
                h.w = __uint_as_float(v.y & 0xffff0000u) * sigmoidf_(__uint_as_float(g.y & 0xffff0000u));
            }
            *(float4*)(hs + j * 256 + c4) = h;
        }
    }
    __syncthreads();
    float w[31];
#pragma unroll
    for (int k = 0; k < 31; ++k) w[k] = p.in[23][(size_t)(l * 31 + k) * 256 + c];
    const float cb = p.in[24][l * 256 + c];
#pragma unroll 1
    for (int tt = 0; tt < 32; ++tt) {
        float s = cb;
#pragma unroll
        for (int k = 0; k < 31; ++k) s += w[k] * hs[(tt + k) * 256 + c];
        hs[tt * 256 + c] = s;
    }
    __syncthreads();
    {
        const float4 lg = *(const float4*)(p.in[25] + l * 256 + lane * 4);
        const float4 lb = *(const float4*)(p.in[26] + l * 256 + lane * 4);
#pragma unroll 1
        for (int q = 0; q < 8; ++q) {
            const int tt = wave * 8 + q;
            const float4 v = *(const float4*)(hs + tt * 256 + lane * 4);
            const float mean = wave_sum(v.x + v.y + v.z + v.w) * (1.f / 256.f);
            const float d0 = v.x - mean, d1 = v.y - mean, d2 = v.z - mean, d3 = v.w - mean;
            const float var = wave_sum(d0 * d0 + d1 * d1 + d2 * d2 + d3 * d3) * (1.f / 256.f);
            const float rstd = rsqrtf(var + EPS);
            uint2 o;
            o.x = pack2(siluf_(d0 * rstd * lg.x + lb.x), siluf_(d1 * rstd * lg.y + lb.y));
            o.y = pack2(siluf_(d2 * rstd * lg.z + lb.z), siluf_(d3 * rstd * lg.w + lb.w));
            *(uint2*)(MIX + (size_t)(rowbase + t0 + tt) * DMIX + 256 + lane * 4) = o;
        }
    }
    __syncthreads();
    {
        const int c4 = (c & 63) * 4, ts = c >> 6;
#pragma unroll 4
        for (int j = ts; j < 47; j += 4) {
            const int t = t0 - 7 + j;
            float4 h = make_float4(0.f, 0.f, 0.f, 0.f);
            if (t >= 0 && t < L) {
                const uint2 v = *(const uint2*)(Z + (size_t)(rowbase + t) * DIN + IN_POOL + c4);
                h.x = __uint_as_float(v.x << 16); h.y = __uint_as_float(v.x & 0xffff0000u); h.z = __uint_as_float(v.y << 16); h.w = __uint_as_float(v.y & 0xffff0000u);
            }
            *(float4*)(hs + j * 256 + c4) = h;
        }
    }
    __syncthreads();
    {
        const int win = 2 << (c >> 6), wa = (win - 1) >> 1, wb = win >> 1;
#pragma unroll 1
        for (int tt = 0; tt < 32; ++tt) {
            const int t = t0 + tt;
            const int lo = max(t - wa, 0), hi = min(t + wb, L - 1);
            float s = 0.f;
            for (int q = lo; q <= hi; ++q) s += hs[(q - t0 + 7) * 256 + c];
            const float o = s / (float)(hi - lo + 1) - hs[(tt + 7) * 256 + c];
            MIX[(size_t)(rowbase + t) * DMIX + 512 + c] = f2bf(o);
        }
    }
    __syncthreads();
}

DI int chunk_row(int b, int k) { return k < 4 ? NL + b * CTXL + 64 * k : b * SEQ + 64 * (k - 4); }

template <bool FINAL>
DI void s5_item(const KP& p, int l, int it, char* smem) {
    const int g4 = it & 3, k = (it >> 2) % NCHUNK, b = (it >> 2) / NCHUNK;
    const int tid = TIDX(), lane = tid & 63, wave = tid >> 6, g = g4 * 4 + wave;
    const bf16_t* Z = (const bf16_t*)(p.ws + OFF_Z);
    float* Us = (float*)smem + wave * 1024;
    bf16_t* Hs = (bf16_t*)(smem + 16384) + wave * (16 * 136);
    const int rbase = chunk_row(b, k);
    {
        const uint4* src = (const uint4*)(Z + (size_t)(rbase + lane) * DIN + g * 16);
        const uint4 v0 = src[0], v1 = src[1];
        const unsigned w[8] = {v0.x, v0.y, v0.z, v0.w, v1.x, v1.y, v1.z, v1.w};
#pragma unroll
        for (int q = 0; q < 8; ++q) { Us[lane * 16 + 2 * q] = __uint_as_float(w[q] << 16); Us[lane * 16 + 2 * q + 1] = __uint_as_float(w[q] & 0xffff0000u); }
    }
    __syncthreads();
    f32x4 yacc[4];
#pragma unroll
    for (int s = 0; s < 4; ++s) yacc[s] = f32x4{0.f, 0.f, 0.f, 0.f};
#pragma unroll
    for (int dir = 0; dir < 2; ++dir) {
        const int pidx = ((l * 2 + dir) * 16 + g) * 64 + lane;
        const float4 lam = ((const float4*)(p.ws + OFF_LAMB))[pidx];
        float br[16], bi[16];
        {
            const float4* bb = (const float4*)((const float*)(p.ws + OFF_BBAR) + (size_t)pidx * 32);
#pragma unroll
            for (int q = 0; q < 8; ++q) { const float4 v = bb[q]; br[2 * q] = v.x; bi[2 * q] = v.y; br[2 * q + 1] = v.z; bi[2 * q + 1] = v.w; }
        }
        const size_t sidx = ((size_t)((b * 2 + dir) * NCHUNK + k) * 16 + g) * 64 + lane;
        float hr = 0.f, hi = 0.f;
        bf16x8 cfr[4];
        if (FINAL) {
            const float2 s0 = ((const float2*)(p.ws + OFF_S))[sidx];
            hr = s0.x; hi = s0.y;
            const bf16_t* cc = (const bf16_t*)(p.ws + OFF_CC) + (size_t)((l * 2 + dir) * 16 + g) * 2048 + (lane & 15) * 128 + (lane >> 4) * 8;
#pragma unroll
            for (int ks = 0; ks < 4; ++ks) cfr[ks] = *(const bf16x8*)(cc + 32 * ks);
        }
#pragma unroll
        for (int s = 0; s < 4; ++s) {
            const int sb = dir ? 3 - s : s;
#pragma unroll 1
            for (int tt = 0; tt < 16; ++tt) {
                const int tl = dir ? 15 - tt : tt, t = sb * 16 + tl;
                const float4* up = (const float4*)(Us + t * 16);
                float ar = 0.f, ai = 0.f;
#pragma unroll
                for (int q = 0; q < 4; ++q) {
                    const float4 u = up[q];
                    ar += br[4 * q] * u.x + br[4 * q + 1] * u.y + br[4 * q + 2] * u.z + br[4 * q + 3] * u.w;
                    ai += bi[4 * q] * u.x + bi[4 * q + 1] * u.y + bi[4 * q + 2] * u.z + bi[4 * q + 3] * u.w;
                }
                const float nr = lam.x * hr - lam.y * hi + ar, ni = lam.x * hi + lam.y * hr + ai;
                hr = nr; hi = ni;
                if (FINAL) { Hs[tl * 136 + lane] = f2bf(hr); Hs[tl * 136 + 64 + lane] = f2bf(hi); }
            }
            if (FINAL) {
                __syncthreads();
                const bf16_t* hp = Hs + (lane & 15) * 136 + (lane >> 4) * 8;
#pragma unroll
                for (int ks = 0; ks < 4; ++ks) { const bf16x8 a = *(const bf16x8*)(hp + 32 * ks); yacc[sb] = MFMA16(a, cfr[ks], yacc[sb]); }
                __syncthreads();
            }
        }
        if (!FINAL) ((float2*)(p.ws + OFF_E))[sidx] = make_float2(hr, hi);
    }
    if (FINAL) {
        bf16_t* S5P = (bf16_t*)(p.ws + OFF_S5P);
        const int hcol = lane & 15;
        const float dg = p.in[20][l * 256 + g * 16 + hcol];
#pragma unroll
        for (int s = 0; s < 4; ++s)
#pragma unroll
            for (int j = 0; j < 4; ++j) {
                const int t = s * 16 + (lane >> 4) * 4 + j;
                const float y = yacc[s][j] + dg * Us[t * 16 + hcol];
                S5P[(size_t)(rbase + t) * 256 + g * 16 + hcol] = f2bf(gelu_tanh(y));
            }
    }
    __syncthreads();
}

DI void s5_carry(const KP& p, int l, int blk) {
    const int idx = blk * 256 + TIDX();
    const int gp = idx & 1023, dir = (idx >> 10) & 1, b = idx >> 11;
    const float4 lam = ((const float4*)(p.ws + OFF_LAMB))[(l * 2 + dir) * 1024 + gp];
    const float2* E = (const float2*)(p.ws + OFF_E) + (size_t)(b * 2 + dir) * NCHUNK * 1024 + gp;
    float2* S = (float2*)(p.ws + OFF_S) + (size_t)(b * 2 + dir) * NCHUNK * 1024 + gp;
    float sr = 0.f, si = 0.f;
    for (int j0 = 0; j0 < NCHUNK; j0 += 4) {
        const int k0 = dir ? (j0 < 4 ? 3 - j0 : 263 - j0) : j0, stp = dir ? -1 : 1;
        const float2 e0 = E[(size_t)k0 * 1024], e1 = E[(size_t)(k0 + stp) * 1024], e2 = E[(size_t)(k0 + 2 * stp) * 1024], e3 = E[(size_t)(k0 + 3 * stp) * 1024];
        float nr, ni;
        S[(size_t)k0 * 1024] = make_float2(sr, si);
        nr = lam.z * sr - lam.w * si + e0.x; ni = lam.z * si + lam.w * sr + e0.y; sr = nr; si = ni;
        S[(size_t)(k0 + stp) * 1024] = make_float2(sr, si);
        nr = lam.z * sr - lam.w * si + e1.x; ni = lam.z * si + lam.w * sr + e1.y; sr = nr; si = ni;
        S[(size_t)(k0 + 2 * stp) * 1024] = make_float2(sr, si);
        nr = lam.z * sr - lam.w * si + e2.x; ni = lam.z * si + lam.w * sr + e2.y; sr = nr; si = ni;
        S[(size_t)(k0 + 3 * stp) * 1024] = make_float2(sr, si);
        nr = lam.z * sr - lam.w * si + e3.x; ni = lam.z * si + lam.w * sr + e3.y; sr = nr; si = ni;
    }
}

DI void attn_item(const KP& p, int it, char* smem) {
    const bf16_t* Q = (const bf16_t*)(p.ws + OFF_Q);
    const bf16_t* Kg = (const bf16_t*)(p.ws + OFF_K);
    const bf16_t* Vg = (const bf16_t*)(p.ws + OFF_VT);
    bf16_t* MIX = (bf16_t*)(p.ws + OFF_MIX);
    const int tid = TIDX(), lane = tid & 63, wave = tid >> 6, l31 = lane & 31, hh = lane >> 5;
    int bh, qrow0, kt0, T;
    if (it < 1024) { bh = it >> 6; qrow0 = (bh >> 3) * SEQ + (it & 63) * 256; kt0 = 0; T = NCHUNK; }
    else { bh = it - 1024; qrow0 = NL + (bh >> 3) * CTXL; kt0 = SEQ / 64; T = CTXL / 64; }
    const int head = bh & 7;
    const bf16_t* Kb = Kg + (size_t)bh * LK * DK + (size_t)kt0 * 64 * DK;
    const bf16_t* Vb = Vg + (size_t)bh * 64 * LK + kt0 * 64;
    bf16_t* sK = (bf16_t*)smem;
    bf16_t* sV = sK + 2 * 64 * 104;
    const int qrow = qrow0 + wave * 64 + l31;
    bf16x8 qf[2][6];
#pragma unroll
    for (int qb = 0; qb < 2; ++qb)
#pragma unroll
        for (int s = 0; s < 6; ++s) qf[qb][s] = *(const bf16x8*)(Q + (size_t)(qrow + 32 * qb) * 768 + head * 96 + 16 * s + 8 * hh);
    f32x16 o[2][2];
#pragma unroll
    for (int i = 0; i < 16; ++i) { o[0][0][i] = 0.f; o[0][1][i] = 0.f; o[1][0][i] = 0.f; o[1][1][i] = 0.f; }
    float m_run[2] = {-1e30f, -1e30f}, l_run[2] = {0.f, 0.f};
    u32x4 rk0, rk1, rk2, rv0, rv1;
    const int vrow = tid >> 3, vcol = (tid & 7) * 8;
    const int kw0 = (tid / 12) * 104 + (tid % 12) * 8, kw1 = ((tid + 256) / 12) * 104 + ((tid + 256) % 12) * 8, kw2 = ((tid + 512) / 12) * 104 + ((tid + 512) % 12) * 8;
    const bf16_t* cK = sK + l31 * 104 + 8 * hh;
    const bf16_t* cV = sV + l31 * 72 + 8 * hh;
#define ATT_KWRITE(buf_) do { bf16_t* k_ = sK + (buf_) * 64 * 104; *(u32x4*)(k_ + kw0) = rk0; *(u32x4*)(k_ + kw1) = rk1; *(u32x4*)(k_ + kw2) = rk2; } while (0)
#define ATT_VWRITE(buf_) do { bf16_t* v_ = sV + (buf_) * 64 * 72 + vrow * 72 + vcol; *(u32x4*)(v_) = rv0; *(u32x4*)(v_ + 32 * 72) = rv1; } while (0)
    {
        const bf16_t* kp = Kb + tid * 8;
        rk0 = *(const u32x4*)(kp); rk1 = *(const u32x4*)(kp + 2048); rk2 = *(const u32x4*)(kp + 4096);
        const bf16_t* vp = Vb + (size_t)vrow * LK + vcol;
        rv0 = *(const u32x4*)(vp); rv1 = *(const u32x4*)(vp + (size_t)32 * LK);
        ATT_KWRITE(0); ATT_VWRITE(0);
    }
    __syncthreads();
    for (int t = 0; t < T; ++t) {
        const int buf = t & 1;
        const bool more = (t + 1) < T;
        if (more) {
            const bf16_t* kp_ = Kb + (size_t)(t + 1) * 64 * DK + tid * 8; gld16(rk0, kp_); gld16(rk1, kp_ + 2048); gld16(rk2, kp_ + 4096);
            const bf16_t* vp_ = Vb + (size_t)vrow * LK + (t + 1) * 64 + vcol; gld16(rv0, vp_); gld16(rv1, vp_ + (size_t)32 * LK);
        }
#pragma unroll
        for (int kb = 0; kb < 2; ++kb) {
            f32x16 s[2];
#pragma unroll
            for (int i = 0; i < 16; ++i) { s[0][i] = 0.f; s[1][i] = 0.f; }
            bf16x8 kf[6];
#pragma unroll
            for (int ks = 0; ks < 6; ++ks) kf[ks] = *(const bf16x8*)(cK + buf * 64 * 104 + kb * 32 * 104 + 16 * ks);
            __builtin_amdgcn_sched_barrier(0);
            __builtin_amdgcn_s_setprio(1);
#pragma unroll
            for (int ks = 0; ks < 6; ++ks) {
                s[0] = MFMA32(kf[ks], qf[0][ks], s[0]);
                s[1] = MFMA32(kf[ks], qf[1][ks], s[1]);
            }
            __builtin_amdgcn_s_setprio(0);
#pragma unroll
            for (int qb = 0; qb < 2; ++qb) {
                float mx = s[qb][0];
#pragma unroll
                for (int i = 1; i < 16; ++i) mx = fmaxf(mx, s[qb][i]);
                mx = xhalf_max(mx);
                const float m_new = fmaxf(m_run[qb], mx);
                if (__builtin_amdgcn_ballot_w64(m_new > m_run[qb]) != 0ull) {
                    const float alpha = __builtin_amdgcn_exp2f(m_run[qb] - m_new);
                    m_run[qb] = m_new; l_run[qb] *= alpha;
#pragma unroll
                    for (int i = 0; i < 16; ++i) { o[qb][0][i] *= alpha; o[qb][1][i] *= alpha; }
                }
                float ps = 0.f;
#pragma unroll
                for (int i = 0; i < 16; ++i) { s[qb][i] = __builtin_amdgcn_exp2f(s[qb][i] - m_run[qb]); ps += s[qb][i]; }
                l_run[qb] += ps;
            }
            bf16x8 vf[2][2];
#pragma unroll
            for (int u = 0; u < 2; ++u)
#pragma unroll
                for (int dvb = 0; dvb < 2; ++dvb) vf[u][dvb] = *(const bf16x8*)(cV + buf * 64 * 72 + dvb * 32 * 72 + 32 * kb + 16 * u);
            __builtin_amdgcn_sched_barrier(0);
#pragma unroll
            for (int u = 0; u < 2; ++u) {
                const bf16x8 p0 = __builtin_bit_cast(bf16x8, u32x4{pack2(s[0][8 * u], s[0][8 * u + 1]), pack2(s[0][8 * u + 2], s[0][8 * u + 3]), pack2(s[0][8 * u + 4], s[0][8 * u + 5]), pack2(s[0][8 * u + 6], s[0][8 * u + 7])});
                const bf16x8 p1 = __builtin_bit_cast(bf16x8, u32x4{pack2(s[1][8 * u], s[1][8 * u + 1]), pack2(s[1][8 * u + 2], s[1][8 * u + 3]), pack2(s[1][8 * u + 4], s[1][8 * u + 5]), pack2(s[1][8 * u + 6], s[1][8 * u + 7])});
                __builtin_amdgcn_s_setprio(1);
#pragma unroll
                for (int dvb = 0; dvb < 2; ++dvb) {
                    o[0][dvb] = MFMA32(vf[u][dvb], p0, o[0][dvb]);
                    o[1][dvb] = MFMA32(vf[u][dvb], p1, o[1][dvb]);
                }
                __builtin_amdgcn_s_setprio(0);
            }
        }
        if (more) { vm_wait5(rk0, rk1, rk2, rv0, rv1); ATT_KWRITE(buf ^ 1); ATT_VWRITE(buf ^ 1); }
        __syncthreads();
    }
#undef ATT_KWRITE
#undef ATT_VWRITE
#pragma unroll
    for (int qb = 0; qb < 2; ++qb) {
        const float lt = xhalf_sum(l_run[qb]);
        const float inv = 1.f / lt;
#pragma unroll
        for (int dvb = 0; dvb < 2; ++dvb)
#pragma unroll
            for (int q = 0; q < 4; ++q) {
                uint2 ov; ov.x = pack2(o[qb][dvb][4 * q] * inv, o[qb][dvb][4 * q + 1] * inv); ov.y = pack2(o[qb][dvb][4 * q + 2] * inv, o[qb][dvb][4 * q + 3] * inv);
                *(uint2*)(MIX + (size_t)(qrow + 32 * qb) * DMIX + 768 + head * 64 + 32 * dvb + 8 * q + 4 * hh) = ov;
            }
    }
}

PH_FN void misc_phase(const KP& p, int l, char* smem) {
    const int n_qkv = 260 * 14, n_cp = l == 1 ? 1024 : 1040, n_s5 = 2 * NCHUNK * 4;
    const int rot = (blockIdx.x + gridDim.x / 2) % gridDim.x;
    for (int it = vblock(); it < n_qkv; it += gridDim.x) qkv_item(p, l, it, smem);
    for (int it = rot; it < n_cp; it += gridDim.x) convpool_item(p, l, it, smem);
    for (int it = blockIdx.x; it < n_s5; it += gridDim.x) s5_item<false>(p, l, it, smem);
#if MISC_DUP == 1
    for (int it = vblock(); it < n_qkv; it += gridDim.x) qkv_item(p, l, it, smem);
#elif MISC_DUP == 2
    for (int it = rot; it < n_cp; it += gridDim.x) convpool_item(p, l, it, smem);
#elif MISC_DUP == 3
    for (int it = blockIdx.x; it < n_s5; it += gridDim.x) s5_item<false>(p, l, it, smem);
#endif
}
PH_FN void attn_phase(const KP& p, int l, char* smem) {
    const int n_att = l == 1 ? 1024 : 1024 + 16;
    if (blockIdx.x < 16) s5_carry(p, l, blockIdx.x);
    for (int it = vblock(); it < n_att; it += gridDim.x) attn_item(p, it, smem);
}
PH_FN void s5fin_phase(const KP& p, int l, char* smem) {
    for (int it = blockIdx.x; it < 2 * NCHUNK * 4; it += gridDim.x) s5_item<true>(p, l, it, smem);
}

DI void run_phase(const KP& p, int ph, char* smem) {
    if (ph == 0) { prep_phase(p, smem); return; }
    if (ph == 27) {
        rowop_phase(p, 1, 8, 0.5f, p.in[7] + (1 * 3 + 2) * D, true, 0, 0, nullptr, false, false, NL);
        return;
    }
    const int l = (ph - 1) / 13, s = (ph - 1) % 13;
    const bf16_t* Wl = (const bf16_t*)(p.ws + OFF_W) + (size_t)l * WL_EL;
    const float* npre = p.in[6] + (size_t)l * 3 * D;
    const float* npost = p.in[7] + (size_t)l * 3 * D;
    const bool lastl = l == 1;
    switch (s) {
    case 0:
        if (l == 0) rowop_phase(p, 0, 0, 0.f, nullptr, false, 0, 0, npre, true, true);
        else rowop_phase(p, l - 1, 8, 0.5f, p.in[7] + ((l - 1) * 3 + 2) * D, true, l, 0, npre, true, false);
        break;
    case 1: case 11: gemm1_phase(p, l, s == 11, smem, (lastl && s == 11) ? NL / 256 : NT / 256); break;
    case 2: case 9: case 12: {
        const bool isout = s == 9;
        const bf16_t* Ag = (const bf16_t*)(p.ws + (isout ? OFF_MIX : OFF_ACT));
        const bf16_t* Wg = Wl + (isout ? WO_OUT : (s == 12 ? WO_D1 : WO_D0));
        const int Kg = isout ? DMIX : FF;
        gemm_store_phase256<D>(Ag, Kg, Wg, Kg, 8, (bf16_t*)(p.ws + OFF_HY), smem, NL / 256, (lastl && s != 2) ? 0 : NC / 128);
    } break;
    case 3: rowop_phase(p, l, 2, 0.5f, npost, true, l, 3, npre + D, true, l == 0); break;
    case 4: gemm_store_phase256<DIN>((const bf16_t*)(p.ws + OFF_HY), D, Wl + WO_IN, D, 12, (bf16_t*)(p.ws + OFF_Z), smem, NL / 256, NC / 128); break;
    case 5: misc_phase(p, l, smem); break;
    case 6: attn_phase(p, l, smem); break;
    case 7: s5fin_phase(p, l, smem); break;
    case 8: glu_phase(p, l, smem); break;
    case 10: rowop_phase(p, l, 5, 1.0f, npost + D, true, l, 6, npre + 2 * D, true, false, lastl ? NL : NT); break;
    }
}

constexpr int N_PHASES = 28;

__global__ void __launch_bounds__(256, 2) mega_kernel(KP p, int ph_lo, int ph_hi) {
    __shared__ __attribute__((aligned(16))) char smem[65536];
    __shared__ KP s_kp;
    if (TIDX() < 33) s_kp.in[TIDX()] = p.in[TIDX()];
    if (TIDX() == 33) s_kp.out = p.out;
    if (TIDX() == 34) s_kp.ws = p.ws;
    __shared__ uint4 xb_words;
    if (TIDX() == 0) xb_words = make_uint4(0u, 0u, 0u, 0u);
    __syncthreads();
    XcdBarrier xb = xcd_barrier_post((unsigned*)(p.ws + OFF_BAR), (volatile LAS unsigned*)&xb_words);
    for (int ph = ph_lo; ph < ph_hi; ++ph) {
        run_phase(p, ph, smem);
        if (DUP_MASK) {
            const int sbit = ph == 0 ? 13 : (ph == 27 ? 14 : (ph - 1) % 13);
            if ((DUP_MASK >> sbit) & 1) { xcd_barrier(xb); run_phase(p, ph, smem); }
        }
#if PROBE_MODE
        {
            const int sb = ph == 0 || ph == 27 ? -1 : (ph - 1) % 13, pl = (ph - 1) / 13;
            const bf16_t* Wl = (const bf16_t*)(s_kp.ws + OFF_W) + (size_t)pl * WL_EL;
            if (sb == 1 || sb == 11) { cg::this_grid().sync(); gemm1_phase<PROBE_MODE>(s_kp, pl, sb == 11, smem); }
            if (sb == 2 || sb == 12) { cg::this_grid().sync(); gemm_store_phase<PROBE_MODE>((const bf16_t*)(s_kp.ws + OFF_ACT), FF, Wl + (sb == 12 ? WO_D1 : WO_D0), FF, 8, (bf16_t*)(s_kp.ws + OFF_HY), D, D, smem); }
        }
#endif
        if (EXTRA_SYNCS) { xcd_barrier(xb); xcd_barrier(xb); }
        if (ph + 1 < ph_hi) { if (ph_hi < 0) cg::this_grid().sync(); else xcd_barrier(xb); }
    }
}

extern "C" void kernel_launch(void* const* d_in, const int* in_sizes, int n_in, void* d_out, int out_size, void* d_ws, size_t ws_size, hipStream_t stream) {
    static int grid = 0;
    if (grid == 0) {
        if (n_in != 33 || ws_size < WS_END) { fprintf(stderr, "kernel_launch: unexpected n_in %d or ws_size %zu < %zu\n", n_in, ws_size, (size_t)WS_END); grid = -1; return; }
        int dev = 0, cus = 0, per_cu = 0;
        hipGetDevice(&dev);
        hipDeviceGetAttribute(&cus, hipDeviceAttributeMultiprocessorCount, dev);
        hipOccupancyMaxActiveBlocksPerMultiprocessor(&per_cu, (const void*)mega_kernel, 256, 0);
        if (per_cu < 1) per_cu = 1;
        if (per_cu > 2) per_cu = 2;
        grid = cus * per_cu;
    }
    if (grid < 0) return;
    KP p{};
    for (int i = 0; i < 33; ++i) p.in[i] = (const float*)d_in[i];
    p.out = (float*)d_out; p.ws = (char*)d_ws;
    if (hipMemsetAsync((char*)d_ws + OFF_BAR, 0, 3456 * 4, stream) != hipSuccess) { fprintf(stderr, "kernel_launch: memset of barrier words failed\n"); return; }
#if ONE_LAUNCH
    int lo = 0, hi = N_PHASES;
    void* args[] = {&p, &lo, &hi};
    hipError_t e = hipLaunchCooperativeKernel((const void*)mega_kernel, dim3(grid), dim3(256), args, 0, stream);
    if (e != hipSuccess) fprintf(stderr, "cooperative launch failed: %s (grid %d)\n", hipGetErrorString(e), grid);
#else
    for (int ph = 0; ph < N_PHASES; ++ph) hipLaunchKernelGGL(mega_kernel, dim3(grid), dim3(256), 0, stream, p, ph, ph + 1);
#endif
}
```

```cpp
#include <hip/hip_runtime.h>
#include <hip/hip_cooperative_groups.h>
#include <cstdio>
#include <cstdint>
namespace cg = cooperative_groups;

#ifndef ONE_LAUNCH
#define ONE_LAUNCH 1
#endif
#define PROBE_MODE 0
#define EXTRA_SYNCS 0
#define MISC_DUP 0
#define ATT_PROBE 0
#define DUP_MASK 0

#define DI __device__ __forceinline__
#define PH_FN __device__ __forceinline__
typedef unsigned short bf16_t;
using bf16x8 = __attribute__((ext_vector_type(8))) short;
using f32x16 = __attribute__((ext_vector_type(16))) float;
using f32x4 = __attribute__((ext_vector_type(4))) float;
typedef unsigned u32x4 __attribute__((ext_vector_type(4)));
typedef __bf16 bf16x2_t __attribute__((ext_vector_type(2)));
typedef float f2_t __attribute__((ext_vector_type(2)));
typedef float f4_t __attribute__((ext_vector_type(4)));
typedef unsigned u2_t __attribute__((ext_vector_type(2)));

constexpr int D = 1024, SEQ = 16384, NB = 2, CTXL = 256;
constexpr int NL = NB * SEQ, NC = NB * CTXL, NT = NL + NC;
constexpr int FF = 2816, DIN = 1440, DMIX = 1280;
constexpr int NH = 8, DK = 96, LK = SEQ + CTXL;
constexpr int IN_CONV = 256, IN_POOL = 768, IN_CQ = 1024, IN_CKV = 1280, IN_KR = 1408;
constexpr int NCHUNK = LK / 64;
constexpr float EPS = 1e-6f;
constexpr float QSCALE = 0.10206207261596575f * 1.4426950408889634f;

constexpr size_t EL_GU = 5632ull * 1024, EL_D = 1024ull * 2816, EL_IN = 1536ull * 1024, EL_OUT = 1024ull * 1280,
                 EL_UQ = 768ull * 256, EL_UKV = 1024ull * 128, EL_GLU = 256ull * 256;
constexpr size_t WO_GU0 = 0, WO_GU1 = EL_GU, WO_D0 = 2 * EL_GU, WO_D1 = WO_D0 + EL_D, WO_IN = WO_D1 + EL_D,
                 WO_OUT = WO_IN + EL_IN, WO_UQ = WO_OUT + EL_OUT, WO_UKV = WO_UQ + EL_UQ, WO_GLU = WO_UKV + EL_UKV,
                 WL_EL = WO_GLU + EL_GLU;
constexpr size_t al256(size_t x) { return (x + 255) & ~(size_t)255; }
constexpr size_t OFF_W = 0;
constexpr size_t OFF_MOD = al256(OFF_W + 2 * WL_EL * 2);
constexpr size_t OFF_ROPE = al256(OFF_MOD + 2ull * 3 * 9216 * 4);
constexpr size_t OFF_LAMB = al256(OFF_ROPE + 256ull * 8 * 2 * 4);
constexpr size_t OFF_BBAR = al256(OFF_LAMB + 2ull * 2048 * 16);
constexpr size_t OFF_CC = al256(OFF_BBAR + 2ull * 2048 * 32 * 4);
constexpr size_t OFF_XC = al256(OFF_CC + 2ull * 32 * 2048 * 2);
constexpr size_t OFF_HY = al256(OFF_XC + (size_t)NC * D * 4);
constexpr size_t OFF_BIG = al256(OFF_HY + (size_t)NT * D * 2);
constexpr size_t OFF_ACT = OFF_BIG;
constexpr size_t OFF_Z = OFF_BIG;
constexpr size_t OFF_Q = al256(OFF_Z + (size_t)NT * DIN * 2);
constexpr size_t OFF_K = al256(OFF_Q + (size_t)NT * 768 * 2);
constexpr size_t OFF_VT = al256(OFF_K + (size_t)NB * NH * LK * 96 * 2);
constexpr size_t OFF_MIX = al256(OFF_VT + (size_t)NB * NH * 64 * LK * 2);
constexpr size_t OFF_S5P = al256(OFF_MIX + (size_t)NT * DMIX * 2);
constexpr size_t OFF_E = al256(OFF_S5P + (size_t)NT * 256 * 2);
constexpr size_t OFF_S = al256(OFF_E + 2ull * 2 * NCHUNK * 1024 * 8);
constexpr size_t OFF_BAR = al256(OFF_S + 2ull * 2 * NCHUNK * 1024 * 8);
constexpr size_t WS_END = al256(OFF_BAR + 3456 * 4);
static_assert(OFF_ACT + (size_t)NT * FF * 2 <= WS_END, "act fits");

struct KP { const float* in[33]; float* out; char* ws; };

DI int TIDX() { int t = threadIdx.x; asm volatile("" : "+v"(t)); return t; }
DI float bf2f(bf16_t b) { return __uint_as_float((unsigned)b << 16); }
DI unsigned pack2(float a, float b) { f2_t v = {a, b}; bf16x2_t r = __builtin_convertvector(v, bf16x2_t); return __builtin_bit_cast(unsigned, r); }
DI bf16_t f2bf(float a) { return (bf16_t)(pack2(a, 0.f) & 0xffffu); }
DI float fast_exp(float x) { return __builtin_amdgcn_exp2f(x * 1.4426950408889634f); }
DI float sigmoidf_(float x) { return __builtin_amdgcn_rcpf(1.f + fast_exp(-x)); }
DI float siluf_(float x) { return x * sigmoidf_(x); }
DI float gelu_tanh(float x) { float u = 0.7978845608028654f * (x + 0.044715f * x * x * x); float t = 1.f - 2.f * __builtin_amdgcn_rcpf(1.f + fast_exp(2.f * u)); return 0.5f * x * (1.f + t); }
DI float shflx(float v, int m) { const int idx = ((TIDX() & 63) ^ m) << 2; return __int_as_float(__builtin_amdgcn_ds_bpermute(idx, __float_as_int(v))); }
DI float xhalf_max(float v) { const auto r = __builtin_amdgcn_permlane32_swap(__float_as_uint(v), __float_as_uint(v), false, false); return fmaxf(__uint_as_float(r[0]), __uint_as_float(r[1])); }
DI float xhalf_sum(float v) { const auto r = __builtin_amdgcn_permlane32_swap(__float_as_uint(v), __float_as_uint(v), false, false); return __uint_as_float(r[0]) + __uint_as_float(r[1]); }
DI float wave_sum(float v) { for (int m = 32; m >= 1; m >>= 1) v += shflx(v, m); return v; }
DI int crow(int i, int hh) { return (i & 3) + 8 * (i >> 2) + 4 * hh; }
DI int row_mod(int row) { return row < NL ? (row >= SEQ ? 1 : 0) : 2; }
DI int vblock() { const int G = gridDim.x, b = blockIdx.x; return (G & 7) ? b : (G >> 3) * (b & 7) + (b >> 3); }
DI void tile_mn(int it, int TM, int TN, int& mt, int& nt) {
    const int band = it / (8 * TN), within = it - band * 8 * TN;
    const int gm = min(8, TM - 8 * band);
    nt = within / gm; mt = 8 * band + (within - nt * gm);
}
DI void gld16(u32x4& r, const void* p) { asm volatile("global_load_dwordx4 %0, %1, off" : "=&v"(r) : "v"(p) : "memory"); }
DI void vm_wait8(u32x4& a, u32x4& b, u32x4& c, u32x4& d, u32x4& e, u32x4& f, u32x4& g, u32x4& h) {
    asm volatile("s_waitcnt vmcnt(0)" : "+v"(a), "+v"(b), "+v"(c), "+v"(d), "+v"(e), "+v"(f), "+v"(g), "+v"(h) : : "memory"); }
DI void vm_wait5(u32x4& a, u32x4& b, u32x4& c, u32x4& d, u32x4& e) {
    asm volatile("s_waitcnt vmcnt(0)" : "+v"(a), "+v"(b), "+v"(c), "+v"(d), "+v"(e) : : "memory"); }
#define MFMA32(a, b, c) __builtin_amdgcn_mfma_f32_32x32x16_bf16((a), (b), (c), 0, 0, 0)
#define MFMA16(a, b, c) __builtin_amdgcn_mfma_f32_16x16x32_bf16((a), (b), (c), 0, 0, 0)

#define XB_TMO      128
#define XB_XCNT(j)  (256  + 64 * (j))
#define XB_XSUB(j)  (1280 + 64 * (j))
#define XB_XGEN(j)  (2304 + 64 * (j))
#define XB_TOP      3328
#define XB_TOPGEN   3392
#define XCD_BAR_WORDS 3456
#define XB_SPIN_CAP (1u << 18)
#define LAS __attribute__((address_space(3)))

__device__ __forceinline__ unsigned xb_ld(unsigned* p)              { return __hip_atomic_load(p, __ATOMIC_RELAXED, __HIP_MEMORY_SCOPE_AGENT); }
__device__ __forceinline__ unsigned xb_add(unsigned* p, unsigned v) { return __hip_atomic_fetch_add(p, v, __ATOMIC_RELAXED, __HIP_MEMORY_SCOPE_AGENT); }
__device__ __forceinline__ unsigned xb_xcc_id() { return (unsigned)__builtin_amdgcn_s_getreg((3 << 11) | 20) & 0xFu; }
#define XB_SPIN(cond, bar) do { unsigned _sp = 0; while (cond) { __builtin_amdgcn_s_sleep(1); \
    if ((++_sp & 255u) == 0u) { if (xb_ld(&(bar)[XB_TMO])) break; if (_sp > XB_SPIN_CAP) { atomicAdd(&(bar)[XB_TMO], 1u); break; } } } } while (0)

struct XcdBarrier {
    unsigned* bar; unsigned x;
    volatile LAS unsigned* st;
};

__device__ __forceinline__ XcdBarrier xcd_barrier_post(unsigned* bar, volatile LAS unsigned* st) {
    XcdBarrier b; b.bar = bar; b.x = xb_xcc_id(); b.st = st;
    if (TIDX() == 0) (void)xb_add(&bar[XB_XCNT(b.x)], 1u);
    return b;
}
__device__ __forceinline__ void xcd_barrier_complete(unsigned* bar, unsigned x, unsigned& nloc, unsigned& nx) {
    const unsigned G = gridDim.x * gridDim.y * gridDim.z;
    unsigned sum, cnt, mine, sp = 0u;
    for (;;) {
        sum = 0u; cnt = 0u; mine = 0u;
#pragma unroll
        for (unsigned j = 0; j < 16; ++j) { const unsigned c = xb_ld(&bar[XB_XCNT(j)]); sum += c; cnt += (c > 0u) ? 1u : 0u; mine = (j == x) ? c : mine; }
        if (sum == G) break;
        __builtin_amdgcn_s_sleep(1);
        if ((++sp & 255u) == 0u) { if (xb_ld(&bar[XB_TMO])) break; if (sp > XB_SPIN_CAP) { atomicAdd(&bar[XB_TMO], 1u); break; } }
    }
    nloc = mine > 0u ? mine : 1u; nx = cnt > 0u ? cnt : 1u;
}

__device__ __forceinline__ void xcd_barrier(const XcdBarrier& b) {
    asm volatile("s_waitcnt vmcnt(0)" ::: "memory");
    __syncthreads();
    if (TIDX() == 0) {
        unsigned* bar = b.bar;
        __builtin_amdgcn_s_waitcnt(0);
        unsigned nloc = b.st[0], nx = b.st[1];
        if (nloc == 0u) { xcd_barrier_complete(bar, b.x, nloc, nx); b.st[0] = nloc; b.st[1] = nx; }
        const unsigned old = xb_add(&bar[XB_XSUB(b.x)], 1u);
        const unsigned gen = old / nloc;
        if (old + 1u == (gen + 1u) * nloc) {
            __builtin_amdgcn_fence(__ATOMIC_RELEASE, "agent");
            asm volatile("s_waitcnt vmcnt(0)" ::: "memory");
            const unsigned og = xb_add(&bar[XB_TOP], 1u);
            const unsigned tg = og / nx;
            if (og + 1u == (tg + 1u) * nx) xb_add(&bar[XB_TOPGEN], 1u);
            else XB_SPIN(xb_ld(&bar[XB_TOPGEN]) == tg, bar);
            __builtin_amdgcn_fence(__ATOMIC_ACQUIRE, "agent");
            xb_add(&bar[XB_XGEN(b.x)], 1u);
            asm volatile("s_waitcnt vmcnt(0)" ::: "memory");
        } else {
            XB_SPIN(xb_ld(&bar[XB_XGEN(b.x)]) == gen, bar);
            __builtin_amdgcn_fence(__ATOMIC_ACQUIRE, "agent");
            asm volatile("s_waitcnt vmcnt(0)" ::: "memory");
        }
    }
    __syncthreads();
}


DI void vm_wait_sel(u32x4& a, u32x4& b, u32x4& c, u32x4& d, u32x4& e, u32x4& f, u32x4& g, u32x4& h, int all) {
    asm volatile("s_cmp_lg_u32 %8, 0\n\ts_cbranch_scc1 1f\n\ts_waitcnt vmcnt(8)\n\ts_branch 2f\n1:\n\ts_waitcnt vmcnt(0)\n2:"
                 : "+v"(a), "+v"(b), "+v"(c), "+v"(d), "+v"(e), "+v"(f), "+v"(g), "+v"(h) : "s"(all) : "memory", "scc"); }

template <int MODE = 0, class Epi>
DI void gemm_tile(const bf16_t* __restrict__ A, int lda, const bf16_t* __restrict__ Bt, int ldb, int K, int row0, int col0, char* smem, Epi&& epi) {
    bf16_t* sA = (bf16_t*)smem;
    bf16_t* sB = sA + 2 * 8192;
    const int tid = TIDX(), lane = tid & 63, wave = tid >> 6;
    const int wm = wave >> 1, wn = wave & 1, l31 = lane & 31, hh = lane >> 5;
    u32x4 r0a[4], r0b[4], r1a[4], r1b[4];
    const bf16_t* Ap = A + (size_t)(row0 + (tid >> 3)) * lda + (tid & 7) * 8;
    const bf16_t* Bp = Bt + (size_t)(col0 + (tid >> 3)) * ldb + (tid & 7) * 8;
    const int wr_off = (tid >> 3) * 64 + (((tid & 7) ^ ((tid >> 4) & 7)) * 8);
    f32x16 acc[2][2];
#pragma unroll
    for (int a = 0; a < 2; ++a)
#pragma unroll
        for (int b = 0; b < 2; ++b)
#pragma unroll
            for (int i = 0; i < 16; ++i) acc[a][b][i] = 0.f;
    const int nk = K >> 6;
#pragma unroll
    for (int i = 0; i < 4; ++i) { r0a[i] = *(const u32x4*)(Ap + (size_t)i * 32 * lda); r0b[i] = *(const u32x4*)(Bp + (size_t)i * 32 * ldb); }
#pragma unroll
    for (int i = 0; i < 4; ++i) { *(u32x4*)(sA + wr_off + i * 2048) = r0a[i]; *(u32x4*)(sB + wr_off + i * 2048) = r0b[i]; }
#pragma unroll
    for (int i = 0; i < 4; ++i) { gld16(r1a[i], Ap + (size_t)i * 32 * lda + 64); gld16(r1b[i], Bp + (size_t)i * 32 * ldb + 64); }
    __syncthreads();
    const int sw = (l31 >> 1) & 7;
    const bf16_t* cA = sA + (wm * 64 + l31) * 64;
    const bf16_t* cB = sB + (wn * 64 + l31) * 64;
#define GEMM_LDFRAG(buf_, ks_, a0_, a1_, b0_, b1_) do { const int ch = ((2 * (ks_) + hh) ^ sw) * 8; \
            a0_ = *(const bf16x8*)(cA + (buf_) * 8192 + ch); a1_ = *(const bf16x8*)(cA + (buf_) * 8192 + 32 * 64 + ch); \
            b0_ = *(const bf16x8*)(cB + (buf_) * 8192 + ch); b1_ = *(const bf16x8*)(cB + (buf_) * 8192 + 32 * 64 + ch); } while (0)
#define GEMM_MMA(a0_, a1_, b0_, b1_) do { acc[0][0] = MFMA32(a0_, b0_, acc[0][0]); acc[0][1] = MFMA32(a0_, b1_, acc[0][1]); \
            acc[1][0] = MFMA32(a1_, b0_, acc[1][0]); acc[1][1] = MFMA32(a1_, b1_, acc[1][1]); } while (0)
#define SB_ __builtin_amdgcn_sched_barrier(0)
#define GEMM_COMPUTE(buf_) do { bf16x8 pa0, pa1, pb0, pb1, qa0, qa1, qb0, qb1; \
            GEMM_LDFRAG(buf_, 0, pa0, pa1, pb0, pb1); GEMM_LDFRAG(buf_, 1, qa0, qa1, qb0, qb1); SB_; GEMM_MMA(pa0, pa1, pb0, pb1); SB_; \
            GEMM_LDFRAG(buf_, 2, pa0, pa1, pb0, pb1); SB_; GEMM_MMA(qa0, qa1, qb0, qb1); SB_; \
            GEMM_LDFRAG(buf_, 3, qa0, qa1, qb0, qb1); SB_; GEMM_MMA(pa0, pa1, pb0, pb1); SB_; GEMM_MMA(qa0, qa1, qb0, qb1); SB_; } while (0)
    for (int kt = 0; kt < nk; kt += 2) {
        const bool m2 = (kt + 2) < nk, m3 = (kt + 3) < nk;
        if (m2 && MODE == 0) {
            const int k0 = (kt + 2) << 6;
#pragma unroll
            for (int i = 0; i < 4; ++i) { gld16(r0a[i], Ap + (size_t)i * 32 * lda + k0); gld16(r0b[i], Bp + (size_t)i * 32 * ldb + k0); }
        }
        GEMM_COMPUTE(0);
        vm_wait_sel(r1a[0], r1a[1], r1a[2], r1a[3], r1b[0], r1b[1], r1b[2], r1b[3], __builtin_amdgcn_readfirstlane((m2 && MODE == 0) ? 0 : 1));
        if (MODE < 2)
#pragma unroll
        for (int i = 0; i < 4; ++i) { *(u32x4*)(sA + 8192 + wr_off + i * 2048) = r1a[i]; *(u32x4*)(sB + 8192 + wr_off + i * 2048) = r1b[i]; }
        __syncthreads();
        if (m3 && MODE == 0) {
            const int k0 = (kt + 3) << 6;
#pragma unroll
            for (int i = 0; i < 4; ++i) { gld16(r1a[i], Ap + (size_t)i * 32 * lda + k0); gld16(r1b[i], Bp + (size_t)i * 32 * ldb + k0); }
        }
        GEMM_COMPUTE(1);
        if (m2) {
            vm_wait_sel(r0a[0], r0a[1], r0a[2], r0a[3], r0b[0], r0b[1], r0b[2], r0b[3], __builtin_amdgcn_readfirstlane((m3 && MODE == 0) ? 0 : 1));
            if (MODE < 2)
#pragma unroll
            for (int i = 0; i < 4; ++i) { *(u32x4*)(sA + wr_off + i * 2048) = r0a[i]; *(u32x4*)(sB + wr_off + i * 2048) = r0b[i]; }
        }
        __syncthreads();
    }
#undef GEMM_COMPUTE
#undef GEMM_LDFRAG
#undef GEMM_MMA
    epi(acc, row0 + wm * 64, col0 + wn * 64);
}

DI const bf16_t* uni_ptr(const bf16_t* p) {
    const unsigned long long v = (unsigned long long)p;
    const unsigned lo = __builtin_amdgcn_readfirstlane((unsigned)v), hi = __builtin_amdgcn_readfirstlane((unsigned)(v >> 32));
    return (const bf16_t*)(((unsigned long long)hi << 32) | lo); }
DI void gld16s(u32x4& r, unsigned voff, const void* sbase) { asm volatile("global_load_dwordx4 %0, %1, %2" : "=&v"(r) : "v"(voff), "s"(sbase) : "memory"); }
DI void vm_wait12(u32x4& a, u32x4& b, u32x4& c, u32x4& d, u32x4& e, u32x4& f, u32x4& g, u32x4& h, u32x4& i, u32x4& j, u32x4& k, u32x4& l) {
    asm volatile("s_waitcnt vmcnt(0)" : "+v"(a), "+v"(b), "+v"(c), "+v"(d), "+v"(e), "+v"(f), "+v"(g), "+v"(h), "+v"(i), "+v"(j), "+v"(k), "+v"(l) : : "memory"); }

template <class Epi>
DI void gemm_tile256(const bf16_t* __restrict__ A, int lda, const bf16_t* __restrict__ Bt, int ldb, int K, int row0, int col0, char* smem, Epi&& epi) {
    bf16_t* sA = (bf16_t*)smem;
    bf16_t* sB = sA + 256 * 64;
    const int tid = TIDX(), lane = tid & 63, wave = tid >> 6;
    const int wm = wave >> 1, wn = wave & 1, l31 = lane & 31, hh = lane >> 5;
    u32x4 ra[8], rb[4];
    const bf16_t* Ab = uni_ptr(A + (size_t)row0 * lda);
    const bf16_t* Bb = uni_ptr(Bt + (size_t)col0 * ldb);
    const unsigned voa = ((unsigned)(tid >> 3) * (unsigned)lda + (tid & 7) * 8) * 2u;
    const unsigned vob = ((unsigned)(tid >> 3) * (unsigned)ldb + (tid & 7) * 8) * 2u;
    const int wr_off = (tid >> 3) * 64 + (((tid & 7) ^ ((tid >> 4) & 7)) * 8);
    f32x16 acc[4][2];
#pragma unroll
    for (int a = 0; a < 4; ++a)
#pragma unroll
        for (int b = 0; b < 2; ++b)
#pragma unroll
            for (int i = 0; i < 16; ++i) acc[a][b][i] = 0.f;
    const int nk = K >> 6;
#pragma unroll
    for (int i = 0; i < 8; ++i) gld16s(ra[i], voa, Ab + (size_t)i * 32 * lda);
#pragma unroll
    for (int i = 0; i < 4; ++i) gld16s(rb[i], vob, Bb + (size_t)i * 32 * ldb);
    const int sw = (l31 >> 1) & 7;
    const bf16_t* cA = sA + (wm * 128 + l31) * 64;
    const bf16_t* cB = sB + (wn * 64 + l31) * 64;
    for (int kt = 0; kt < nk; ++kt) {
        vm_wait12(ra[0], ra[1], ra[2], ra[3], ra[4], ra[5], ra[6], ra[7], rb[0], rb[1], rb[2], rb[3]);
#pragma unroll
        for (int i = 0; i < 8; ++i) *(u32x4*)(sA + wr_off + i * 2048) = ra[i];
#pragma unroll
        for (int i = 0; i < 4; ++i) *(u32x4*)(sB + wr_off + i * 2048) = rb[i];
        __syncthreads();
        if (kt + 1 < nk) {
            const int k0 = (kt + 1) << 6;
#pragma unroll
            for (int i = 0; i < 8; ++i) gld16s(ra[i], voa, Ab + (size_t)i * 32 * lda + k0);
#pragma unroll
            for (int i = 0; i < 4; ++i) gld16s(rb[i], vob, Bb + (size_t)i * 32 * ldb + k0);
        }
        __builtin_amdgcn_s_setprio(1);
#pragma unroll
        for (int ks = 0; ks < 4; ++ks) {
            const int ch = ((2 * ks + hh) ^ sw) * 8;
            const bf16x8 b0 = *(const bf16x8*)(cB + ch), b1 = *(const bf16x8*)(cB + 32 * 64 + ch);
#pragma unroll
            for (int mi = 0; mi < 4; ++mi) {
                const bf16x8 a = *(const bf16x8*)(cA + mi * 32 * 64 + ch);
                acc[mi][0] = MFMA32(a, b0, acc[mi][0]);
                acc[mi][1] = MFMA32(a, b1, acc[mi][1]);
            }
        }
        __builtin_amdgcn_s_setprio(0);
        __syncthreads();
    }
    epi(acc, row0 + wm * 128, col0 + wn * 64);
}

DI void transpose_store(bf16_t* dst, int K, int n0, int k0, const float* tile) {
    const int kp = TIDX() & 31, nn = TIDX() >> 5;
#pragma unroll
    for (int i = 0; i < 8; ++i) {
        const int n = nn + 8 * i;
        *(unsigned*)(dst + (size_t)(n0 + n) * K + k0 + 2 * kp) = pack2(tile[(2 * kp) * 65 + n], tile[(2 * kp + 1) * 65 + n]);
    }
}
template <class F>
DI void transpose_tile(bf16_t* dst, int K, int tn, int tk, F src, float* tile) {
    const int tx = TIDX() & 63, ty = TIDX() >> 6;
    const int n0 = tn * 64, k0 = tk * 64;
    float v[16];
#pragma unroll
    for (int i = 0; i < 16; ++i) v[i] = src(k0 + ty + 4 * i, n0 + tx);
#pragma unroll
    for (int i = 0; i < 16; ++i) tile[(ty + 4 * i) * 65 + tx] = v[i];
    __syncthreads();
    transpose_store(dst, K, n0, k0, tile);
    __syncthreads();
}
DI void poolfold_tile(bf16_t* dst, int tn, int tk, const float* wi, const float* pw, const float* ps, float* smemf) {
    float* wt = smemf;
    float* pt = smemf + 64 * 65;
    float* ot = pt + 64 * 64;
    const int tx = TIDX() & 63, ty = TIDX() >> 6;
    const int n0 = tn * 64, k0 = tk * 64, g = (n0 - IN_POOL) >> 6;
    const float sc = ps[g * 64 + tx];
#pragma unroll
    for (int i = 0; i < 16; ++i) {
        const int r = ty + 4 * i;
        wt[r * 65 + tx] = wi[(size_t)(k0 + r) * DIN + IN_POOL + g * 64 + tx];
        pt[r * 64 + tx] = pw[g * 4096 + r * 64 + tx] * sc;
    }
    __syncthreads();
    float acc[16];
#pragma unroll
    for (int i = 0; i < 16; ++i) acc[i] = 0.f;
    for (int ii = 0; ii < 64; ++ii) {
        const float pv = pt[ii * 64 + tx];
#pragma unroll
        for (int i = 0; i < 16; ++i) acc[i] += wt[(ty + 4 * i) * 65 + ii] * pv;
    }
#pragma unroll
    for (int i = 0; i < 16; ++i) ot[(ty + 4 * i) * 65 + tx] = acc[i];
    __syncthreads();
    transpose_store(dst, 1024, n0, k0, ot);
    __syncthreads();
}

PH_FN void prep_phase(const KP& p, char* smem) {
    float* tile = (float*)smem;
    bf16_t* W = (bf16_t*)(p.ws + OFF_W);
    const int NTR = 5024;
    const int n_items = 2 * NTR + 288 + 1 + 16;
    for (int it = blockIdx.x; it < n_items; it += gridDim.x) {
        if (it < 2 * NTR) {
            const int l = it / NTR; int r = it % NTR;
            bf16_t* Wl = W + (size_t)l * WL_EL;
            if (r < 2816) {
                const int f = r / 1408; r %= 1408;
                const float* g = p.in[8] + (size_t)(l * 2 + f) * D * FF;
                const float* u = p.in[9] + (size_t)(l * 2 + f) * D * FF;
                transpose_tile(Wl + (f ? WO_GU1 : WO_GU0), 1024, r / 16, r % 16, [&](int k, int n) {
                    const int j = n >> 7, w = n & 127, c = j * 64 + (w >> 6) * 32 + (w & 31);
                    return ((w >> 5) & 1) ? u[(size_t)k * FF + c] : g[(size_t)k * FF + c]; }, tile);
            } else if (r < 2816 + 1408) {
                r -= 2816; const int f = r / 704; r %= 704;
                const float* dn = p.in[10] + (size_t)(l * 2 + f) * FF * D;
                transpose_tile(Wl + (f ? WO_D1 : WO_D0), 2816, r / 44, r % 44, [&](int k, int n) { return dn[(size_t)k * D + n]; }, tile);
            } else if (r < 4224 + 384) {
                r -= 4224;
                const float* wi = p.in[11] + (size_t)l * D * DIN;
                const float* pw = p.in[27] + (size_t)l * 4 * 64 * 64;
                const float* ps = p.in[28] + (size_t)l * 256;
                const int tn = r / 16, tk = r % 16;
                if (tn >= IN_POOL / 64 && tn < IN_CQ / 64) poolfold_tile(Wl + WO_IN, tn, tk, wi, pw, ps, tile);
                else transpose_tile(Wl + WO_IN, 1024, tn, tk, [&](int k, int n) { return n < DIN ? wi[(size_t)k * DIN + n] : 0.f; }, tile);
            } else if (r < 4608 + 320) {
                r -= 4608;
                const float* wo = p.in[12] + (size_t)l * DMIX * D;
                transpose_tile(Wl + WO_OUT, 1280, r / 20, r % 20, [&](int k, int n) { return wo[(size_t)k * D + n]; }, tile);
            } else if (r < 4928 + 48) {
                r -= 4928;
                const float* wq = p.in[30] + (size_t)l * 256 * 768;
                const float* gn = p.in[29] + (size_t)l * 256;
                transpose_tile(Wl + WO_UQ, 256, r / 4, r % 4, [&](int k, int n) { return wq[(size_t)k * 768 + n] * gn[k] * QSCALE; }, tile);
            } else if (r < 4976 + 32) {
                r -= 4976;
                const float* wk = p.in[32] + (size_t)l * 128 * 1024;
                const float* gn = p.in[31] + (size_t)l * 128;
                transpose_tile(Wl + WO_UKV, 128, r / 2, r % 2, [&](int k, int n) { return wk[(size_t)k * 1024 + n] * gn[k]; }, tile);
            } else {
                r -= 5008;
                const float* wg = p.in[21] + (size_t)l * 256 * 256;
                transpose_tile(Wl + WO_GLU, 256, r / 4, r % 4, [&](int k, int n) { return wg[(size_t)k * 256 + n]; }, tile);
            }
        } else if (it < 2 * NTR + 288) {
            const int r = it - 2 * NTR, l = r / 144, n0 = (r % 144) * 64;
            float* sc = (float*)smem;
            float* red = sc + 3072;
            for (int i = TIDX(); i < 3072; i += 256) {
                const int v = i >> 10, k = i & 1023;
                const float cv = v < 2 ? p.in[1][v * 1024 + k] : p.in[3][k];
                sc[i] = cv / (1.f + expf(-cv));
            }
            __syncthreads();
            const int tx = TIDX() & 63, ty = TIDX() >> 6;
            const float* wa = p.in[4] + (size_t)l * D * 9216 + n0 + tx;
            float a0 = 0.f, a1 = 0.f, a2 = 0.f;
#pragma unroll 32
            for (int k = ty * 256; k < ty * 256 + 256; ++k) {
                const float w = wa[(size_t)k * 9216];
                a0 += sc[k] * w; a1 += sc[1024 + k] * w; a2 += sc[2048 + k] * w;
            }
            red[(ty * 3 + 0) * 64 + tx] = a0; red[(ty * 3 + 1) * 64 + tx] = a1; red[(ty * 3 + 2) * 64 + tx] = a2;
            __syncthreads();
            if (TIDX() < 192) {
                const int v = TIDX() >> 6;
                float s = p.in[5][l * 9216 + n0 + tx];
                for (int q = 0; q < 4; ++q) s += red[(q * 3 + v) * 64 + tx];
                ((float*)(p.ws + OFF_MOD))[(size_t)(l * 3 + v) * 9216 + n0 + tx] = s;
            }
            __syncthreads();
        } else if (it == 2 * NTR + 288) {
            float* tab = (float*)(p.ws + OFF_ROPE);
            const int pos = TIDX();
            for (int i = 0; i < 8; ++i) {
                const float inv = powf(10000.f, -(float)(2 * i) / 16.f);
                const float ang = (float)pos * inv;
                tab[(pos * 8 + i) * 2 + 0] = cosf(ang);
                tab[(pos * 8 + i) * 2 + 1] = sinf(ang);
            }
        } else {
            const int idx = (it - (2 * NTR + 289)) * 256 + TIDX();
            const int pp = idx & 63, g = (idx >> 6) & 15, ld = idx >> 10;
            float lr = fminf(p.in[13][idx], -1e-4f), li = p.in[14][idx];
            const float dt = expf(p.in[15][ld * 16 + g]);
            const float mag = expf(lr * dt);
            const float br = mag * cosf(li * dt), bi = mag * sinf(li * dt);
            float tr = br, ti = bi;
            for (int q = 0; q < 6; ++q) { const float nr = tr * tr - ti * ti, ni = 2.f * tr * ti; tr = nr; ti = ni; }
            ((float4*)(p.ws + OFF_LAMB))[idx] = make_float4(br, bi, tr, ti);
            const float nr = br - 1.f, ni = bi, den = 1.f / (lr * lr + li * li);
            const float cr = (nr * lr + ni * li) * den, ci = (ni * lr - nr * li) * den;
            float* bb = (float*)(p.ws + OFF_BBAR) + (size_t)idx * 32;
            const float* sbr = p.in[16] + (size_t)idx * 16; const float* sbi = p.in[17] + (size_t)idx * 16;
            for (int h = 0; h < 16; ++h) { const float xr = sbr[h], xi = sbi[h]; bb[2 * h] = cr * xr - ci * xi; bb[2 * h + 1] = cr * xi + ci * xr; }
            bf16_t* cc = (bf16_t*)(p.ws + OFF_CC) + (size_t)(ld * 16 + g) * 2048;
            const float* scr = p.in[18] + (size_t)(ld * 16 + g) * 1024; const float* sci = p.in[19] + (size_t)(ld * 16 + g) * 1024;
            for (int h = 0; h < 16; ++h) { cc[h * 128 + pp] = f2bf(scr[h * 64 + pp]); cc[h * 128 + 64 + pp] = f2bf(-sci[h * 64 + pp]); }
        }
    }
}

PH_FN void rowop_phase(const KP& p, int l_mod_post, int gate_idx, float coef, const float* gpost, bool has_y,
                    int l_mod_pre, int shift_idx, const float* gpre, bool has_pre, bool first, int nrows = NT) {
    const int lane = TIDX() & 63;
    const int wid = blockIdx.x * 4 + (TIDX() >> 6), nw = gridDim.x * 4;
    bf16_t* HY = (bf16_t*)(p.ws + OFF_HY);
    float* Xc = (float*)(p.ws + OFF_XC);
    const float* MOD = (const float*)(p.ws + OFF_MOD);
    f4_t wpost[4], wpre[4], vg[4], vs0[4], vs1[4];
#pragma unroll
    for (int i = 0; i < 4; ++i) {
        wpost[i] = has_y ? *(const f4_t*)(gpost + lane * 4 + 256 * i) : f4_t{0.f, 0.f, 0.f, 0.f};
        wpre[i] = has_pre ? *(const f4_t*)(gpre + lane * 4 + 256 * i) : f4_t{0.f, 0.f, 0.f, 0.f};
        vg[i] = vs0[i] = vs1[i] = f4_t{0.f, 0.f, 0.f, 0.f};
    }
    int cur_mv = -1;
    for (int row0 = wid; row0 < nrows; row0 += 2 * nw) {
        int rows[2]; bool ok[2];
        rows[0] = row0; ok[0] = true;
        ok[1] = (row0 + nw) < nrows; rows[1] = ok[1] ? row0 + nw : row0;
        float* xp[2]; int mv[2];
        f4_t x[2][4], y[2][4];
        float ssy[2] = {0.f, 0.f};
#pragma unroll
        for (int q = 0; q < 2; ++q) {
            const int row = rows[q];
            mv[q] = row_mod(row);
            xp[q] = row < NL ? p.out + (size_t)row * D : Xc + (size_t)(row - NL) * D;
            const float* xin = first ? (row < NL ? p.in[0] + (size_t)row * D : p.in[2] + (size_t)(row - NL) * D) : xp[q];
#pragma unroll
            for (int i = 0; i < 4; ++i) x[q][i] = __builtin_nontemporal_load((const f4_t*)(xin + lane * 4 + 256 * i));
            if (has_y) {
#pragma unroll
                for (int i = 0; i < 4; ++i) {
                    const u2_t raw = __builtin_nontemporal_load((const u2_t*)(HY + (size_t)row * D + lane * 4 + 256 * i));
                    y[q][i].x = __uint_as_float(raw.x << 16); y[q][i].y = __uint_as_float(raw.x & 0xffff0000u);
                    y[q][i].z = __uint_as_float(raw.y << 16); y[q][i].w = __uint_as_float(raw.y & 0xffff0000u);
                    ssy[q] += y[q][i].x * y[q][i].x + y[q][i].y * y[q][i].y + y[q][i].z * y[q][i].z + y[q][i].w * y[q][i].w;
                }
            }
        }
        if (has_y) {
            for (int m = 32; m >= 1; m >>= 1) { ssy[0] += shflx(ssy[0], m); ssy[1] += shflx(ssy[1], m); }
        }
        float ssx[2] = {0.f, 0.f};
#pragma unroll
        for (int q = 0; q < 2; ++q) {
            if (mv[q] != cur_mv) {
                cur_mv = mv[q];
#pragma unroll
                for (int i = 0; i < 4; ++i) {
                    if (has_y) vg[i] = *(const f4_t*)(MOD + (size_t)(l_mod_post * 3 + cur_mv) * 9216 + gate_idx * 1024 + lane * 4 + 256 * i);
                    if (has_pre) {
                        const float* sh = MOD + (size_t)(l_mod_pre * 3 + cur_mv) * 9216 + shift_idx * 1024 + lane * 4 + 256 * i;
                        vs0[i] = *(const f4_t*)sh; vs1[i] = *(const f4_t*)(sh + 1024);
                    }
                }
            }
            if (has_y) {
                const float rstd = rsqrtf(ssy[q] * (1.f / D) + EPS);
#pragma unroll
                for (int i = 0; i < 4; ++i) x[q][i] += coef * vg[i] * (y[q][i] * rstd * wpost[i]);
                if (ok[q]) {
#pragma unroll
                    for (int i = 0; i < 4; ++i) __builtin_nontemporal_store(x[q][i], (f4_t*)(xp[q] + lane * 4 + 256 * i));
                }
            }
            if (has_pre) {
#pragma unroll
                for (int i = 0; i < 4; ++i) ssx[q] += x[q][i].x * x[q][i].x + x[q][i].y * x[q][i].y + x[q][i].z * x[q][i].z + x[q][i].w * x[q][i].w;
                for (int m = 32; m >= 1; m >>= 1) ssx[q] += shflx(ssx[q], m);
                const float rstd = rsqrtf(ssx[q] * (1.f / D) + EPS);
                if (ok[q]) {
#pragma unroll
                    for (int i = 0; i < 4; ++i) {
                        const f4_t h = x[q][i] * rstd * wpre[i] * (1.f + vs1[i]) + vs0[i];
                        uint2 o; o.x = pack2(h.x, h.y); o.y = pack2(h.z, h.w);
                        *(uint2*)(HY + (size_t)rows[q] * D + lane * 4 + 256 * i) = o;
                    }
                }
            }
        }
    }
}

template <int MODE = 0>
PH_FN void gemm1_phase(const KP& p, int l, int f, char* smem, int ntm = NT / 256) {
    const bf16_t* H = (const bf16_t*)(p.ws + OFF_HY);
    const bf16_t* W = (const bf16_t*)(p.ws + OFF_W) + (size_t)l * WL_EL + (f ? WO_GU1 : WO_GU0);
    bf16_t* ACT = (bf16_t*)(p.ws + OFF_ACT);
    const int lane = TIDX() & 63, l31 = lane & 31, hh = lane >> 5;
    const int n_items = (NL / 256) * 44;
    const int n_ctx = ntm > NL / 256 ? (NC / 128) * 44 : 0;
    for (int it = vblock(); it < n_ctx; it += gridDim.x) {
        const int mt = it / 44, nt = it - mt * 44;
        gemm_tile(H, D, W, D, D, NL + mt * 128, nt * 128, smem, [&](f32x16 (&acc)[2][2], int r0, int c0) {
            const int col = (c0 >> 7) * 64 + ((c0 >> 6) & 1) * 32 + l31;
#pragma unroll
            for (int mi = 0; mi < 2; ++mi)
#pragma unroll
                for (int i = 0; i < 16; ++i) ACT[(size_t)(r0 + 32 * mi + crow(i, hh)) * FF + col] = f2bf(siluf_(acc[mi][0][i]) * acc[mi][1][i]);
        });
    }
    for (int it = vblock(); it < n_items; it += gridDim.x) {
        int mt, nt; tile_mn(it, NL / 256, 44, mt, nt);
        gemm_tile256(H, D, W, D, D, mt * 256, nt * 128, smem, [&](f32x16 (&acc)[4][2], int r0, int c0) {
            const int col = (c0 >> 7) * 64 + ((c0 >> 6) & 1) * 32 + l31;
#pragma unroll
            for (int mi = 0; mi < 4; ++mi)
#pragma unroll
                for (int i = 0; i < 16; ++i) {
                    const int row = r0 + 32 * mi + crow(i, hh);
                    ACT[(size_t)row * FF + col] = f2bf(siluf_(acc[mi][0][i]) * acc[mi][1][i]);
                }
        });
    }
}

template <int MODE = 0>
PH_FN void gemm_store_phase(const bf16_t* A, int lda, const bf16_t* W, int K, int ntn, bf16_t* C, int ldc, int ncols, char* smem, int ntm = NT / 128) {
    const int lane = TIDX() & 63, l31 = lane & 31, hh = lane >> 5;
    const int n_items = ntm * ntn;
    for (int it = vblock(); it < n_items; it += gridDim.x) {
        int mt, nt; tile_mn(it, ntm, ntn, mt, nt);
        gemm_tile<MODE>(A, lda, W, K, K, mt * 128, nt * 128, smem, [&](f32x16 (&acc)[2][2], int r0, int c0) {
            if (MODE != 0 && acc[0][0][0] != 123456.789f) return;
#pragma unroll
            for (int ni = 0; ni < 2; ++ni) {
                const int col = c0 + 32 * ni + l31;
                if (col < ncols) {
#pragma unroll
                    for (int mi = 0; mi < 2; ++mi)
#pragma unroll
                        for (int i = 0; i < 16; ++i) C[(size_t)(r0 + 32 * mi + crow(i, hh)) * ldc + col] = f2bf(acc[mi][ni][i]);
                }
            }
        });
    }
}

template <int LDC>
PH_FN void gemm_store_phase256(const bf16_t* A, int lda, const bf16_t* W, int K, int ntn, bf16_t* C, char* smem, int ntm, int nctx128) {
    const int lane = TIDX() & 63, l31 = lane & 31, hh = lane >> 5;
    const int n_items = ntm * ntn;
    for (int it = vblock(); it < nctx128 * ntn; it += gridDim.x) {
        const int mt = it / ntn, nt = it - mt * ntn;
        gemm_tile(A, lda, W, K, K, NL + mt * 128, nt * 128, smem, [&](f32x16 (&acc)[2][2], int r0, int c0) {
#pragma unroll
            for (int mi = 0; mi < 2; ++mi) {
                bf16_t* cp = C + (size_t)(r0 + 32 * mi + 4 * hh) * LDC + c0 + l31;
#pragma unroll
                for (int ni = 0; ni < 2; ++ni)
#pragma unroll
                    for (int i = 0; i < 16; ++i) if (LDC == D || c0 + l31 + 32 * ni < LDC) cp[((i & 3) + 8 * (i >> 2)) * LDC + 32 * ni] = f2bf(acc[mi][ni][i]);
            }
        });
    }
    for (int it = vblock(); it < n_items; it += gridDim.x) {
        int mt, nt; tile_mn(it, ntm, ntn, mt, nt);
        gemm_tile256(A, lda, W, K, K, mt * 256, nt * 128, smem, [&](f32x16 (&acc)[4][2], int r0, int c0) {
#pragma unroll
            for (int mi = 0; mi < 4; ++mi) {
                bf16_t* cp = C + (size_t)(r0 + 32 * mi + 4 * hh) * LDC + c0 + l31;
#pragma unroll
                for (int ni = 0; ni < 2; ++ni)
#pragma unroll
                    for (int i = 0; i < 16; ++i) if (LDC == D || c0 + l31 + 32 * ni < LDC) cp[((i & 3) + 8 * (i >> 2)) * LDC + 32 * ni] = f2bf(acc[mi][ni][i]);
                __builtin_amdgcn_sched_barrier(0);
            }
        });
    }
}

PH_FN void glu_phase(const KP& p, int l, char* smem) {
    const bf16_t* S5P = (const bf16_t*)(p.ws + OFF_S5P);
    const bf16_t* W = (const bf16_t*)(p.ws + OFF_W) + (size_t)l * WL_EL + WO_GLU;
    bf16_t* MIX = (bf16_t*)(p.ws + OFF_MIX);
    const float* bg = p.in[22] + l * 256;
    const int lane = TIDX() & 63, l31 = lane & 31, hh = lane >> 5;
    const int n_items = (NT / 128) * 2;
    for (int it = vblock(); it < n_items; it += gridDim.x) {
        const int mt = it >> 1, nt = it & 1;
        gemm_tile(S5P, 256, W, 256, 256, mt * 128, nt * 128, smem, [&](f32x16 (&acc)[2][2], int r0, int c0) {
#pragma unroll
            for (int ni = 0; ni < 2; ++ni) {
                const int col = c0 + 32 * ni + l31;
                const float b = bg[col];
#pragma unroll
                for (int mi = 0; mi < 2; ++mi)
#pragma unroll
                    for (int i = 0; i < 16; ++i) {
                        const int row = r0 + 32 * mi + crow(i, hh);
                        const float y = bf2f(S5P[(size_t)row * 256 + col]);
                        MIX[(size_t)row * DMIX + col] = f2bf(y * sigmoidf_(acc[mi][ni][i] + b));
                        if ((i & 3) == 3) __builtin_amdgcn_sched_barrier(0);
                    }
            }
        });
    }
}

DI void key_pos(int row, int& b, int& pos) {
    if (row < NL) { b = row >= SEQ ? 1 : 0; pos = row - b * SEQ; }
    else { const int r = row - NL; b = r >> 8; pos = SEQ + (r & 255); }
}

DI void qkv_item(const KP& p, int l, int it, char* smem) {
    const bf16_t* Z = (const bf16_t*)(p.ws + OFF_Z);
    const bf16_t* Wl = (const bf16_t*)(p.ws + OFF_W) + (size_t)l * WL_EL;
    bf16_t* Q = (bf16_t*)(p.ws + OFF_Q);
    bf16_t* Kb = (bf16_t*)(p.ws + OFF_K);
    bf16_t* Vt = (bf16_t*)(p.ws + OFF_VT);
    const float* tab = (const float*)(p.ws + OFF_ROPE);
    const int mt = it / 14, sub = it % 14, row0 = mt * 128;
    const int tid = TIDX(), lane = tid & 63, l31 = lane & 31, hh = lane >> 5;
    __shared__ float s_rs[128];
    {
        const int r = tid >> 1, half = tid & 1;
        const bool isq = sub < 6;
        const int n = isq ? 128 : 64;
        const bf16_t* src = Z + (size_t)(row0 + r) * DIN + (isq ? IN_CQ : IN_CKV) + half * n;
        float ss = 0.f;
        auto sq8 = [&](const u32x4& v) {
#pragma unroll
            for (int q = 0; q < 4; ++q) { const float a = __uint_as_float(v[q] << 16), b = __uint_as_float(v[q] & 0xffff0000u); ss += a * a + b * b; }
        };
        if (isq) {
            u32x4 v[16];
#pragma unroll
            for (int i = 0; i < 16; ++i) v[i] = *(const u32x4*)(src + 8 * i);
#pragma unroll
            for (int i = 0; i < 16; ++i) sq8(v[i]);
        } else {
            u32x4 v[8];
#pragma unroll
            for (int i = 0; i < 8; ++i) v[i] = *(const u32x4*)(src + 8 * i);
#pragma unroll
            for (int i = 0; i < 8; ++i) sq8(v[i]);
        }
        ss += shflx(ss, 1);
        if (half == 0) s_rs[r] = rsqrtf(ss / (float)(2 * n) + EPS);
    }
    __syncthreads();
    if (sub < 6) {
        gemm_tile(Z + IN_CQ, DIN, Wl + WO_UQ, 256, 256, row0, sub * 128, smem, [&](f32x16 (&acc)[2][2], int r0, int c0) {
#pragma unroll
            for (int ni = 0; ni < 2; ++ni) {
                const int cb = c0 + 32 * ni, col = cb + l31;
                const bool is_rope = ((cb >> 5) % 3) == 2;
                const int axis = l31 >> 4, second = (l31 >> 3) & 1, fi = l31 & 7;
#pragma unroll
                for (int mi = 0; mi < 2; ++mi)
#pragma unroll
                    for (int i = 0; i < 16; ++i) {
                        const int row = r0 + 32 * mi + crow(i, hh);
                        float v = acc[mi][ni][i] * s_rs[row - row0];
                        if (is_rope) {
                            const float pr = shflx(v, 8);
                            if (row < NL) {
                                const int t = row & (SEQ - 1);
                                const int pos = axis ? (t & 63) : (t >> 6);
                                const float cs = tab[(pos * 8 + fi) * 2], sn = tab[(pos * 8 + fi) * 2 + 1];
                                v = second ? (v * cs + pr * sn) : (v * cs - pr * sn);
                            }
                        }
                        Q[(size_t)row * 768 + col] = f2bf(v);
                        if ((i & 3) == 3) __builtin_amdgcn_sched_barrier(0);
                    }
            }
        });
    } else {
        const int head = sub - 6;
        gemm_tile(Z + IN_CKV, DIN, Wl + WO_UKV, 128, 128, row0, head * 128, smem, [&](f32x16 (&acc)[2][2], int r0, int c0) {
            const bool isv = (c0 >> 6) & 1;
#pragma unroll
            for (int ni = 0; ni < 2; ++ni) {
                const int dcol = 32 * ni + l31;
#pragma unroll
                for (int mi = 0; mi < 2; ++mi)
#pragma unroll
                    for (int q = 0; q < 4; ++q) {
                        const int rowb = r0 + 32 * mi + 8 * q + 4 * hh;
                        int b, pos; key_pos(rowb, b, pos);
                        float v[4];
#pragma unroll
                        for (int j = 0; j < 4; ++j) v[j] = acc[mi][ni][4 * q + j] * s_rs[rowb + j - row0];
                        if (isv) {
                            uint2 o; o.x = pack2(v[0], v[1]); o.y = pack2(v[2], v[3]);
                            *(uint2*)(Vt + ((size_t)(b * NH + head) * 64 + dcol) * LK + ((pos & ~12) | ((pos & 4) << 1) | ((pos & 8) >> 1))) = o;
                        } else {
#pragma unroll
                            for (int j = 0; j < 4; ++j) Kb[((size_t)(b * NH + head) * LK + pos + j) * DK + dcol] = f2bf(v[j]);
                        }
                    }
            }
        });
        for (int e = tid; e < 128 * 32; e += 256) {
            const int r = e >> 5, d = e & 31, row = row0 + r;
            const bf16_t* kr = Z + (size_t)row * DIN + IN_KR;
            float v = bf2f(kr[d]);
            if (row < NL) {
                const float pr = bf2f(kr[d ^ 8]);
                const int t = row & (SEQ - 1), axis = d >> 4, second = (d >> 3) & 1, fi = d & 7;
                const int pos = axis ? (t & 63) : (t >> 6);
                const float cs = tab[(pos * 8 + fi) * 2], sn = tab[(pos * 8 + fi) * 2 + 1];
                v = second ? (v * cs + pr * sn) : (v * cs - pr * sn);
            }
            int b, pos; key_pos(row, b, pos);
            Kb[((size_t)(b * NH + head) * LK + pos) * DK + 64 + d] = f2bf(v);
        }
    }
    __syncthreads();
}

DI void convpool_item(const KP& p, int l, int it, char* smem) {
    const bf16_t* Z = (const bf16_t*)(p.ws + OFF_Z);
    bf16_t* MIX = (bf16_t*)(p.ws + OFF_MIX);
    float* hs = (float*)smem;
    int L, rowbase, t0;
    if (it < 1024) { L = SEQ; rowbase = (it >> 9) * SEQ; t0 = (it & 511) * 32; }
    else { const int r = it - 1024; L = CTXL; rowbase = NL + (r >> 3) * CTXL; t0 = (r & 7) * 32; }
    const int c = TIDX(), lane = c & 63, wave = c >> 6;
    {
        const int c4 = (c & 63) * 4, ts = c >> 6;
#pragma unroll 4
        for (int j = ts; j < 62; j += 4) {
            const int t = t0 - 15 + j;
            float4 h = make_float4(0.f, 0.f, 0.f, 0.f);
            if (t >= 0 && t < L) {
                const bf16_t* zr = Z + (size_t)(rowbase + t) * DIN + IN_CONV + c4;
                const uint2 v = *(const uint2*)zr, g = *(const uint2*)(zr + 256);
                h.x = __uint_as_float(v.x << 16) * sigmoidf_(__uint_as_float(g.x << 16));
                h.y = __uint_as_float(v.x & 0xffff0000u) * sigmoidf_(__uint_as_float(g.x & 0xffff0000u));
                h.z = __uint_as_float(v.y << 16) * sigmoidf_(__uint_as_float(g.y << 16));
                h.w = __uint_as_float(v.y & 0xffff0000u) * sigmoidf_(__uint_as_float(g.y & 0xffff0000u));
            }
            *(float4*)(hs + j * 256 + c4) = h;
        }
    }
    __syncthreads();
    float w[31];
#pragma unroll
    for (int k = 0; k < 31; ++k) w[k] = p.in[23][(size_t)(l * 31 + k) * 256 + c];
    const float cb = p.in[24][l * 256 + c];
#pragma unroll 1
    for (int tt = 0; tt < 32; ++tt) {
        float s = cb;
#pragma unroll
        for (int k = 0; k < 31; ++k) s += w[k] * hs[(tt + k) * 256 + c];
        hs[tt * 256 + c] = s;
    }
    __syncthreads();
    {
        const float4 lg = *(const float4*)(p.in[25] + l * 256 + lane * 4);
        const float4 lb = *(const float4*)(p.in[26] + l * 256 + lane * 4);
#pragma unroll 1
        for (int q = 0; q < 8; ++q) {
            const int tt = wave * 8 + q;
            const float4 v = *(const float4*)(hs + tt * 256 + lane * 4);
            const float mean = wave_sum(v.x + v.y + v.z + v.w) * (1.f / 256.f);
            const float d0 = v.x - mean, d1 = v.y - mean, d2 = v.z - mean, d3 = v.w - mean;
            const float var = wave_sum(d0 * d0 + d1 * d1 + d2 * d2 + d3 * d3) * (1.f / 256.f);
            const float rstd = rsqrtf(var + EPS);
            uint2 o;
            o.x = pack2(siluf_(d0 * rstd * lg.x + lb.x), siluf_(d1 * rstd * lg.y + lb.y));
            o.y = pack2(siluf_(d2 * rstd * lg.z + lb.z), siluf_(d3 * rstd * lg.w + lb.w));
            *(uint2*)(MIX + (size_t)(rowbase + t0 + tt) * DMIX + 256 + lane * 4) = o;
        }
    }
    __syncthreads();
    {
        const int c4 = (c & 63) * 4, ts = c >> 6;
#pragma unroll 4
        for (int j = ts; j < 47; j += 4) {
            const int t = t0 - 7 + j;
            float4 h = make_float4(0.f, 0.f, 0.f, 0.f);
            if (t >= 0 && t < L) {
                const uint2 v = *(const uint2*)(Z + (size_t)(rowbase + t) * DIN + IN_POOL + c4);
                h.x = __uint_as_float(v.x << 16); h.y = __uint_as_float(v.x & 0xffff0000u); h.z = __uint_as_float(v.y << 16); h.w = __uint_as_float(v.y & 0xffff0000u);
            }
            *(float4*)(hs + j * 256 + c4) = h;
        }
    }
    __syncthreads();
    {
        const int win = 2 << (c >> 6), wa = (win - 1) >> 1, wb = win >> 1;
#pragma unroll 1
        for (int tt = 0; tt < 32; ++tt) {
            const int t = t0 + tt;
            const int lo = max(t - wa, 0), hi = min(t + wb, L - 1);
            float s = 0.f;
            for (int q = lo; q <= hi; ++q) s += hs[(q - t0 + 7) * 256 + c];
            const float o = s / (float)(hi - lo + 1) - hs[(tt + 7) * 256 + c];
            MIX[(size_t)(rowbase + t) * DMIX + 512 + c] = f2bf(o);
        }
    }
    __syncthreads();
}

DI int chunk_row(int b, int k) { return k < 4 ? NL + b * CTXL + 64 * k : b * SEQ + 64 * (k - 4); }

template <bool FINAL>
DI void s5_item(const KP& p, int l, int it, char* smem) {
    const int g4 = it & 3, k = (it >> 2) % NCHUNK, b = (it >> 2) / NCHUNK;
    const int tid = TIDX(), lane = tid & 63, wave = tid >> 6, g = g4 * 4 + wave;
    const bf16_t* Z = (const bf16_t*)(p.ws + OFF_Z);
    float* Us = (float*)smem + wave * 1024;
    bf16_t* Hs = (bf16_t*)(smem + 16384) + wave * (16 * 136);
    const int rbase = chunk_row(b, k);
    {
        const uint4* src = (const uint4*)(Z + (size_t)(rbase + lane) * DIN + g * 16);
        const uint4 v0 = src[0], v1 = src[1];
        const unsigned w[8] = {v0.x, v0.y, v0.z, v0.w, v1.x, v1.y, v1.z, v1.w};
#pragma unroll
        for (int q = 0; q < 8; ++q) { Us[lane * 16 + 2 * q] = __uint_as_float(w[q] << 16); Us[lane * 16 + 2 * q + 1] = __uint_as_float(w[q] & 0xffff0000u); }
    }
    __syncthreads();
    f32x4 yacc[4];
#pragma unroll
    for (int s = 0; s < 4; ++s) yacc[s] = f32x4{0.f, 0.f, 0.f, 0.f};
#pragma unroll
    for (int dir = 0; dir < 2; ++dir) {
        const int pidx = ((l * 2 + dir) * 16 + g) * 64 + lane;
        const float4 lam = ((const float4*)(p.ws + OFF_LAMB))[pidx];
        float br[16], bi[16];
        {
            const float4* bb = (const float4*)((const float*)(p.ws + OFF_BBAR) + (size_t)pidx * 32);
#pragma unroll
            for (int q = 0; q < 8; ++q) { const float4 v = bb[q]; br[2 * q] = v.x; bi[2 * q] = v.y; br[2 * q + 1] = v.z; bi[2 * q + 1] = v.w; }
        }
        const size_t sidx = ((size_t)((b * 2 + dir) * NCHUNK + k) * 16 + g) * 64 + lane;
        float hr = 0.f, hi = 0.f;
        bf16x8 cfr[4];
        if (FINAL) {
            const float2 s0 = ((const float2*)(p.ws + OFF_S))[sidx];
            hr = s0.x; hi = s0.y;
            const bf16_t* cc = (const bf16_t*)(p.ws + OFF_CC) + (size_t)((l * 2 + dir) * 16 + g) * 2048 + (lane & 15) * 128 + (lane >> 4) * 8;
#pragma unroll
            for (int ks = 0; ks < 4; ++ks) cfr[ks] = *(const bf16x8*)(cc + 32 * ks);
        }
#pragma unroll
        for (int s = 0; s < 4; ++s) {
            const int sb = dir ? 3 - s : s;
#pragma unroll 1
            for (int tt = 0; tt < 16; ++tt) {
                const int tl = dir ? 15 - tt : tt, t = sb * 16 + tl;
                const float4* up = (const float4*)(Us + t * 16);
                float ar = 0.f, ai = 0.f;
#pragma unroll
                for (int q = 0; q < 4; ++q) {
                    const float4 u = up[q];
                    ar += br[4 * q] * u.x + br[4 * q + 1] * u.y + br[4 * q + 2] * u.z + br[4 * q + 3] * u.w;
                    ai += bi[4 * q] * u.x + bi[4 * q + 1] * u.y + bi[4 * q + 2] * u.z + bi[4 * q + 3] * u.w;
                }
                const float nr = lam.x * hr - lam.y * hi + ar, ni = lam.x * hi + lam.y * hr + ai;
                hr = nr; hi = ni;
                if (FINAL) { Hs[tl * 136 + lane] = f2bf(hr); Hs[tl * 136 + 64 + lane] = f2bf(hi); }
            }
            if (FINAL) {
                __syncthreads();
                const bf16_t* hp = Hs + (lane & 15) * 136 + (lane >> 4) * 8;
#pragma unroll
                for (int ks = 0; ks < 4; ++ks) { const bf16x8 a = *(const bf16x8*)(hp + 32 * ks); yacc[sb] = MFMA16(a, cfr[ks], yacc[sb]); }
                __syncthreads();
            }
        }
        if (!FINAL) ((float2*)(p.ws + OFF_E))[sidx] = make_float2(hr, hi);
    }
    if (FINAL) {
        bf16_t* S5P = (bf16_t*)(p.ws + OFF_S5P);
        const int hcol = lane & 15;
        const float dg = p.in[20][l * 256 + g * 16 + hcol];
#pragma unroll
        for (int s = 0; s < 4; ++s)
#pragma unroll
            for (int j = 0; j < 4; ++j) {
                const int t = s * 16 + (lane >> 4) * 4 + j;
                const float y = yacc[s][j] + dg * Us[t * 16 + hcol];
                S5P[(size_t)(rbase + t) * 256 + g * 16 + hcol] = f2bf(gelu_tanh(y));
            }
    }
    __syncthreads();
}

DI void s5_carry(const KP& p, int l, int blk) {
    const int idx = blk * 256 + TIDX();
    const int gp = idx & 1023, dir = (idx >> 10) & 1, b = idx >> 11;
    const float4 lam = ((const float4*)(p.ws + OFF_LAMB))[(l * 2 + dir) * 1024 + gp];
    const float2* E = (const float2*)(p.ws + OFF_E) + (size_t)(b * 2 + dir) * NCHUNK * 1024 + gp;
    float2* S = (float2*)(p.ws + OFF_S) + (size_t)(b * 2 + dir) * NCHUNK * 1024 + gp;
    float sr = 0.f, si = 0.f;
    for (int j0 = 0; j0 < NCHUNK; j0 += 4) {
        const int k0 = dir ? (j0 < 4 ? 3 - j0 : 263 - j0) : j0, stp = dir ? -1 : 1;
        const float2 e0 = E[(size_t)k0 * 1024], e1 = E[(size_t)(k0 + stp) * 1024], e2 = E[(size_t)(k0 + 2 * stp) * 1024], e3 = E[(size_t)(k0 + 3 * stp) * 1024];
        float nr, ni;
        S[(size_t)k0 * 1024] = make_float2(sr, si);
        nr = lam.z * sr - lam.w * si + e0.x; ni = lam.z * si + lam.w * sr + e0.y; sr = nr; si = ni;
        S[(size_t)(k0 + stp) * 1024] = make_float2(sr, si);
        nr = lam.z * sr - lam.w * si + e1.x; ni = lam.z * si + lam.w * sr + e1.y; sr = nr; si = ni;
        S[(size_t)(k0 + 2 * stp) * 1024] = make_float2(sr, si);
        nr = lam.z * sr - lam.w * si + e2.x; ni = lam.z * si + lam.w * sr + e2.y; sr = nr; si = ni;
        S[(size_t)(k0 + 3 * stp) * 1024] = make_float2(sr, si);
        nr = lam.z * sr - lam.w * si + e3.x; ni = lam.z * si + lam.w * sr + e3.y; sr = nr; si = ni;
    }
}

DI void attn_item(const KP& p, int it, char* smem) {
    const bf16_t* Q = (const bf16_t*)(p.ws + OFF_Q);
    const bf16_t* Kg = (const bf16_t*)(p.ws + OFF_K);
    const bf16_t* Vg = (const bf16_t*)(p.ws + OFF_VT);
    bf16_t* MIX = (bf16_t*)(p.ws + OFF_MIX);
    const int tid = TIDX(), lane = tid & 63, wave = tid >> 6, l31 = lane & 31, hh = lane >> 5;
    int bh, qrow0, kt0, T;
    if (it < 1024) { bh = it >> 6; qrow0 = (bh >> 3) * SEQ + (it & 63) * 256; kt0 = 0; T = NCHUNK; }
    else { bh = it - 1024; qrow0 = NL + (bh >> 3) * CTXL; kt0 = SEQ / 64; T = CTXL / 64; }
    const int head = bh & 7;
    const bf16_t* Kb = Kg + (size_t)bh * LK * DK + (size_t)kt0 * 64 * DK;
    const bf16_t* Vb = Vg + (size_t)bh * 64 * LK + kt0 * 64;
    bf16_t* sK = (bf16_t*)smem;
    bf16_t* sV = sK + 2 * 64 * 104;
    const int qrow = qrow0 + wave * 64 + l31;
    bf16x8 qf[2][6];
#pragma unroll
    for (int qb = 0; qb < 2; ++qb)
#pragma unroll
        for (int s = 0; s < 6; ++s) qf[qb][s] = *(const bf16x8*)(Q + (size_t)(qrow + 32 * qb) * 768 + head * 96 + 16 * s + 8 * hh);
    f32x16 o[2][2];
#pragma unroll
    for (int i = 0; i < 16; ++i) { o[0][0][i] = 0.f; o[0][1][i] = 0.f; o[1][0][i] = 0.f; o[1][1][i] = 0.f; }
    float m_run[2] = {-1e30f, -1e30f}, l_run[2] = {0.f, 0.f};
    u32x4 rk0, rk1, rk2, rv0, rv1;
    const int vrow = tid >> 3, vcol = (tid & 7) * 8;
    const int kw0 = (tid / 12) * 104 + (tid % 12) * 8, kw1 = ((tid + 256) / 12) * 104 + ((tid + 256) % 12) * 8, kw2 = ((tid + 512) / 12) * 104 + ((tid + 512) % 12) * 8;
    const bf16_t* cK = sK + l31 * 104 + 8 * hh;
    const bf16_t* cV = sV + l31 * 72 + 8 * hh;
#define ATT_KWRITE(buf_) do { bf16_t* k_ = sK + (buf_) * 64 * 104; *(u32x4*)(k_ + kw0) = rk0; *(u32x4*)(k_ + kw1) = rk1; *(u32x4*)(k_ + kw2) = rk2; } while (0)
#define ATT_VWRITE(buf_) do { bf16_t* v_ = sV + (buf_) * 64 * 72 + vrow * 72 + vcol; *(u32x4*)(v_) = rv0; *(u32x4*)(v_ + 32 * 72) = rv1; } while (0)
    {
        const bf16_t* kp = Kb + tid * 8;
        rk0 = *(const u32x4*)(kp); rk1 = *(const u32x4*)(kp + 2048); rk2 = *(const u32x4*)(kp + 4096);
        const bf16_t* vp = Vb + (size_t)vrow * LK + vcol;
        rv0 = *(const u32x4*)(vp); rv1 = *(const u32x4*)(vp + (size_t)32 * LK);
        ATT_KWRITE(0); ATT_VWRITE(0);
    }
    __syncthreads();
    for (int t = 0; t < T; ++t) {
        const int buf = t & 1;
        const bool more = (t + 1) < T;
        if (more) {
            const bf16_t* kp_ = Kb + (size_t)(t + 1) * 64 * DK + tid * 8; gld16(rk0, kp_); gld16(rk1, kp_ + 2048); gld16(rk2, kp_ + 4096);
            const bf16_t* vp_ = Vb + (size_t)vrow * LK + (t + 1) * 64 + vcol; gld16(rv0, vp_); gld16(rv1, vp_ + (size_t)32 * LK);
        }
#pragma unroll
        for (int kb = 0; kb < 2; ++kb) {
            f32x16 s[2];
#pragma unroll
            for (int i = 0; i < 16; ++i) { s[0][i] = 0.f; s[1][i] = 0.f; }
            bf16x8 kf[6];
#pragma unroll
            for (int ks = 0; ks < 6; ++ks) kf[ks] = *(const bf16x8*)(cK + buf * 64 * 104 + kb * 32 * 104 + 16 * ks);
            __builtin_amdgcn_sched_barrier(0);
            __builtin_amdgcn_s_setprio(1);
#pragma unroll
            for (int ks = 0; ks < 6; ++ks) {
                s[0] = MFMA32(kf[ks], qf[0][ks], s[0]);
                s[1] = MFMA32(kf[ks], qf[1][ks], s[1]);
            }
            __builtin_amdgcn_s_setprio(0);
#pragma unroll
            for (int qb = 0; qb < 2; ++qb) {
                float mx = s[qb][0];
#pragma unroll
                for (int i = 1; i < 16; ++i) mx = fmaxf(mx, s[qb][i]);
                mx = xhalf_max(mx);
                const float m_new = fmaxf(m_run[qb], mx);
                if (__builtin_amdgcn_ballot_w64(m_new > m_run[qb]) != 0ull) {
                    const float alpha = __builtin_amdgcn_exp2f(m_run[qb] - m_new);
                    m_run[qb] = m_new; l_run[qb] *= alpha;
#pragma unroll
                    for (int i = 0; i < 16; ++i) { o[qb][0][i] *= alpha; o[qb][1][i] *= alpha; }
                }
                float ps = 0.f;
#pragma unroll
                for (int i = 0; i < 16; ++i) { s[qb][i] = __builtin_amdgcn_exp2f(s[qb][i] - m_run[qb]); ps += s[qb][i]; }
                l_run[qb] += ps;
            }
            bf16x8 vf[2][2];
#pragma unroll
            for (int u = 0; u < 2; ++u)
#pragma unroll
                for (int dvb = 0; dvb < 2; ++dvb) vf[u][dvb] = *(const bf16x8*)(cV + buf * 64 * 72 + dvb * 32 * 72 + 32 * kb + 16 * u);
            __builtin_amdgcn_sched_barrier(0);
#pragma unroll
            for (int u = 0; u < 2; ++u) {
                const bf16x8 p0 = __builtin_bit_cast(bf16x8, u32x4{pack2(s[0][8 * u], s[0][8 * u + 1]), pack2(s[0][8 * u + 2], s[0][8 * u + 3]), pack2(s[0][8 * u + 4], s[0][8 * u + 5]), pack2(s[0][8 * u + 6], s[0][8 * u + 7])});
                const bf16x8 p1 = __builtin_bit_cast(bf16x8, u32x4{pack2(s[1][8 * u], s[1][8 * u + 1]), pack2(s[1][8 * u + 2], s[1][8 * u + 3]), pack2(s[1][8 * u + 4], s[1][8 * u + 5]), pack2(s[1][8 * u + 6], s[1][8 * u + 7])});
                __builtin_amdgcn_s_setprio(1);
#pragma unroll
                for (int dvb = 0; dvb < 2; ++dvb) {
                    o[0][dvb] = MFMA32(vf[u][dvb], p0, o[0][dvb]);
                    o[1][dvb] = MFMA32(vf[u][dvb], p1, o[1][dvb]);
                }
                __builtin_amdgcn_s_setprio(0);
            }
        }
        if (more) { vm_wait5(rk0, rk1, rk2, rv0, rv1); ATT_KWRITE(buf ^ 1); ATT_VWRITE(buf ^ 1); }
        __syncthreads();
    }
#undef ATT_KWRITE
#undef ATT_VWRITE
#pragma unroll
    for (int qb = 0; qb < 2; ++qb) {
        const float lt = xhalf_sum(l_run[qb]);
        const float inv = 1.f / lt;
#pragma unroll
        for (int dvb = 0; dvb < 2; ++dvb)
#pragma unroll
            for (int q = 0; q < 4; ++q) {
                uint2 ov; ov.x = pack2(o[qb][dvb][4 * q] * inv, o[qb][dvb][4 * q + 1] * inv); ov.y = pack2(o[qb][dvb][4 * q + 2] * inv, o[qb][dvb][4 * q + 3] * inv);
                *(uint2*)(MIX + (size_t)(qrow + 32 * qb) * DMIX + 768 + head * 64 + 32 * dvb + 8 * q + 4 * hh) = ov;
            }
    }
}

PH_FN void misc_phase(const KP& p, int l, char* smem) {
    const int n_qkv = 260 * 14, n_cp = l == 1 ? 1024 : 1040, n_s5 = 2 * NCHUNK * 4;
    const int rot = (blockIdx.x + gridDim.x / 2) % gridDim.x;
    for (int it = vblock(); it < n_qkv; it += gridDim.x) qkv_item(p, l, it, smem);
    for (int it = rot; it < n_cp; it += gridDim.x) convpool_item(p, l, it, smem);
    for (int it = blockIdx.x; it < n_s5; it += gridDim.x) s5_item<false>(p, l, it, smem);
#if MISC_DUP == 1
    for (int it = vblock(); it < n_qkv; it += gridDim.x) qkv_item(p, l, it, smem);
#elif MISC_DUP == 2
    for (int it = rot; it < n_cp; it += gridDim.x) convpool_item(p, l, it, smem);
#elif MISC_DUP == 3
    for (int it = blockIdx.x; it < n_s5; it += gridDim.x) s5_item<false>(p, l, it, smem);
#endif
}
PH_FN void attn_phase(const KP& p, int l, char* smem) {
    const int n_att = l == 1 ? 1024 : 1024 + 16;
    if (blockIdx.x < 16) s5_carry(p, l, blockIdx.x);
    for (int it = vblock(); it < n_att; it += gridDim.x) attn_item(p, it, smem);
}
PH_FN void s5fin_phase(const KP& p, int l, char* smem) {
    for (int it = blockIdx.x; it < 2 * NCHUNK * 4; it += gridDim.x) s5_item<true>(p, l, it, smem);
}

DI void run_phase(const KP& p, int ph, char* smem) {
    if (ph == 0) { prep_phase(p, smem); return; }
    if (ph == 27) {
        rowop_phase(p, 1, 8, 0.5f, p.in[7] + (1 * 3 + 2) * D, true, 0, 0, nullptr, false, false, NL);
        return;
    }
    const int l = (ph - 1) / 13, s = (ph - 1) % 13;
    const bf16_t* Wl = (const bf16_t*)(p.ws + OFF_W) + (size_t)l * WL_EL;
    const float* npre = p.in[6] + (size_t)l * 3 * D;
    const float* npost = p.in[7] + (size_t)l * 3 * D;
    const bool lastl = l == 1;
    switch (s) {
    case 0:
        if (l == 0) rowop_phase(p, 0, 0, 0.f, nullptr, false, 0, 0, npre, true, true);
        else rowop_phase(p, l - 1, 8, 0.5f, p.in[7] + ((l - 1) * 3 + 2) * D, true, l, 0, npre, true, false);
        break;
    case 1: case 11: gemm1_phase(p, l, s == 11, smem, (lastl && s == 11) ? NL / 256 : NT / 256); break;
    case 2: case 9: case 12: {
        const bool isout = s == 9;
        const bf16_t* Ag = (const bf16_t*)(p.ws + (isout ? OFF_MIX : OFF_ACT));
        const bf16_t* Wg = Wl + (isout ? WO_OUT : (s == 12 ? WO_D1 : WO_D0));
        const int Kg = isout ? DMIX : FF;
        gemm_store_phase256<D>(Ag, Kg, Wg, Kg, 8, (bf16_t*)(p.ws + OFF_HY), smem, NL / 256, (lastl && s != 2) ? 0 : NC / 128);
    } break;
    case 3: rowop_phase(p, l, 2, 0.5f, npost, true, l, 3, npre + D, true, l == 0); break;
    case 4: gemm_store_phase256<DIN>((const bf16_t*)(p.ws + OFF_HY), D, Wl + WO_IN, D, 12, (bf16_t*)(p.ws + OFF_Z), smem, NL / 256, NC / 128); break;
    case 5: misc_phase(p, l, smem); break;
    case 6: attn_phase(p, l, smem); break;
    case 7: s5fin_phase(p, l, smem); break;
    case 8: glu_phase(p, l, smem); break;
    case 10: rowop_phase(p, l, 5, 1.0f, npost + D, true, l, 6, npre + 2 * D, true, false, lastl ? NL : NT); break;
    }
}

constexpr int N_PHASES = 28;

__global__ void __launch_bounds__(256, 2) mega_kernel(KP p, int ph_lo, int ph_hi) {
    __shared__ __attribute__((aligned(16))) char smem[65536];
    __shared__ KP s_kp;
    if (TIDX() < 33) s_kp.in[TIDX()] = p.in[TIDX()];
    if (TIDX() == 33) s_kp.out = p.out;
    if (TIDX() == 34) s_kp.ws = p.ws;
    __shared__ uint4 xb_words;
    if (TIDX() == 0) xb_words = make_uint4(0u, 0u, 0u, 0u);
    __syncthreads();
    XcdBarrier xb = xcd_barrier_post((unsigned*)(p.ws + OFF_BAR), (volatile LAS unsigned*)&xb_words);
    for (int ph = ph_lo; ph < ph_hi; ++ph) {
        run_phase(p, ph, smem);
        if (DUP_MASK) {
            const int sbit = ph == 0 ? 13 : (ph == 27 ? 14 : (ph - 1) % 13);
            if ((DUP_MASK >> sbit) & 1) { xcd_barrier(xb); run_phase(p, ph, smem); }
        }
#if PROBE_MODE
        {
            const int sb = ph == 0 || ph == 27 ? -1 : (ph - 1) % 13, pl = (ph - 1) / 13;
            const bf16_t* Wl = (const bf16_t*)(s_kp.ws + OFF_W) + (size_t)pl * WL_EL;
            if (sb == 1 || sb == 11) { cg::this_grid().sync(); gemm1_phase<PROBE_MODE>(s_kp, pl, sb == 11, smem); }
            if (sb == 2 || sb == 12) { cg::this_grid().sync(); gemm_store_phase<PROBE_MODE>((const bf16_t*)(s_kp.ws + OFF_ACT), FF, Wl + (sb == 12 ? WO_D1 : WO_D0), FF, 8, (bf16_t*)(s_kp.ws + OFF_HY), D, D, smem); }
        }
#endif
        if (EXTRA_SYNCS) { xcd_barrier(xb); xcd_barrier(xb); }
        if (ph + 1 < ph_hi) { if (ph_hi < 0) cg::this_grid().sync(); else xcd_barrier(xb); }
    }
}

extern "C" void kernel_launch(void* const* d_in, const int* in_sizes, int n_in, void* d_out, int out_size, void* d_ws, size_t ws_size, hipStream_t stream) {
    static int grid = 0;
    if (grid == 0) {
        if (n_in != 33 || ws_size < WS_END) { fprintf(stderr, "kernel_launch: unexpected n_in %d or ws_size %zu < %zu\n", n_in, ws_size, (size_t)WS_END); grid = -1; return; }
        int dev = 0, cus = 0, per_cu = 0;
        hipGetDevice(&dev);
        hipDeviceGetAttribute(&cus, hipDeviceAttributeMultiprocessorCount, dev);
        hipOccupancyMaxActiveBlocksPerMultiprocessor(&per_cu, (const void*)mega_kernel, 256, 0);
        if (per_cu < 1) per_cu = 1;
        if (per_cu > 2) per_cu = 2;
        grid = cus * per_cu;
    }
    if (grid < 0) return;
    KP p{};
    for (int i = 0; i < 33; ++i) p.in[i] = (const float*)d_in[i];
    p.out = (float*)d_out; p.ws = (char*)d_ws;
    if (hipMemsetAsync((char*)d_ws + OFF_BAR, 0, 3456 * 4, stream) != hipSuccess) { fprintf(stderr, "kernel_launch: memset of barrier words failed\n"); return; }
#if ONE_LAUNCH
    int lo = 0, hi = N_PHASES;
    void* args[] = {&p, &lo, &hi};
    hipError_t e = hipLaunchCooperativeKernel((const void*)mega_kernel, dim3(grid), dim3(256), args, 0, stream);
    if (e != hipSuccess) fprintf(stderr, "cooperative launch failed: %s (grid %d)\n", hipGetErrorString(e), grid);
#else
    for (int ph = 0; ph < N_PHASES; ++ph) hipLaunchKernelGGL(mega_kernel, dim3(grid), dim3(256), 0, stream, p, ph, ph + 1);
#endif
}
```

```cpp
#include <hip/hip_runtime.h>
#include <hip/hip_cooperative_groups.h>
#include <cstdio>
#include <cstdint>
namespace cg = cooperative_groups;

#ifndef ONE_LAUNCH
#define ONE_LAUNCH 1
#endif
#define PROBE_MODE 0
#define EXTRA_SYNCS 0
#define MISC_DUP 0
#define ATT_PROBE 0
#define DUP_MASK 0

#define DI __device__ __forceinline__
#define PH_FN __device__ __forceinline__
typedef unsigned short bf16_t;
using bf16x8 = __attribute__((ext_vector_type(8))) short;
using f32x16 = __attribute__((ext_vector_type(16))) float;
using f32x4 = __attribute__((ext_vector_type(4))) float;
typedef unsigned u32x4 __attribute__((ext_vector_type(4)));
typedef __bf16 bf16x2_t __attribute__((ext_vector_type(2)));
typedef float f2_t __attribute__((ext_vector_type(2)));
typedef float f4_t __attribute__((ext_vector_type(4)));
typedef unsigned u2_t __attribute__((ext_vector_type(2)));

constexpr int D = 1024, SEQ = 16384, NB = 2, CTXL = 256;
constexpr int NL = NB * SEQ, NC = NB * CTXL, NT = NL + NC;
constexpr int FF = 2816, DIN = 1440, DMIX = 1280;
constexpr int NH = 8, DK = 96, LK = SEQ + CTXL;
constexpr int IN_CONV = 256, IN_POOL = 768, IN_CQ = 1024, IN_CKV = 1280, IN_KR = 1408;
constexpr int NCHUNK = LK / 64;
constexpr float EPS = 1e-6f;
constexpr float QSCALE = 0.10206207261596575f * 1.4426950408889634f;

constexpr size_t EL_GU = 5632ull * 1024, EL_D = 1024ull * 2816, EL_IN = 1536ull * 1024, EL_OUT = 1024ull * 1280,
                 EL_UQ = 768ull * 256, EL_UKV = 1024ull * 128, EL_GLU = 256ull * 256;
constexpr size_t WO_GU0 = 0, WO_GU1 = EL_GU, WO_D0 = 2 * EL_GU, WO_D1 = WO_D0 + EL_D, WO_IN = WO_D1 + EL_D,
                 WO_OUT = WO_IN + EL_IN, WO_UQ = WO_OUT + EL_OUT, WO_UKV = WO_UQ + EL_UQ, WO_GLU = WO_UKV + EL_UKV,
                 WL_EL = WO_GLU + EL_GLU;
constexpr size_t al256(size_t x) { return (x + 255) & ~(size_t)255; }
constexpr size_t OFF_W = 0;
constexpr size_t OFF_MOD = al256(OFF_W + 2 * WL_EL * 2);
constexpr size_t OFF_ROPE = al256(OFF_MOD + 2ull * 3 * 9216 * 4);
constexpr size_t OFF_LAMB = al256(OFF_ROPE + 256ull * 8 * 2 * 4);
constexpr size_t OFF_BBAR = al256(OFF_LAMB + 2ull * 2048 * 16);
constexpr size_t OFF_CC = al256(OFF_BBAR + 2ull * 2048 * 32 * 4);
constexpr size_t OFF_XC = al256(OFF_CC + 2ull * 32 * 2048 * 2);
constexpr size_t OFF_HY = al256(OFF_XC + (size_t)NC * D * 4);
constexpr size_t OFF_BIG = al256(OFF_HY + (size_t)NT * D * 2);
constexpr size_t OFF_ACT = OFF_BIG;
constexpr size_t OFF_Z = OFF_BIG;
constexpr size_t OFF_Q = al256(OFF_Z + (size_t)NT * DIN * 2);
constexpr size_t OFF_K = al256(OFF_Q + (size_t)NT * 768 * 2);
constexpr size_t OFF_VT = al256(OFF_K + (size_t)NB * NH * LK * 96 * 2);
constexpr size_t OFF_MIX = al256(OFF_VT + (size_t)NB * NH * 64 * LK * 2);
constexpr size_t OFF_S5P = al256(OFF_MIX + (size_t)NT * DMIX * 2);
constexpr size_t OFF_E = al256(OFF_S5P + (size_t)NT * 256 * 2);
constexpr size_t OFF_S = al256(OFF_E + 2ull * 2 * NCHUNK * 1024 * 8);
constexpr size_t OFF_BAR = al256(OFF_S + 2ull * 2 * NCHUNK * 1024 * 8);
constexpr size_t WS_END = al256(OFF_BAR + 3456 * 4);
static_assert(OFF_ACT + (size_t)NT * FF * 2 <= WS_END, "act fits");

struct KP { const float* in[33]; float* out; char* ws; };

DI int TIDX() { int t = threadIdx.x; asm volatile("" : "+v"(t)); return t; }
DI float bf2f(bf16_t b) { return __uint_as_float((unsigned)b << 16); }
DI unsigned pack2(float a, float b) { f2_t v = {a, b}; bf16x2_t r = __builtin_convertvector(v, bf16x2_t); return __builtin_bit_cast(unsigned, r); }
DI bf16_t f2bf(float a) { return (bf16_t)(pack2(a, 0.f) & 0xffffu); }
DI float fast_exp(float x) { return __builtin_amdgcn_exp2f(x * 1.4426950408889634f); }
DI float sigmoidf_(float x) { return __builtin_amdgcn_rcpf(1.f + fast_exp(-x)); }
DI float siluf_(float x) { return x * sigmoidf_(x); }
DI float gelu_tanh(float x) { float u = 0.7978845608028654f * (x + 0.044715f * x * x * x); float t = 1.f - 2.f * __builtin_amdgcn_rcpf(1.f + fast_exp(2.f * u)); return 0.5f * x * (1.f + t); }
DI float shflx(float v, int m) { const int idx = ((TIDX() & 63) ^ m) << 2; return __int_as_float(__builtin_amdgcn_ds_bpermute(idx, __float_as_int(v))); }
DI float xhalf_max(float v) { const auto r = __builtin_amdgcn_permlane32_swap(__float_as_uint(v), __float_as_uint(v), false, false); return fmaxf(__uint_as_float(r[0]), __uint_as_float(r[1])); }
DI float xhalf_sum(float v) { const auto r = __builtin_amdgcn_permlane32_swap(__float_as_uint(v), __float_as_uint(v), false, false); return __uint_as_float(r[0]) + __uint_as_float(r[1]); }
DI float wave_sum(float v) { for (int m = 32; m >= 1; m >>= 1) v += shflx(v, m); return v; }
DI int crow(int i, int hh) { return (i & 3) + 8 * (i >> 2) + 4 * hh; }
DI int row_mod(int row) { return row < NL ? (row >= SEQ ? 1 : 0) : 2; }
DI int vblock() { const int G = gridDim.x, b = blockIdx.x; return (G & 7) ? b : (G >> 3) * (b & 7) + (b >> 3); }
DI void tile_mn(int it, int TM, int TN, int& mt, int& nt) {
    const int band = it / (8 * TN), within = it - band * 8 * TN;
    const int gm = min(8, TM - 8 * band);
    nt = within / gm; mt = 8 * band + (within - nt * gm);
}
DI void gld16(u32x4& r, const void* p) { asm volatile("global_load_dwordx4 %0, %1, off" : "=&v"(r) : "v"(p) : "memory"); }
DI void vm_wait8(u32x4& a, u32x4& b, u32x4& c, u32x4& d, u32x4& e, u32x4& f, u32x4& g, u32x4& h) {
    asm volatile("s_waitcnt vmcnt(0)" : "+v"(a), "+v"(b), "+v"(c), "+v"(d), "+v"(e), "+v"(f), "+v"(g), "+v"(h) : : "memory"); }
DI void vm_wait5(u32x4& a, u32x4& b, u32x4& c, u32x4& d, u32x4& e) {
    asm volatile("s_waitcnt vmcnt(0)" : "+v"(a), "+v"(b), "+v"(c), "+v"(d), "+v"(e) : : "memory"); }
#define MFMA32(a, b, c) __builtin_amdgcn_mfma_f32_32x32x16_bf16((a), (b), (c), 0, 0, 0)
#define MFMA16(a, b, c) __builtin_amdgcn_mfma_f32_16x16x32_bf16((a), (b), (c), 0, 0, 0)

#define XB_TMO      128
#define XB_XCNT(j)  (256  + 64 * (j))
#define XB_XSUB(j)  (1280 + 64 * (j))
#define XB_XGEN(j)  (2304 + 64 * (j))
#define XB_TOP      3328
#define XB_TOPGEN   3392
#define XCD_BAR_WORDS 3456
#define XB_SPIN_CAP (1u << 18)
#define LAS __attribute__((address_space(3)))

__device__ __forceinline__ unsigned xb_ld(unsigned* p)              { return __hip_atomic_load(p, __ATOMIC_RELAXED, __HIP_MEMORY_SCOPE_AGENT); }
__device__ __forceinline__ unsigned xb_add(unsigned* p, unsigned v) { return __hip_atomic_fetch_add(p, v, __ATOMIC_RELAXED, __HIP_MEMORY_SCOPE_AGENT); }
__device__ __forceinline__ unsigned xb_xcc_id() { return (unsigned)__builtin_amdgcn_s_getreg((3 << 11) | 20) & 0xFu; }
#define XB_SPIN(cond, bar) do { unsigned _sp = 0; while (cond) { __builtin_amdgcn_s_sleep(1); \
    if ((++_sp & 255u) == 0u) { if (xb_ld(&(bar)[XB_TMO])) break; if (_sp > XB_SPIN_CAP) { atomicAdd(&(bar)[XB_TMO], 1u); break; } } } } while (0)

struct XcdBarrier {
    unsigned* bar; unsigned x;
    volatile LAS unsigned* st;
};

__device__ __forceinline__ XcdBarrier xcd_barrier_post(unsigned* bar, volatile LAS unsigned* st) {
    XcdBarrier b; b.bar = bar; b.x = xb_xcc_id(); b.st = st;
    if (TIDX() == 0) (void)xb_add(&bar[XB_XCNT(b.x)], 1u);
    return b;
}
__device__ __forceinline__ void xcd_barrier_complete(unsigned* bar, unsigned x, unsigned& nloc, unsigned& nx) {
    const unsigned G = gridDim.x * gridDim.y * gridDim.z;
    unsigned sum, cnt, mine, sp = 0u;
    for (;;) {
        sum = 0u; cnt = 0u; mine = 0u;
#pragma unroll
        for (unsigned j = 0; j < 16; ++j) { const unsigned c = xb_ld(&bar[XB_XCNT(j)]); sum += c; cnt += (c > 0u) ? 1u : 0u; mine = (j == x) ? c : mine; }
        if (sum == G) break;
        __builtin_amdgcn_s_sleep(1);
        if ((++sp & 255u) == 0u) { if (xb_ld(&bar[XB_TMO])) break; if (sp > XB_SPIN_CAP) { atomicAdd(&bar[XB_TMO], 1u); break; } }
    }
    nloc = mine > 0u ? mine : 1u; nx = cnt > 0u ? cnt : 1u;
}

__device__ __forceinline__ void xcd_barrier(const XcdBarrier& b) {
    asm volatile("s_waitcnt vmcnt(0)" ::: "memory");
    __syncthreads();
    if (TIDX() == 0) {
        unsigned* bar = b.bar;
        __builtin_amdgcn_s_waitcnt(0);
        unsigned nloc = b.st[0], nx = b.st[1];
        if (nloc == 0u) { xcd_barrier_complete(bar, b.x, nloc, nx); b.st[0] = nloc; b.st[1] = nx; }
        const unsigned old = xb_add(&bar[XB_XSUB(b.x)], 1u);
        const unsigned gen = old / nloc;
        if (old + 1u == (gen + 1u) * nloc) {
            __builtin_amdgcn_fence(__ATOMIC_RELEASE, "agent");
            asm volatile("s_waitcnt vmcnt(0)" ::: "memory");
            const unsigned og = xb_add(&bar[XB_TOP], 1u);
            const unsigned tg = og / nx;
            if (og + 1u == (tg + 1u) * nx) xb_add(&bar[XB_TOPGEN], 1u);
            else XB_SPIN(xb_ld(&bar[XB_TOPGEN]) == tg, bar);
            __builtin_amdgcn_fence(__ATOMIC_ACQUIRE, "agent");
            xb_add(&bar[XB_XGEN(b.x)], 1u);
            asm volatile("s_waitcnt vmcnt(0)" ::: "memory");
        } else {
            XB_SPIN(xb_ld(&bar[XB_XGEN(b.x)]) == gen, bar);
            __builtin_amdgcn_fence(__ATOMIC_ACQUIRE, "agent");
            asm volatile("s_waitcnt vmcnt(0)" ::: "memory");
        }
    }
    __syncthreads();
}


DI void vm_wait_sel(u32x4& a, u32x4& b, u32x4& c, u32x4& d, u32x4& e, u32x4& f, u32x4& g, u32x4& h, int all) {
    asm volatile("s_cmp_lg_u32 %8, 0\n\ts_cbranch_scc1 1f\n\ts_waitcnt vmcnt(8)\n\ts_branch 2f\n1:\n\ts_waitcnt vmcnt(0)\n2:"
                 : "+v"(a), "+v"(b), "+v"(c), "+v"(d), "+v"(e), "+v"(f), "+v"(g), "+v"(h) : "s"(all) : "memory", "scc"); }

template <int MODE = 0, class Epi>
DI void gemm_tile(const bf16_t* __restrict__ A, int lda, const bf16_t* __restrict__ Bt, int ldb, int K, int row0, int col0, char* smem, Epi&& epi) {
    bf16_t* sA = (bf16_t*)smem;
    bf16_t* sB = sA + 2 * 8192;
    const int tid = TIDX(), lane = tid & 63, wave = tid >> 6;
    const int wm = wave >> 1, wn = wave & 1, l31 = lane & 31, hh = lane >> 5;
    u32x4 r0a[4], r0b[4], r1a[4], r1b[4];
    const bf16_t* Ap = A + (size_t)(row0 + (tid >> 3)) * lda + (tid & 7) * 8;
    const bf16_t* Bp = Bt + (size_t)(col0 + (tid >> 3)) * ldb + (tid & 7) * 8;
    const int wr_off = (tid >> 3) * 64 + (((tid & 7) ^ ((tid >> 4) & 7)) * 8);
    f32x16 acc[2][2];
#pragma unroll
    for (int a = 0; a < 2; ++a)
#pragma unroll
        for (int b = 0; b < 2; ++b)
#pragma unroll
            for (int i = 0; i < 16; ++i) acc[a][b][i] = 0.f;
    const int nk = K >> 6;
#pragma unroll
    for (int i = 0; i < 4; ++i) { r0a[i] = *(const u32x4*)(Ap + (size_t)i * 32 * lda); r0b[i] = *(const u32x4*)(Bp + (size_t)i * 32 * ldb); }
#pragma unroll
    for (int i = 0; i < 4; ++i) { *(u32x4*)(sA + wr_off + i * 2048) = r0a[i]; *(u32x4*)(sB + wr_off + i * 2048) = r0b[i]; }
#pragma unroll
    for (int i = 0; i < 4; ++i) { gld16(r1a[i], Ap + (size_t)i * 32 * lda + 64); gld16(r1b[i], Bp + (size_t)i * 32 * ldb + 64); }
    __syncthreads();
    const int sw = (l31 >> 1) & 7;
    const bf16_t* cA = sA + (wm * 64 + l31) * 64;
    const bf16_t* cB = sB + (wn * 64 + l31) * 64;
#define GEMM_LDFRAG(buf_, ks_, a0_, a1_, b0_, b1_) do { const int ch = ((2 * (ks_) + hh) ^ sw) * 8; \
            a0_ = *(const bf16x8*)(cA + (buf_) * 8192 + ch); a1_ = *(const bf16x8*)(cA + (buf_) * 8192 + 32 * 64 + ch); \
            b0_ = *(const bf16x8*)(cB + (buf_) * 8192 + ch); b1_ = *(const bf16x8*)(cB + (buf_) * 8192 + 32 * 64 + ch); } while (0)
#define GEMM_MMA(a0_, a1_, b0_, b1_) do { acc[0][0] = MFMA32(a0_, b0_, acc[0][0]); acc[0][1] = MFMA32(a0_, b1_, acc[0][1]); \
            acc[1][0] = MFMA32(a1_, b0_, acc[1][0]); acc[1][1] = MFMA32(a1_, b1_, acc[1][1]); } while (0)
#define SB_ __builtin_amdgcn_sched_barrier(0)
#define GEMM_COMPUTE(buf_) do { bf16x8 pa0, pa1, pb0, pb1, qa0, qa1, qb0, qb1; \
            GEMM_LDFRAG(buf_, 0, pa0, pa1, pb0, pb1); GEMM_LDFRAG(buf_, 1, qa0, qa1, qb0, qb1); SB_; GEMM_MMA(pa0, pa1, pb0, pb1); SB_; \
            GEMM_LDFRAG(buf_, 2, pa0, pa1, pb0, pb1); SB_; GEMM_MMA(qa0, qa1, qb0, qb1); SB_; \
            GEMM_LDFRAG(buf_, 3, qa0, qa1, qb0, qb1); SB_; GEMM_MMA(pa0, pa1, pb0, pb1); SB_; GEMM_MMA(qa0, qa1, qb0, qb1); SB_; } while (0)
    for (int kt = 0; kt < nk; kt += 2) {
        const bool m2 = (kt + 2) < nk, m3 = (kt + 3) < nk;
        if (m2 && MODE == 0) {
            const int k0 = (kt + 2) << 6;
#pragma unroll
            for (int i = 0; i < 4; ++i) { gld16(r0a[i], Ap + (size_t)i * 32 * lda + k0); gld16(r0b[i], Bp + (size_t)i * 32 * ldb + k0); }
        }
        GEMM_COMPUTE(0);
        vm_wait_sel(r1a[0], r1a[1], r1a[2], r1a[3], r1b[0], r1b[1], r1b[2], r1b[3], __builtin_amdgcn_readfirstlane((m2 && MODE == 0) ? 0 : 1));
        if (MODE < 2)
#pragma unroll
        for (int i = 0; i < 4; ++i) { *(u32x4*)(sA + 8192 + wr_off + i * 2048) = r1a[i]; *(u32x4*)(sB + 8192 + wr_off + i * 2048) = r1b[i]; }
        __syncthreads();
        if (m3 && MODE == 0) {
            const int k0 = (kt + 3) << 6;
#pragma unroll
            for (int i = 0; i < 4; ++i) { gld16(r1a[i], Ap + (size_t)i * 32 * lda + k0); gld16(r1b[i], Bp + (size_t)i * 32 * ldb + k0); }
        }
        GEMM_COMPUTE(1);
        if (m2) {
            vm_wait_sel(r0a[0], r0a[1], r0a[2], r0a[3], r0b[0], r0b[1], r0b[2], r0b[3], __builtin_amdgcn_readfirstlane((m3 && MODE == 0) ? 0 : 1));
            if (MODE < 2)
#pragma unroll
            for (int i = 0; i < 4; ++i) { *(u32x4*)(sA + wr_off + i * 2048) = r0a[i]; *(u32x4*)(sB + wr_off + i * 2048) = r0b[i]; }
        }
        __syncthreads();
    }
#undef GEMM_COMPUTE
#undef GEMM_LDFRAG
#undef GEMM_MMA
    epi(acc, row0 + wm * 64, col0 + wn * 64);
}

DI const bf16_t* uni_ptr(const bf16_t* p) {
    const unsigned long long v = (unsigned long long)p;
    const unsigned lo = __builtin_amdgcn_readfirstlane((unsigned)v), hi = __builtin_amdgcn_readfirstlane((unsigned)(v >> 32));
    return (const bf16_t*)(((unsigned long long)hi << 32) | lo); }
DI void gld16s(u32x4& r, unsigned voff, const void* sbase) { asm volatile("global_load_dwordx4 %0, %1, %2" : "=&v"(r) : "v"(voff), "s"(sbase) : "memory"); }
DI void vm_wait12(u32x4& a, u32x4& b, u32x4& c, u32x4& d, u32x4& e, u32x4& f, u32x4& g, u32x4& h, u32x4& i, u32x4& j, u32x4& k, u32x4& l) {
    asm volatile("s_waitcnt vmcnt(0)" : "+v"(a), "+v"(b), "+v"(c), "+v"(d), "+v"(e), "+v"(f), "+v"(g), "+v"(h), "+v"(i), "+v"(j), "+v"(k), "+v"(l) : : "memory"); }

template <class Epi>
DI void gemm_tile256(const bf16_t* __restrict__ A, int lda, const bf16_t* __restrict__ Bt, int ldb, int K, int row0, int col0, char* smem, Epi&& epi) {
    bf16_t* sA = (bf16_t*)smem;
    bf16_t* sB = sA + 256 * 64;
    const int tid = TIDX(), lane = tid & 63, wave = tid >> 6;
    const int wm = wave >> 1, wn = wave & 1, l31 = lane & 31, hh = lane >> 5;
    u32x4 ra[8], rb[4];
    const bf16_t* Ab = uni_ptr(A + (size_t)row0 * lda);
    const bf16_t* Bb = uni_ptr(Bt + (size_t)col0 * ldb);
    const unsigned voa = ((unsigned)(tid >> 3) * (unsigned)lda + (tid & 7) * 8) * 2u;
    const unsigned vob = ((unsigned)(tid >> 3) * (unsigned)ldb + (tid & 7) * 8) * 2u;
    const int wr_off = (tid >> 3) * 64 + (((tid & 7) ^ ((tid >> 4) & 7)) * 8);
    f32x16 acc[4][2];
#pragma unroll
    for (int a = 0; a < 4; ++a)
#pragma unroll
        for (int b = 0; b < 2; ++b)
#pragma unroll
            for (int i = 0; i < 16; ++i) acc[a][b][i] = 0.f;
    const int nk = K >> 6;
#pragma unroll
    for (int i = 0; i < 8; ++i) gld16s(ra[i], voa, Ab + (size_t)i * 32 * lda);
#pragma unroll
    for (int i = 0; i < 4; ++i) gld16s(rb[i], vob, Bb + (size_t)i * 32 * ldb);
    const int sw = (l31 >> 1) & 7;
    const bf16_t* cA = sA + (wm * 128 + l31) * 64;
    const bf16_t* cB = sB + (wn * 64 + l31) * 64;
    for (int kt = 0; kt < nk; ++kt) {
        vm_wait12(ra[0], ra[1], ra[2], ra[3], ra[4], ra[5], ra[6], ra[7], rb[0], rb[1], rb[2], rb[3]);
#pragma unroll
        for (int i = 0; i < 8; ++i) *(u32x4*)(sA + wr_off + i * 2048) = ra[i];
#pragma unroll
        for (int i = 0; i < 4; ++i) *(u32x4*)(sB + wr_off + i * 2048) = rb[i];
        __syncthreads();
        if (kt + 1 < nk) {
            const int k0 = (kt + 1) << 6;
#pragma unroll
            for (int i = 0; i < 8; ++i) gld16s(ra[i], voa, Ab + (size_t)i * 32 * lda + k0);
#pragma unroll
            for (int i = 0; i < 4; ++i) gld16s(rb[i], vob, Bb + (size_t)i * 32 * ldb + k0);
        }
        __builtin_amdgcn_s_setprio(1);
#pragma unroll
        for (int ks = 0; ks < 4; ++ks) {
            const int ch = ((2 * ks + hh) ^ sw) * 8;
            const bf16x8 b0 = *(const bf16x8*)(cB + ch), b1 = *(const bf16x8*)(cB + 32 * 64 + ch);
#pragma unroll
            for (int mi = 0; mi < 4; ++mi) {
                const bf16x8 a = *(const bf16x8*)(cA + mi * 32 * 64 + ch);
                acc[mi][0] = MFMA32(a, b0, acc[mi][0]);
                acc[mi][1] = MFMA32(a, b1, acc[mi][1]);
            }
        }
        __builtin_amdgcn_s_setprio(0);
        __syncthreads();
    }
    epi(acc, row0 + wm * 128, col0 + wn * 64);
}

DI void transpose_store(bf16_t* dst, int K, int n0, int k0, const float* tile) {
    const int kp = TIDX() & 31, nn = TIDX() >> 5;
#pragma unroll
    for (int i = 0; i < 8; ++i) {
        const int n = nn + 8 * i;
        *(unsigned*)(dst + (size_t)(n0 + n) * K + k0 + 2 * kp) = pack2(tile[(2 * kp) * 65 + n], tile[(2 * kp + 1) * 65 + n]);
    }
}
template <class F>
DI void transpose_tile(bf16_t* dst, int K, int tn, int tk, F src, float* tile) {
    const int tx = TIDX() & 63, ty = TIDX() >> 6;
    const int n0 = tn * 64, k0 = tk * 64;
    float v[16];
#pragma unroll
    for (int i = 0; i < 16; ++i) v[i] = src(k0 + ty + 4 * i, n0 + tx);
#pragma unroll
    for (int i = 0; i < 16; ++i) tile[(ty + 4 * i) * 65 + tx] = v[i];
    __syncthreads();
    transpose_store(dst, K, n0, k0, tile);
    __syncthreads();
}
DI void poolfold_tile(bf16_t* dst, int tn, int tk, const float* wi, const float* pw, const float* ps, float* smemf) {
    float* wt = smemf;
    float* pt = smemf + 64 * 65;
    float* ot = pt + 64 * 64;
    const int tx = TIDX() & 63, ty = TIDX() >> 6;
    const int n0 = tn * 64, k0 = tk * 64, g = (n0 - IN_POOL) >> 6;
    const float sc = ps[g * 64 + tx];
#pragma unroll
    for (int i = 0; i < 16; ++i) {
        const int r = ty + 4 * i;
        wt[r * 65 + tx] = wi[(size_t)(k0 + r) * DIN + IN_POOL + g * 64 + tx];
        pt[r * 64 + tx] = pw[g * 4096 + r * 64 + tx] * sc;
    }
    __syncthreads();
    float acc[16];
#pragma unroll
    for (int i = 0; i < 16; ++i) acc[i] = 0.f;
    for (int ii = 0; ii < 64; ++ii) {
        const float pv = pt[ii * 64 + tx];
#pragma unroll
        for (int i = 0; i < 16; ++i) acc[i] += wt[(ty + 4 * i) * 65 + ii] * pv;
    }
#pragma unroll
    for (int i = 0; i < 16; ++i) ot[(ty + 4 * i) * 65 + tx] = acc[i];
    __syncthreads();
    transpose_store(dst, 1024, n0, k0, ot);
    __syncthreads();
}

PH_FN void prep_phase(const KP& p, char* smem) {
    float* tile = (float*)smem;
    bf16_t* W = (bf16_t*)(p.ws + OFF_W);
    const int NTR = 5024;
    const int n_items = 2 * NTR + 288 + 1 + 16;
    for (int it = blockIdx.x; it < n_items; it += gridDim.x) {
        if (it < 2 * NTR) {
            const int l = it / NTR; int r = it % NTR;
            bf16_t* Wl = W + (size_t)l * WL_EL;
            if (r < 2816) {
                const int f = r / 1408; r %= 1408;
                const float* g = p.in[8] + (size_t)(l * 2 + f) * D * FF;
                const float* u = p.in[9] + (size_t)(l * 2 + f) * D * FF;
                transpose_tile(Wl + (f ? WO_GU1 : WO_GU0), 1024, r / 16, r % 16, [&](int k, int n) {
                    const int j = n >> 7, w = n & 127, c = j * 64 + (w >> 6) * 32 + (w & 31);
                    return ((w >> 5) & 1) ? u[(size_t)k * FF + c] : g[(size_t)k * FF + c]; }, tile);
            } else if (r < 2816 + 1408) {
                r -= 2816; const int f = r / 704; r %= 704;
                const float* dn = p.in[10] + (size_t)(l * 2 + f) * FF * D;
                transpose_tile(Wl + (f ? WO_D1 : WO_D0), 2816, r / 44, r % 44, [&](int k, int n) { return dn[(size_t)k * D + n]; }, tile);
            } else if (r < 4224 + 384) {
                r -= 4224;
                const float* wi = p.in[11] + (size_t)l * D * DIN;
                const float* pw = p.in[27] + (size_t)l * 4 * 64 * 64;
                const float* ps = p.in[28] + (size_t)l * 256;
                const int tn = r / 16, tk = r % 16;
                if (tn >= IN_POOL / 64 && tn < IN_CQ / 64) poolfold_tile(Wl + WO_IN, tn, tk, wi, pw, ps, tile);
                else transpose_tile(Wl + WO_IN, 1024, tn, tk, [&](int k, int n) { return n < DIN ? wi[(size_t)k * DIN + n] : 0.f; }, tile);
            } else if (r < 4608 + 320) {
                r -= 4608;
                const float* wo = p.in[12] + (size_t)l * DMIX * D;
                transpose_tile(Wl + WO_OUT, 1280, r / 20, r % 20, [&](int k, int n) { return wo[(size_t)k * D + n]; }, tile);
            } else if (r < 4928 + 48) {
                r -= 4928;
                const float* wq = p.in[30] + (size_t)l * 256 * 768;
                const float* gn = p.in[29] + (size_t)l * 256;
                transpose_tile(Wl + WO_UQ, 256, r / 4, r % 4, [&](int k, int n) { return wq[(size_t)k * 768 + n] * gn[k] * QSCALE; }, tile);
            } else if (r < 4976 + 32) {
                r -= 4976;
                const float* wk = p.in[32] + (size_t)l * 128 * 1024;
                const float* gn = p.in[31] + (size_t)l * 128;
                transpose_tile(Wl + WO_UKV, 128, r / 2, r % 2, [&](int k, int n) { return wk[(size_t)k * 1024 + n] * gn[k]; }, tile);
            } else {
                r -= 5008;
                const float* wg = p.in[21] + (size_t)l * 256 * 256;
                transpose_tile(Wl + WO_GLU, 256, r / 4, r % 4, [&](int k, int n) { return wg[(size_t)k * 256 + n]; }, tile);
            }
        } else if (it < 2 * NTR + 288) {
            const int r = it - 2 * NTR, l = r / 144, n0 = (r % 144) * 64;
            float* sc = (float*)smem;
            float* red = sc + 3072;
            for (int i = TIDX(); i < 3072; i += 256) {
                const int v = i >> 10, k = i & 1023;
                const float cv = v < 2 ? p.in[1][v * 1024 + k] : p.in[3][k];
                sc[i] = cv / (1.f + expf(-cv));
            }
            __syncthreads();
            const int tx = TIDX() & 63, ty = TIDX() >> 6;
            const float* wa = p.in[4] + (size_t)l * D * 9216 + n0 + tx;
            float a0 = 0.f, a1 = 0.f, a2 = 0.f;
#pragma unroll 32
            for (int k = ty * 256; k < ty * 256 + 256; ++k) {
                const float w = wa[(size_t)k * 9216];
                a0 += sc[k] * w; a1 += sc[1024 + k] * w; a2 += sc[2048 + k] * w;
            }
            red[(ty * 3 + 0) * 64 + tx] = a0; red[(ty * 3 + 1) * 64 + tx] = a1; red[(ty * 3 + 2) * 64 + tx] = a2;
            __syncthreads();
            if (TIDX() < 192) {
                const int v = TIDX() >> 6;
                float s = p.in[5][l * 9216 + n0 + tx];
                for (int q = 0; q < 4; ++q) s += red[(q * 3 + v) * 64 + tx];
                ((float*)(p.ws + OFF_MOD))[(size_t)(l * 3 + v) * 9216 + n0 + tx] = s;
            }
            __syncthreads();
        } else if (it == 2 * NTR + 288) {
            float* tab = (float*)(p.ws + OFF_ROPE);
            const int pos = TIDX();
            for (int i = 0; i < 8; ++i) {
                const float inv = powf(10000.f, -(float)(2 * i) / 16.f);
                const float ang = (float)pos * inv;
                tab[(pos * 8 + i) * 2 + 0] = cosf(ang);
                tab[(pos * 8 + i) * 2 + 1] = sinf(ang);
            }
        } else {
            const int idx = (it - (2 * NTR + 289)) * 256 + TIDX();
            const int pp = idx & 63, g = (idx >> 6) & 15, ld = idx >> 10;
            float lr = fminf(p.in[13][idx], -1e-4f), li = p.in[14][idx];
            const float dt = expf(p.in[15][ld * 16 + g]);
            const float mag = expf(lr * dt);
            const float br = mag * cosf(li * dt), bi = mag * sinf(li * dt);
            float tr = br, ti = bi;
            for (int q = 0; q < 6; ++q) { const float nr = tr * tr - ti * ti, ni = 2.f * tr * ti; tr = nr; ti = ni; }
            ((float4*)(p.ws + OFF_LAMB))[idx] = make_float4(br, bi, tr, ti);
            const float nr = br - 1.f, ni = bi, den = 1.f / (lr * lr + li * li);
            const float cr = (nr * lr + ni * li) * den, ci = (ni * lr - nr * li) * den;
            float* bb = (float*)(p.ws + OFF_BBAR) + (size_t)idx * 32;
            const float* sbr = p.in[16] + (size_t)idx * 16; const float* sbi = p.in[17] + (size_t)idx * 16;
            for (int h = 0; h < 16; ++h) { const float xr = sbr[h], xi = sbi[h]; bb[2 * h] = cr * xr - ci * xi; bb[2 * h + 1] = cr * xi + ci * xr; }
            bf16_t* cc = (bf16_t*)(p.ws + OFF_CC) + (size_t)(ld * 16 + g) * 2048;
            const float* scr = p.in[18] + (size_t)(ld * 16 + g) * 1024; const float* sci = p.in[19] + (size_t)(ld * 16 + g) * 1024;
            for (int h = 0; h < 16; ++h) { cc[h * 128 + pp] = f2bf(scr[h * 64 + pp]); cc[h * 128 + 64 + pp] = f2bf(-sci[h * 64 + pp]); }
        }
    }
}

PH_FN void rowop_phase(const KP& p, int l_mod_post, int gate_idx, float coef, const float* gpost, bool has_y,
                    int l_mod_pre, int shift_idx, const float* gpre, bool has_pre, bool first, int nrows = NT) {
    const int lane = TIDX() & 63;
    const int wid = blockIdx.x * 4 + (TIDX() >> 6), nw = gridDim.x * 4;
    bf16_t* HY = (bf16_t*)(p.ws + OFF_HY);
    float* Xc = (float*)(p.ws + OFF_XC);
    const float* MOD = (const float*)(p.ws + OFF_MOD);
    f4_t wpost[4], wpre[4], vg[4], vs0[4], vs1[4];
#pragma unroll
    for (int i = 0; i < 4; ++i) {
        wpost[i] = has_y ? *(const f4_t*)(gpost + lane * 4 + 256 * i) : f4_t{0.f, 0.f, 0.f, 0.f};
        wpre[i] = has_pre ? *(const f4_t*)(gpre + lane * 4 + 256 * i) : f4_t{0.f, 0.f, 0.f, 0.f};
        vg[i] = vs0[i] = vs1[i] = f4_t{0.f, 0.f, 0.f, 0.f};
    }
    int cur_mv = -1;
    for (int row0 = wid; row0 < nrows; row0 += 2 * nw) {
        int rows[2]; bool ok[2];
        rows[0] = row0; ok[0] = true;
        ok[1] = (row0 + nw) < nrows; rows[1] = ok[1] ? row0 + nw : row0;
        float* xp[2]; int mv[2];
        f4_t x[2][4], y[2][4];
        float ssy[2] = {0.f, 0.f};
#pragma unroll
        for (int q = 0; q < 2; ++q) {
            const int row = rows[q];
            mv[q] = row_mod(row);
            xp[q] = row < NL ? p.out + (size_t)row * D : Xc + (size_t)(row - NL) * D;
            const float* xin = first ? (row < NL ? p.in[0] + (size_t)row * D : p.in[2] + (size_t)(row - NL) * D) : xp[q];
#pragma unroll
            for (int i = 0; i < 4; ++i) x[q][i] = __builtin_nontemporal_load((const f4_t*)(xin + lane * 4 + 256 * i));
            if (has_y) {
#pragma unroll
                for (int i = 0; i < 4; ++i) {
                    const u2_t raw = __builtin_nontemporal_load((const u2_t*)(HY + (size_t)row * D + lane * 4 + 256 * i));
                    y[q][i].x = __uint_as_float(raw.x << 16); y[q][i].y = __uint_as_float(raw.x & 0xffff0000u);
                    y[q][i].z = __uint_as_float(raw.y << 16); y[q][i].w = __uint_as_float(raw.y & 0xffff0000u);
                    ssy[q] += y[q][i].x * y[q][i].x + y[q][i].y * y[q][i].y + y[q][i].z * y[q][i].z + y[q][i].w * y[q][i].w;
                }
            }
        }
        if (has_y) {
            for (int m = 32; m >= 1; m >>= 1) { ssy[0] += shflx(ssy[0], m); ssy[1] += shflx(ssy[1], m); }
        }
        float ssx[2] = {0.f, 0.f};
        f4_t hv[2][4];
#pragma unroll
        for (int qq = 0; qq < 2; ++qq) {
            const int q = 1 - qq;
            if (mv[q] != cur_mv) {
                cur_mv = mv[q];
#pragma unroll
                for (int i = 0; i < 4; ++i) {
                    if (has_y) vg[i] = *(const f4_t*)(MOD + (size_t)(l_mod_post * 3 + cur_mv) * 9216 + gate_idx * 1024 + lane * 4 + 256 * i);
                    if (has_pre) {
                        const float* sh = MOD + (size_t)(l_mod_pre * 3 + cur_mv) * 9216 + shift_idx * 1024 + lane * 4 + 256 * i;
                        vs0[i] = *(const f4_t*)sh; vs1[i] = *(const f4_t*)(sh + 1024);
                    }
                }
            }
            if (has_y) {
                const float rstd = rsqrtf(ssy[q] * (1.f / D) + EPS);
#pragma unroll
                for (int i = 0; i < 4; ++i) x[q][i] += coef * vg[i] * (y[q][i] * rstd * wpost[i]);
                if (ok[q]) {
#pragma unroll
                    for (int i = 0; i < 4; ++i) __builtin_nontemporal_store(x[q][i], (f4_t*)(xp[q] + lane * 4 + 256 * i));
                }
            }
            if (has_pre) {
#pragma unroll
                for (int i = 0; i < 4; ++i) {
                    ssx[q] += x[q][i].x * x[q][i].x + x[q][i].y * x[q][i].y + x[q][i].z * x[q][i].z + x[q][i].w * x[q][i].w;
                    hv[q][i] = x[q][i] * wpre[i] * (1.f + vs1[i]);
                    y[q][i] = vs0[i];
                }
            }
        }
        if (has_pre) {
            for (int m = 32; m >= 1; m >>= 1) { ssx[0] += shflx(ssx[0], m); ssx[1] += shflx(ssx[1], m); }
#pragma unroll
            for (int q = 0; q < 2; ++q) {
                const float rstd = rsqrtf(ssx[q] * (1.f / D) + EPS);
                if (ok[q]) {
#pragma unroll
                    for (int i = 0; i < 4; ++i) {
                        const f4_t h = hv[q][i] * rstd + y[q][i];
                        uint2 o; o.x = pack2(h.x, h.y); o.y = pack2(h.z, h.w);
                        *(uint2*)(HY + (size_t)rows[q] * D + lane * 4 + 256 * i) = o;
                    }
                }
            }
        }
    }
}

template <int MODE = 0>
PH_FN void gemm1_phase(const KP& p, int l, int f, char* smem, int ntm = NT / 256) {
    const bf16_t* H = (const bf16_t*)(p.ws + OFF_HY);
    const bf16_t* W = (const bf16_t*)(p.ws + OFF_W) + (size_t)l * WL_EL + (f ? WO_GU1 : WO_GU0);
    bf16_t* ACT = (bf16_t*)(p.ws + OFF_ACT);
    const int lane = TIDX() & 63, l31 = lane & 31, hh = lane >> 5;
    const int n_items = (NL / 256) * 44;
    const int n_ctx = ntm > NL / 256 ? (NC / 128) * 44 : 0;
    for (int it = vblock(); it < n_ctx; it += gridDim.x) {
        const int mt = it / 44, nt = it - mt * 44;
        gemm_tile(H, D, W, D, D, NL + mt * 128, nt * 128, smem, [&](f32x16 (&acc)[2][2], int r0, int c0) {
            const int col = (c0 >> 7) * 64 + ((c0 >> 6) & 1) * 32 + l31;
#pragma unroll
            for (int mi = 0; mi < 2; ++mi)
#pragma unroll
                for (int i = 0; i < 16; ++i) ACT[(size_t)(r0 + 32 * mi + crow(i, hh)) * FF + col] = f2bf(siluf_(acc[mi][0][i]) * acc[mi][1][i]);
        });
    }
    for (int it = vblock(); it < n_items; it += gridDim.x) {
        int mt, nt; tile_mn(it, NL / 256, 44, mt, nt);
        gemm_tile256(H, D, W, D, D, mt * 256, nt * 128, smem, [&](f32x16 (&acc)[4][2], int r0, int c0) {
            const int col = (c0 >> 7) * 64 + ((c0 >> 6) & 1) * 32 + l31;
#pragma unroll
            for (int mi = 0; mi < 4; ++mi)
#pragma unroll
                for (int i = 0; i < 16; ++i) {
                    const int row = r0 + 32 * mi + crow(i, hh);
                    ACT[(size_t)row * FF + col] = f2bf(siluf_(acc[mi][0][i]) * acc[mi][1][i]);
                }
        });
    }
}

template <int MODE = 0>
PH_FN void gemm_store_phase(const bf16_t* A, int lda, const bf16_t* W, int K, int ntn, bf16_t* C, int ldc, int ncols, char* smem, int ntm = NT / 128) {
    const int lane = TIDX() & 63, l31 = lane & 31, hh = lane >> 5;
    const int n_items = ntm * ntn;
    for (int it = vblock(); it < n_items; it += gridDim.x) {
        int mt, nt; tile_mn(it, ntm, ntn, mt, nt);
        gemm_tile<MODE>(A, lda, W, K, K, mt * 128, nt * 128, smem, [&](f32x16 (&acc)[2][2], int r0, int c0) {
            if (MODE != 0 && acc[0][0][0] != 123456.789f) return;
#pragma unroll
            for (int ni = 0; ni < 2; ++ni) {
                const int col = c0 + 32 * ni + l31;
                if (col < ncols) {
#pragma unroll
                    for (int mi = 0; mi < 2; ++mi)
#pragma unroll
                        for (int i = 0; i < 16; ++i) C[(size_t)(r0 + 32 * mi + crow(i, hh)) * ldc + col] = f2bf(acc[mi][ni][i]);
                }
            }
        });
    }
}

template <int LDC>
PH_FN void gemm_store_phase256(const bf16_t* A, int lda, const bf16_t* W, int K, int ntn, bf16_t* C, char* smem, int ntm, int nctx128) {
    const int lane = TIDX() & 63, l31 = lane & 31, hh = lane >> 5;
    const int n_items = ntm * ntn;
    for (int it = vblock(); it < nctx128 * ntn; it += gridDim.x) {
        const int mt = it / ntn, nt = it - mt * ntn;
        gemm_tile(A, lda, W, K, K, NL + mt * 128, nt * 128, smem, [&](f32x16 (&acc)[2][2], int r0, int c0) {
#pragma unroll
            for (int mi = 0; mi < 2; ++mi) {
                bf16_t* cp = C + (size_t)(r0 + 32 * mi + 4 * hh) * LDC + c0 + l31;
#pragma unroll
                for (int ni = 0; ni < 2; ++ni)
#pragma unroll
                    for (int i = 0; i < 16; ++i) if (LDC == D || c0 + l31 + 32 * ni < LDC) cp[((i & 3) + 8 * (i >> 2)) * LDC + 32 * ni] = f2bf(acc[mi][ni][i]);
            }
        });
    }
    for (int it = vblock(); it < n_items; it += gridDim.x) {
        int mt, nt; tile_mn(it, ntm, ntn, mt, nt);
        gemm_tile256(A, lda, W, K, K, mt * 256, nt * 128, smem, [&](f32x16 (&acc)[4][2], int r0, int c0) {
#pragma unroll
            for (int mi = 0; mi < 4; ++mi) {
                bf16_t* cp = C + (size_t)(r0 + 32 * mi + 4 * hh) * LDC + c0 + l31;
#pragma unroll
                for (int ni = 0; ni < 2; ++ni)
#pragma unroll
                    for (int i = 0; i < 16; ++i) if (LDC == D || c0 + l31 + 32 * ni < LDC) cp[((i & 3) + 8 * (i >> 2)) * LDC + 32 * ni] = f2bf(acc[mi][ni][i]);
                __builtin_amdgcn_sched_barrier(0);
            }
        });
    }
}

PH_FN void glu_phase(const KP& p, int l, char* smem) {
    const bf16_t* S5P = (const bf16_t*)(p.ws + OFF_S5P);
    const bf16_t* W = (const bf16_t*)(p.ws + OFF_W) + (size_t)l * WL_EL + WO_GLU;
    bf16_t* MIX = (bf16_t*)(p.ws + OFF_MIX);
    const float* bg = p.in[22] + l * 256;
    const int lane = TIDX() & 63, l31 = lane & 31, hh = lane >> 5;
    const int n_items = (NT / 128) * 2;
    for (int it = vblock(); it < n_items; it += gridDim.x) {
        const int mt = it >> 1, nt = it & 1;
        gemm_tile(S5P, 256, W, 256, 256, mt * 128, nt * 128, smem, [&](f32x16 (&acc)[2][2], int r0, int c0) {
#pragma unroll
            for (int ni = 0; ni < 2; ++ni) {
                const int col = c0 + 32 * ni + l31;
                const float b = bg[col];
#pragma unroll
                for (int mi = 0; mi < 2; ++mi)
#pragma unroll
                    for (int i = 0; i < 16; ++i) {
                        const int row = r0 + 32 * mi + crow(i, hh);
                        const float y = bf2f(S5P[(size_t)row * 256 + col]);
                        MIX[(size_t)row * DMIX + col] = f2bf(y * sigmoidf_(acc[mi][ni][i] + b));
                        if ((i & 3) == 3) __builtin_amdgcn_sched_barrier(0);
                    }
            }
        });
    }
}

DI void key_pos(int row, int& b, int& pos) {
    if (row < NL) { b = row >= SEQ ? 1 : 0; pos = row - b * SEQ; }
    else { const int r = row - NL; b = r >> 8; pos = SEQ + (r & 255); }
}

DI void qkv_item(const KP& p, int l, int it, char* smem) {
    const bf16_t* Z = (const bf16_t*)(p.ws + OFF_Z);
    const bf16_t* Wl = (const bf16_t*)(p.ws + OFF_W) + (size_t)l * WL_EL;
    bf16_t* Q = (bf16_t*)(p.ws + OFF_Q);
    bf16_t* Kb = (bf16_t*)(p.ws + OFF_K);
    bf16_t* Vt = (bf16_t*)(p.ws + OFF_VT);
    const float* tab = (const float*)(p.ws + OFF_ROPE);
    const int mt = it / 14, sub = it % 14, row0 = mt * 128;
    const int tid = TIDX(), lane = tid & 63, l31 = lane & 31, hh = lane >> 5;
    __shared__ float s_rs[128];
    {
        const int r = tid >> 1, half = tid & 1;
        const bool isq = sub < 6;
        const int n = isq ? 128 : 64;
        const bf16_t* src = Z + (size_t)(row0 + r) * DIN + (isq ? IN_CQ : IN_CKV) + half * n;
        float ss = 0.f;
        auto sq8 = [&](const u32x4& v) {
#pragma unroll
            for (int q = 0; q < 4; ++q) { const float a = __uint_as_float(v[q] << 16), b = __uint_as_float(v[q] & 0xffff0000u); ss += a * a + b * b; }
        };
        if (isq) {
            u32x4 v[16];
#pragma unroll
            for (int i = 0; i < 16; ++i) v[i] = *(const u32x4*)(src + 8 * i);
#pragma unroll
            for (int i = 0; i < 16; ++i) sq8(v[i]);
        } else {
            u32x4 v[8];
#pragma unroll
            for (int i = 0; i < 8; ++i) v[i] = *(const u32x4*)(src + 8 * i);
#pragma unroll
            for (int i = 0; i < 8; ++i) sq8(v[i]);
        }
        ss += shflx(ss, 1);
        if (half == 0) s_rs[r] = rsqrtf(ss / (float)(2 * n) + EPS);
    }
    __syncthreads();
    if (sub < 6) {
        gemm_tile(Z + IN_CQ, DIN, Wl + WO_UQ, 256, 256, row0, sub * 128, smem, [&](f32x16 (&acc)[2][2], int r0, int c0) {
#pragma unroll
            for (int ni = 0; ni < 2; ++ni) {
                const int cb = c0 + 32 * ni, col = cb + l31;
                const bool is_rope = ((cb >> 5) % 3) == 2;
                const int axis = l31 >> 4, second = (l31 >> 3) & 1, fi = l31 & 7;
#pragma unroll
                for (int mi = 0; mi < 2; ++mi)
#pragma unroll
                    for (int i = 0; i < 16; ++i) {
                        const int row = r0 + 32 * mi + crow(i, hh);
                        float v = acc[mi][ni][i] * s_rs[row - row0];
                        if (is_rope) {
                            const float pr = shflx(v, 8);
                            if (row < NL) {
                                const int t = row & (SEQ - 1);
                                const int pos = axis ? (t & 63) : (t >> 6);
                                const float cs = tab[(pos * 8 + fi) * 2], sn = tab[(pos * 8 + fi) * 2 + 1];
                                v = second ? (v * cs + pr * sn) : (v * cs - pr * sn);
                            }
                        }
                        Q[(size_t)row * 768 + col] = f2bf(v);
                        if ((i & 3) == 3) __builtin_amdgcn_sched_barrier(0);
                    }
            }
        });
    } else {
        const int head = sub - 6;
        gemm_tile(Z + IN_CKV, DIN, Wl + WO_UKV, 128, 128, row0, head * 128, smem, [&](f32x16 (&acc)[2][2], int r0, int c0) {
            const bool isv = (c0 >> 6) & 1;
#pragma unroll
            for (int ni = 0; ni < 2; ++ni) {
                const int dcol = 32 * ni + l31;
#pragma unroll
                for (int mi = 0; mi < 2; ++mi)
#pragma unroll
                    for (int q = 0; q < 4; ++q) {
                        const int rowb = r0 + 32 * mi + 8 * q + 4 * hh;
                        int b, pos; key_pos(rowb, b, pos);
                        float v[4];
#pragma unroll
                        for (int j = 0; j < 4; ++j) v[j] = acc[mi][ni][4 * q + j] * s_rs[rowb + j - row0];
                        if (isv) {
                            uint2 o; o.x = pack2(v[0], v[1]); o.y = pack2(v[2], v[3]);
                            *(uint2*)(Vt + ((size_t)(b * NH + head) * 64 + dcol) * LK + ((pos & ~12) | ((pos & 4) << 1) | ((pos & 8) >> 1))) = o;
                        } else {
#pragma unroll
                            for (int j = 0; j < 4; ++j) Kb[((size_t)(b * NH + head) * LK + pos + j) * DK + dcol] = f2bf(v[j]);
                        }
                    }
            }
        });
        for (int e = tid; e < 128 * 32; e += 256) {
            const int r = e >> 5, d = e & 31, row = row0 + r;
            const bf16_t* kr = Z + (size_t)row * DIN + IN_KR;
            float v = bf2f(kr[d]);
            if (row < NL) {
                const float pr = bf2f(kr[d ^ 8]);
                const int t = row & (SEQ - 1), axis = d >> 4, second = (d >> 3) & 1, fi = d & 7;
                const int pos = axis ? (t & 63) : (t >> 6);
                const float cs = tab[(pos * 8 + fi) * 2], sn = tab[(pos * 8 + fi) * 2 + 1];
                v = second ? (v * cs + pr * sn) : (v * cs - pr * sn);
            }
            int b, pos; key_pos(row, b, pos);
            Kb[((size_t)(b * NH + head) * LK + pos) * DK + 64 + d] = f2bf(v);
        }
    }
    __syncthreads();
}

DI void convpool_item(const KP& p, int l, int it, char* smem) {
    const bf16_t* Z = (const bf16_t*)(p.ws + OFF_Z);
    bf16_t* MIX = (bf16_t*)(p.ws + OFF_MIX);
    float* hs = (float*)smem;
    int L, rowbase, t0;
    if (it < 1024) { L = SEQ; rowbase = (it >> 9) * SEQ; t0 = (it & 511) * 32; }
    else { const int r = it - 1024; L = CTXL; rowbase = NL + (r >> 3) * CTXL; t0 = (r & 7) * 32; }
    const int c = TIDX(), lane = c & 63, wave = c >> 6;
    {
        const int c4 = (c & 63) * 4, ts = c >> 6;
#pragma unroll 4
        for (int j = ts; j < 62; j += 4) {
            const int t = t0 - 15 + j;
            float4 h = make_float4(0.f, 0.f, 0.f, 0.f);
            if (t >= 0 && t < L) {
                const bf16_t* zr = Z + (size_t)(rowbase + t) * DIN + IN_CONV + c4;
                const uint2 v = *(const uint2*)zr, g = *(const uint2*)(zr + 256);
                h.x = __uint_as_float(v.x << 16) * sigmoidf_(__uint_as_float(g.x << 16));
                h.y = __uint_as_float(v.x & 0xffff0000u) * sigmoidf_(__uint_as_float(g.x & 0xffff0000u));
                h.z = __uint_as_float(v.y << 16) * sigmoidf_(__uint_as_float(g.y << 16));
                h.w = __uint_as_float(v.y & 0xffff0000u) * sigmoidf_(__uint_as_float(g.y & 0xffff0000u));
            }
            *(float4*)(hs + j * 256 + c4) = h;
        }
    }
    __syncthreads();
    float w[31];
#pragma unroll
    for (int k = 0; k < 31; ++k) w[k] = p.in[23][(size_t)(l * 31 + k) * 256 + c];
    const float cb = p.in[24][l * 256 + c];
#pragma unroll 1
    for (int tt = 0; tt < 32; ++tt) {
        float s = cb;
#pragma unroll
        for (int k = 0; k < 31; ++k) s += w[k] * hs[(tt + k) * 256 + c];
        hs[tt * 256 + c] = s;
    }
    __syncthreads();
    {
        const float4 lg = *(const float4*)(p.in[25] + l * 256 + lane * 4);
        const float4 lb = *(const float4*)(p.in[26] + l * 256 + lane * 4);
#pragma unroll 1
        for (int q = 0; q < 8; ++q) {
            const int tt = wave * 8 + q;
            const float4 v = *(const float4*)(hs + tt * 256 + lane * 4);
            const float mean = wave_sum(v.x + v.y + v.z + v.w) * (1.f / 256.f);
            const float d0 = v.x - mean, d1 = v.y - mean, d2 = v.z - mean, d3 = v.w - mean;
            const float var = wave_sum(d0 * d0 + d1 * d1 + d2 * d2 + d3 * d3) * (1.f / 256.f);
            const float rstd = rsqrtf(var + EPS);
            uint2 o;
            o.x = pack2(siluf_(d0 * rstd * lg.x + lb.x), siluf_(d1 * rstd * lg.y + lb.y));
            o.y = pack2(siluf_(d2 * rstd * lg.z + lb.z), siluf_(d3 * rstd * lg.w + lb.w));
            *(uint2*)(MIX + (size_t)(rowbase + t0 + tt) * DMIX + 256 + lane * 4) = o;
        }
    }
    __syncthreads();
    {
        const int c4 = (c & 63) * 4, ts = c >> 6;
#pragma unroll 4
        for (int j = ts; j < 47; j += 4) {
            const int t = t0 - 7 + j;
            float4 h = make_float4(0.f, 0.f, 0.f, 0.f);
            if (t >= 0 && t < L) {
                const uint2 v = *(const uint2*)(Z + (size_t)(rowbase + t) * DIN + IN_POOL + c4);
                h.x = __uint_as_float(v.x << 16); h.y = __uint_as_float(v.x & 0xffff0000u); h.z = __uint_as_float(v.y << 16); h.w = __uint_as_float(v.y & 0xffff0000u);
            }
            *(float4*)(hs + j * 256 + c4) = h;
        }
    }
    __syncthreads();
    {
        const int win = 2 << (c >> 6), wa = (win - 1) >> 1, wb = win >> 1;
#pragma unroll 1
        for (int tt = 0; tt < 32; ++tt) {
            const int t = t0 + tt;
            const int lo = max(t - wa, 0), hi = min(t + wb, L - 1);
            float s = 0.f;
            for (int q = lo; q <= hi; ++q) s += hs[(q - t0 + 7) * 256 + c];
            const float o = s / (float)(hi - lo + 1) - hs[(tt + 7) * 256 + c];
            MIX[(size_t)(rowbase + t) * DMIX + 512 + c] = f2bf(o);
        }
    }
    __syncthreads();
}

DI int chunk_row(int b, int k) { return k < 4 ? NL + b * CTXL + 64 * k : b * SEQ + 64 * (k - 4); }

template <bool FINAL>
DI void s5_item(const KP& p, int l, int it, char* smem) {
    const int g4 = it & 3, k = (it >> 2) % NCHUNK, b = (it >> 2) / NCHUNK;
    const int tid = TIDX(), lane = tid & 63, wave = tid >> 6, g = g4 * 4 + wave;
    const bf16_t* Z = (const bf16_t*)(p.ws + OFF_Z);
    float* Us = (float*)smem + wave * 1024;
    bf16_t* Hs = (bf16_t*)(smem + 16384) + wave * (16 * 136);
    const int rbase = chunk_row(b, k);
    {
        const uint4* src = (const uint4*)(Z + (size_t)(rbase + lane) * DIN + g * 16);
        const uint4 v0 = src[0], v1 = src[1];
        const unsigned w[8] = {v0.x, v0.y, v0.z, v0.w, v1.x, v1.y, v1.z, v1.w};
#pragma unroll
        for (int q = 0; q < 8; ++q) { Us[lane * 16 + 2 * q] = __uint_as_float(w[q] << 16); Us[lane * 16 + 2 * q + 1] = __uint_as_float(w[q] & 0xffff0000u); }
    }
    __syncthreads();
    f32x4 yacc[4];
#pragma unroll
    for (int s = 0; s < 4; ++s) yacc[s] = f32x4{0.f, 0.f, 0.f, 0.f};
#pragma unroll
    for (int dir = 0; dir < 2; ++dir) {
        const int pidx = ((l * 2 + dir) * 16 + g) * 64 + lane;
        const float4 lam = ((const float4*)(p.ws + OFF_LAMB))[pidx];
        float br[16], bi[16];
        {
            const float4* bb = (const float4*)((const float*)(p.ws + OFF_BBAR) + (size_t)pidx * 32);
#pragma unroll
            for (int q = 0; q < 8; ++q) { const float4 v = bb[q]; br[2 * q] = v.x; bi[2 * q] = v.y; br[2 * q + 1] = v.z; bi[2 * q + 1] = v.w; }
        }
        const size_t sidx = ((size_t)((b * 2 + dir) * NCHUNK + k) * 16 + g) * 64 + lane;
        float hr = 0.f, hi = 0.f;
        bf16x8 cfr[4];
        if (FINAL) {
            const float2 s0 = ((const float2*)(p.ws + OFF_S))[sidx];
            hr = s0.x; hi = s0.y;
            const bf16_t* cc = (const bf16_t*)(p.ws + OFF_CC) + (size_t)((l * 2 + dir) * 16 + g) * 2048 + (lane & 15) * 128 + (lane >> 4) * 8;
#pragma unroll
            for (int ks = 0; ks < 4; ++ks) cfr[ks] = *(const bf16x8*)(cc + 32 * ks);
        }
#pragma unroll
        for (int s = 0; s < 4; ++s) {
            const int sb = dir ? 3 - s : s;
#pragma unroll 1
            for (int tt = 0; tt < 16; ++tt) {
                const int tl = dir ? 15 - tt : tt, t = sb * 16 + tl;
                const float4* up = (const float4*)(Us + t * 16);
                float ar = 0.f, ai = 0.f;
#pragma unroll
                for (int q = 0; q < 4; ++q) {
                    const float4 u = up[q];
                    ar += br[4 * q] * u.x + br[4 * q + 1] * u.y + br[4 * q + 2] * u.z + br[4 * q + 3] * u.w;
                    ai += bi[4 * q] * u.x + bi[4 * q + 1] * u.y + bi[4 * q + 2] * u.z + bi[4 * q + 3] * u.w;
                }
                const float nr = lam.x * hr - lam.y * hi + ar, ni = lam.x * hi + lam.y * hr + ai;
                hr = nr; hi = ni;
                if (FINAL) { Hs[tl * 136 + lane] = f2bf(hr); Hs[tl * 136 + 64 + lane] = f2bf(hi); }
            }
            if (FINAL) {
                __syncthreads();
                const bf16_t* hp = Hs + (lane & 15) * 136 + (lane >> 4) * 8;
#pragma unroll
                for (int ks = 0; ks < 4; ++ks) { const bf16x8 a = *(const bf16x8*)(hp + 32 * ks); yacc[sb] = MFMA16(a, cfr[ks], yacc[sb]); }
                __syncthreads();
            }
        }
        if (!FINAL) ((float2*)(p.ws + OFF_E))[sidx] = make_float2(hr, hi);
    }
    if (FINAL) {
        bf16_t* S5P = (bf16_t*)(p.ws + OFF_S5P);
        const int hcol = lane & 15;
        const float dg = p.in[20][l * 256 + g * 16 + hcol];
#pragma unroll
        for (int s = 0; s < 4; ++s)
#pragma unroll
            for (int j = 0; j < 4; ++j) {
                const int t = s * 16 + (lane >> 4) * 4 + j;
                const float y = yacc[s][j] + dg * Us[t * 16 + hcol];
                S5P[(size_t)(rbase + t) * 256 + g * 16 + hcol] = f2bf(gelu_tanh(y));
            }
    }
    __syncthreads();
}

DI void s5_carry(const KP& p, int l, int blk) {
    const int idx = blk * 256 + TIDX();
    const int gp = idx & 1023, dir = (idx >> 10) & 1, b = idx >> 11;
    const float4 lam = ((const float4*)(p.ws + OFF_LAMB))[(l * 2 + dir) * 1024 + gp];
    const float2* E = (const float2*)(p.ws + OFF_E) + (size_t)(b * 2 + dir) * NCHUNK * 1024 + gp;
    float2* S = (float2*)(p.ws + OFF_S) + (size_t)(b * 2 + dir) * NCHUNK * 1024 + gp;
    float sr = 0.f, si = 0.f;
    for (int j0 = 0; j0 < NCHUNK; j0 += 4) {
        const int k0 = dir ? (j0 < 4 ? 3 - j0 : 263 - j0) : j0, stp = dir ? -1 : 1;
        const float2 e0 = E[(size_t)k0 * 1024], e1 = E[(size_t)(k0 + stp) * 1024], e2 = E[(size_t)(k0 + 2 * stp) * 1024], e3 = E[(size_t)(k0 + 3 * stp) * 1024];
        float nr, ni;
        S[(size_t)k0 * 1024] = make_float2(sr, si);
        nr = lam.z * sr - lam.w * si + e0.x; ni = lam.z * si + lam.w * sr + e0.y; sr = nr; si = ni;
        S[(size_t)(k0 + stp) * 1024] = make_float2(sr, si);
        nr = lam.z * sr - lam.w * si + e1.x; ni = lam.z * si + lam.w * sr + e1.y; sr = nr; si = ni;
        S[(size_t)(k0 + 2 * stp) * 1024] = make_float2(sr, si);
        nr = lam.z * sr - lam.w * si + e2.x; ni = lam.z * si + lam.w * sr + e2.y; sr = nr; si = ni;
        S[(size_t)(k0 + 3 * stp) * 1024] = make_float2(sr, si);
        nr = lam.z * sr - lam.w * si + e3.x; ni = lam.z * si + lam.w * sr + e3.y; sr = nr; si = ni;
    }
}

DI void attn_item(const KP& p, int it, char* smem) {
    const bf16_t* Q = (const bf16_t*)(p.ws + OFF_Q);
    const bf16_t* Kg = (const bf16_t*)(p.ws + OFF_K);
    const bf16_t* Vg = (const bf16_t*)(p.ws + OFF_VT);
    bf16_t* MIX = (bf16_t*)(p.ws + OFF_MIX);
    const int tid = TIDX(), lane = tid & 63, wave = tid >> 6, l31 = lane & 31, hh = lane >> 5;
    int bh, qrow0, kt0, T;
    if (it < 1024) { bh = it >> 6; qrow0 = (bh >> 3) * SEQ + (it & 63) * 256; kt0 = 0; T = NCHUNK; }
    else { bh = it - 1024; qrow0 = NL + (bh >> 3) * CTXL; kt0 = SEQ / 64; T = CTXL / 64; }
    const int head = bh & 7;
    const bf16_t* Kb = Kg + (size_t)bh * LK * DK + (size_t)kt0 * 64 * DK;
    const bf16_t* Vb = Vg + (size_t)bh * 64 * LK + kt0 * 64;
    bf16_t* sK = (bf16_t*)smem;
    bf16_t* sV = sK + 2 * 64 * 104;
    const int qrow = qrow0 + wave * 64 + l31;
    bf16x8 qf[2][6];
#pragma unroll
    for (int qb = 0; qb < 2; ++qb)
#pragma unroll
        for (int s = 0; s < 6; ++s) qf[qb][s] = *(const bf16x8*)(Q + (size_t)(qrow + 32 * qb) * 768 + head * 96 + 16 * s + 8 * hh);
    f32x16 o[2][2];
#pragma unroll
    for (int i = 0; i < 16; ++i) { o[0][0][i] = 0.f; o[0][1][i] = 0.f; o[1][0][i] = 0.f; o[1][1][i] = 0.f; }
    float m_run[2] = {-1e30f, -1e30f}, l_run[2] = {0.f, 0.f};
    u32x4 rk0, rk1, rk2, rv0, rv1;
    const int vrow = tid >> 3, vcol = (tid & 7) * 8;
    const int kw0 = (tid / 12) * 104 + (tid % 12) * 8, kw1 = ((tid + 256) / 12) * 104 + ((tid + 256) % 12) * 8, kw2 = ((tid + 512) / 12) * 104 + ((tid + 512) % 12) * 8;
    const bf16_t* cK = sK + l31 * 104 + 8 * hh;
    const bf16_t* cV = sV + l31 * 72 + 8 * hh;
#define ATT_KWRITE(buf_) do { bf16_t* k_ = sK + (buf_) * 64 * 104; *(u32x4*)(k_ + kw0) = rk0; *(u32x4*)(k_ + kw1) = rk1; *(u32x4*)(k_ + kw2) = rk2; } while (0)
#define ATT_VWRITE(buf_) do { bf16_t* v_ = sV + (buf_) * 64 * 72 + vrow * 72 + vcol; *(u32x4*)(v_) = rv0; *(u32x4*)(v_ + 32 * 72) = rv1; } while (0)
    {
        const bf16_t* kp = Kb + tid * 8;
        rk0 = *(const u32x4*)(kp); rk1 = *(const u32x4*)(kp + 2048); rk2 = *(const u32x4*)(kp + 4096);
        const bf16_t* vp = Vb + (size_t)vrow * LK + vcol;
        rv0 = *(const u32x4*)(vp); rv1 = *(const u32x4*)(vp + (size_t)32 * LK);
        ATT_KWRITE(0); ATT_VWRITE(0);
    }
    __syncthreads();
    for (int t = 0; t < T; ++t) {
        const int buf = t & 1;
        const bool more = (t + 1) < T;
        if (more) {
            const bf16_t* kp_ = Kb + (size_t)(t + 1) * 64 * DK + tid * 8; gld16(rk0, kp_); gld16(rk1, kp_ + 2048); gld16(rk2, kp_ + 4096);
            const bf16_t* vp_ = Vb + (size_t)vrow * LK + (t + 1) * 64 + vcol; gld16(rv0, vp_); gld16(rv1, vp_ + (size_t)32 * LK);
        }
#pragma unroll
        for (int kb = 0; kb < 2; ++kb) {
            f32x16 s[2];
#pragma unroll
            for (int i = 0; i < 16; ++i) { s[0][i] = 0.f; s[1][i] = 0.f; }
            bf16x8 kf[6];
#pragma unroll
            for (int ks = 0; ks < 6; ++ks) kf[ks] = *(const bf16x8*)(cK + buf * 64 * 104 + kb * 32 * 104 + 16 * ks);
            __builtin_amdgcn_sched_barrier(0);
            __builtin_amdgcn_s_setprio(1);
#pragma unroll
            for (int ks = 0; ks < 6; ++ks) {
                s[0] = MFMA32(kf[ks], qf[0][ks], s[0]);
                s[1] = MFMA32(kf[ks], qf[1][ks], s[1]);
            }
            __builtin_amdgcn_s_setprio(0);
#pragma unroll
            for (int qb = 0; qb < 2; ++qb) {
                float mx = s[qb][0];
#pragma unroll
                for (int i = 1; i < 16; ++i) mx = fmaxf(mx, s[qb][i]);
                mx = xhalf_max(mx);
                const float m_new = fmaxf(m_run[qb], mx);
                if (__builtin_amdgcn_ballot_w64(m_new > m_run[qb]) != 0ull) {
                    const float alpha = __builtin_amdgcn_exp2f(m_run[qb] - m_new);
                    m_run[qb] = m_new; l_run[qb] *= alpha;
#pragma unroll
                    for (int i = 0; i < 16; ++i) { o[qb][0][i] *= alpha; o[qb][1][i] *= alpha; }
                }
                float ps = 0.f;
#pragma unroll
                for (int i = 0; i < 16; ++i) { s[qb][i] = __builtin_amdgcn_exp2f(s[qb][i] - m_run[qb]); ps += s[qb][i]; }
                l_run[qb] += ps;
            }
            bf16x8 vf[2][2];
#pragma unroll
            for (int u = 0; u < 2; ++u)
#pragma unroll
                for (int dvb = 0; dvb < 2; ++dvb) vf[u][dvb] = *(const bf16x8*)(cV + buf * 64 * 72 + dvb * 32 * 72 + 32 * kb + 16 * u);
            __builtin_amdgcn_sched_barrier(0);
#pragma unroll
            for (int u = 0; u < 2; ++u) {
                const bf16x8 p0 = __builtin_bit_cast(bf16x8, u32x4{pack2(s[0][8 * u], s[0][8 * u + 1]), pack2(s[0][8 * u + 2], s[0][8 * u + 3]), pack2(s[0][8 * u + 4], s[0][8 * u + 5]), pack2(s[0][8 * u + 6], s[0][8 * u + 7])});
                const bf16x8 p1 = __builtin_bit_cast(bf16x8, u32x4{pack2(s[1][8 * u], s[1][8 * u + 1]), pack2(s[1][8 * u + 2], s[1][8 * u + 3]), pack2(s[1][8 * u + 4], s[1][8 * u + 5]), pack2(s[1][8 * u + 6], s[1][8 * u + 7])});
                __builtin_amdgcn_s_setprio(1);
#pragma unroll
                for (int dvb = 0; dvb < 2; ++dvb) {
                    o[0][dvb] = MFMA32(vf[u][dvb], p0, o[0][dvb]);
                    o[1][dvb] = MFMA32(vf[u][dvb], p1, o[1][dvb]);
                }
                __builtin_amdgcn_s_setprio(0);
            }
        }
        if (more) { vm_wait5(rk0, rk1, rk2, rv0, rv1); ATT_KWRITE(buf ^ 1); ATT_VWRITE(buf ^ 1); }
        __syncthreads();
    }
#undef ATT_KWRITE
#undef ATT_VWRITE
#pragma unroll
    for (int qb = 0; qb < 2; ++qb) {
        const float lt = xhalf_sum(l_run[qb]);
        const float inv = 1.f / lt;
#pragma unroll
        for (int dvb = 0; dvb < 2; ++dvb)
#pragma unroll
            for (int q = 0; q < 4; ++q) {
                uint2 ov; ov.x = pack2(o[qb][dvb][4 * q] * inv, o[qb][dvb][4 * q + 1] * inv); ov.y = pack2(o[qb][dvb][4 * q + 2] * inv, o[qb][dvb][4 * q + 3] * inv);
                *(uint2*)(MIX + (size_t)(qrow + 32 * qb) * DMIX + 768 + head * 64 + 32 * dvb + 8 * q + 4 * hh) = ov;
            }
    }
}

PH_FN void misc_phase(const KP& p, int l, char* smem) {
    const int n_qkv = 260 * 14, n_cp = l == 1 ? 1024 : 1040, n_s5 = 2 * NCHUNK * 4;
    const int rot = (blockIdx.x + gridDim.x / 2) % gridDim.x;
    for (int it = vblock(); it < n_qkv; it += gridDim.x) qkv_item(p, l, it, smem);
    for (int it = rot; it < n_cp; it += gridDim.x) convpool_item(p, l, it, smem);
    for (int it = blockIdx.x; it < n_s5; it += gridDim.x) s5_item<false>(p, l, it, smem);
#if MISC_DUP == 1
    for (int it = vblock(); it < n_qkv; it += gridDim.x) qkv_item(p, l, it, smem);
#elif MISC_DUP == 2
    for (int it = rot; it < n_cp; it += gridDim.x) convpool_item(p, l, it, smem);
#elif MISC_DUP == 3
    for (int it = blockIdx.x; it < n_s5; it += gridDim.x) s5_item<false>(p, l, it, smem);
#endif
}
PH_FN void attn_phase(const KP& p, int l, char* smem) {
    const int n_att = l == 1 ? 1024 : 1024 + 16;
    if (blockIdx.x < 16) s5_carry(p, l, blockIdx.x);
    for (int it = vblock(); it < n_att; it += gridDim.x) attn_item(p, it, smem);
}
PH_FN void s5fin_phase(const KP& p, int l, char* smem) {
    for (int it = blockIdx.x; it < 2 * NCHUNK * 4; it += gridDim.x) s5_item<true>(p, l, it, smem);
}

DI void run_phase(const KP& p, int ph, char* smem) {
    if (ph == 0) { prep_phase(p, smem); return; }
    if (ph == 27) {
        rowop_phase(p, 1, 8, 0.5f, p.in[7] + (1 * 3 + 2) * D, true, 0, 0, nullptr, false, false, NL);
        return;
    }
    const int l = (ph - 1) / 13, s = (ph - 1) % 13;
    const bf16_t* Wl = (const bf16_t*)(p.ws + OFF_W) + (size_t)l * WL_EL;
    const float* npre = p.in[6] + (size_t)l * 3 * D;
    const float* npost = p.in[7] + (size_t)l * 3 * D;
    const bool lastl = l == 1;
    switch (s) {
    case 0:
        if (l == 0) rowop_phase(p, 0, 0, 0.f, nullptr, false, 0, 0, npre, true, true);
        else rowop_phase(p, l - 1, 8, 0.5f, p.in[7] + ((l - 1) * 3 + 2) * D, true, l, 0, npre, true, false);
        break;
    case 1: case 11: gemm1_phase(p, l, s == 11, smem, (lastl && s == 11) ? NL / 256 : NT / 256); break;
    case 2: case 9: case 12: {
        const bool isout = s == 9;
        const bf16_t* Ag = (const bf16_t*)(p.ws + (isout ? OFF_MIX : OFF_ACT));
        const bf16_t* Wg = Wl + (isout ? WO_OUT : (s == 12 ? WO_D1 : WO_D0));
        const int Kg = isout ? DMIX : FF;
        gemm_store_phase256<D>(Ag, Kg, Wg, Kg, 8, (bf16_t*)(p.ws + OFF_HY), smem, NL / 256, (lastl && s != 2) ? 0 : NC / 128);
    } break;
    case 3: rowop_phase(p, l, 2, 0.5f, npost, true, l, 3, npre + D, true, l == 0); break;
    case 4: gemm_store_phase256<DIN>((const bf16_t*)(p.ws + OFF_HY), D, Wl + WO_IN, D, 12, (bf16_t*)(p.ws + OFF_Z), smem, NL / 256, NC / 128); break;
    case 5: misc_phase(p, l, smem); break;
    case 6: attn_phase(p, l, smem); break;
    case 7: s5fin_phase(p, l, smem); break;
    case 8: glu_phase(p, l, smem); break;
    case 10: rowop_phase(p, l, 5, 1.0f, npost + D, true, l, 6, npre + 2 * D, true, false, lastl ? NL : NT); break;
    }
}

constexpr int N_PHASES = 28;

__global__ void __launch_bounds__(256, 2) mega_kernel(KP p, int ph_lo, int ph_hi) {
    __shared__ __attribute__((aligned(16))) char smem[65536];
    __shared__ KP s_kp;
    if (TIDX() < 33) s_kp.in[TIDX()] = p.in[TIDX()];
    if (TIDX() == 33) s_kp.out = p.out;
    if (TIDX() == 34) s_kp.ws = p.ws;
    __shared__ uint4 xb_words;
    if (TIDX() == 0) xb_words = make_uint4(0u, 0u, 0u, 0u);
    __syncthreads();
    XcdBarrier xb = xcd_barrier_post((unsigned*)(p.ws + OFF_BAR), (volatile LAS unsigned*)&xb_words);
    for (int ph = ph_lo; ph < ph_hi; ++ph) {
        run_phase(p, ph, smem);
        if (DUP_MASK) {
            const int sbit = ph == 0 ? 13 : (ph == 27 ? 14 : (ph - 1) % 13);
            if ((DUP_MASK >> sbit) & 1) { xcd_barrier(xb); run_phase(p, ph, smem); }
        }
#if PROBE_MODE
        {
            const int sb = ph == 0 || ph == 27 ? -1 : (ph - 1) % 13, pl = (ph - 1) / 13;
            const bf16_t* Wl = (const bf16_t*)(s_kp.ws + OFF_W) + (size_t)pl * WL_EL;
            if (sb == 1 || sb == 11) { cg::this_grid().sync(); gemm1_phase<PROBE_MODE>(s_kp, pl, sb == 11, smem); }
            if (sb == 2 || sb == 12) { cg::this_grid().sync(); gemm_store_phase<PROBE_MODE>((const bf16_t*)(s_kp.ws + OFF_ACT), FF, Wl + (sb == 12 ? WO_D1 : WO_D0), FF, 8, (bf16_t*)(s_kp.ws + OFF_HY), D, D, smem); }
        }
#endif
        if (EXTRA_SYNCS) { xcd_barrier(xb); xcd_barrier(xb); }
        if (ph + 1 < ph_hi) { if (ph_hi < 0) cg::this_grid().sync(); else xcd_barrier(xb); }
    }
}

extern "C" void kernel_launch(void* const* d_in, const int* in_sizes, int n_in, void* d_out, int out_size, void* d_ws, size_t ws_size, hipStream_t stream) {
    static int grid = 0;
    if (grid == 0) {
        if (n_in != 33 || ws_size < WS_END) { fprintf(stderr, "kernel_launch: unexpected n_in %d or ws_size %zu < %zu\n", n_in, ws_size, (size_t)WS_END); grid = -1; return; }
        int dev = 0, cus = 0, per_cu = 0;
        hipGetDevice(&dev);
        hipDeviceGetAttribute(&cus, hipDeviceAttributeMultiprocessorCount, dev);
        hipOccupancyMaxActiveBlocksPerMultiprocessor(&per_cu, (const void*)mega_kernel, 256, 0);
        if (per_cu < 1) per_cu = 1;
        if (per_cu > 2) per_cu = 2;
        grid = cus * per_cu;
    }
    if (grid < 0) return;
    KP p{};
    for (int i = 0; i < 33; ++i) p.in[i] = (const float*)d_in[i];
    p.out = (float*)d_out; p.ws = (char*)d_ws;
    if (hipMemsetAsync((char*)d_ws + OFF_BAR, 0, 3456 * 4, stream) != hipSuccess) { fprintf(stderr, "kernel_launch: memset of barrier words failed\n"); return; }
#if ONE_LAUNCH
    int lo = 0, hi = N_PHASES;
    void* args[] = {&p, &lo, &hi};
    hipError_t e = hipLaunchCooperativeKernel((const void*)mega_kernel, dim3(grid), dim3(256), args, 0, stream);
    if (e != hipSuccess) fprintf(stderr, "cooperative launch failed: %s (grid %d)\n", hipGetErrorString(e), grid);
#else
    for (int ph = 0; ph < N_PHASES; ++ph) hipLaunchKernelGGL(mega_kernel, dim3(grid), dim3(256), 0, stream, p, ph, ph + 1);
#endif
}
```

```cpp
#include <hip/hip_runtime.h>
#include <hip/hip_cooperative_groups.h>
#include <cstdio>
#include <cstdint>
namespace cg = cooperative_groups;

#ifndef ONE_LAUNCH
#define ONE_LAUNCH 1
#endif
#define PROBE_MODE 0
#define EXTRA_SYNCS 0
#define MISC_DUP 0
#define ATT_PROBE 0
#define DUP_MASK 0

#define DI __device__ __forceinline__
#define PH_FN __device__ __forceinline__
typedef unsigned short bf16_t;
using bf16x8 = __attribute__((ext_vector_type(8))) short;
using f32x16 = __attribute__((ext_vector_type(16))) float;
using f32x4 = __attribute__((ext_vector_type(4))) float;
typedef unsigned u32x4 __attribute__((ext_vector_type(4)));
typedef __bf16 bf16x2_t __attribute__((ext_vector_type(2)));
typedef float f2_t __attribute__((ext_vector_type(2)));
typedef float f4_t __attribute__((ext_vector_type(4)));
typedef unsigned u2_t __attribute__((ext_vector_type(2)));

constexpr int D = 1024, SEQ = 16384, NB = 2, CTXL = 256;
constexpr int NL = NB * SEQ, NC = NB * CTXL, NT = NL + NC;
constexpr int FF = 2816, DIN = 1440, DMIX = 1280;
constexpr int NH = 8, DK = 96, LK = SEQ + CTXL;
constexpr int IN_CONV = 256, IN_POOL = 768, IN_CQ = 1024, IN_CKV = 1280, IN_KR = 1408;
constexpr int NCHUNK = LK / 64;
constexpr float EPS = 1e-6f;
constexpr float QSCALE = 0.10206207261596575f * 1.4426950408889634f;

constexpr size_t EL_GU = 5632ull * 1024, EL_D = 1024ull * 2816, EL_IN = 1536ull * 1024, EL_OUT = 1024ull * 1280,
                 EL_UQ = 768ull * 256, EL_UKV = 1024ull * 128, EL_GLU = 256ull * 256;
constexpr size_t WO_GU0 = 0, WO_GU1 = EL_GU, WO_D0 = 2 * EL_GU, WO_D1 = WO_D0 + EL_D, WO_IN = WO_D1 + EL_D,
                 WO_OUT = WO_IN + EL_IN, WO_UQ = WO_OUT + EL_OUT, WO_UKV = WO_UQ + EL_UQ, WO_GLU = WO_UKV + EL_UKV,
                 WL_EL = WO_GLU + EL_GLU;
constexpr size_t al256(size_t x) { return (x + 255) & ~(size_t)255; }
constexpr size_t OFF_W = 0;
constexpr size_t OFF_MOD = al256(OFF_W + 2 * WL_EL * 2);
constexpr size_t OFF_ROPE = al256(OFF_MOD + 2ull * 3 * 9216 * 4);
constexpr size_t OFF_LAMB = al256(OFF_ROPE + 256ull * 8 * 2 * 4);
constexpr size_t OFF_BBAR = al256(OFF_LAMB + 2ull * 2048 * 16);
constexpr size_t OFF_CC = al256(OFF_BBAR + 2ull * 2048 * 32 * 4);
constexpr size_t OFF_XC = al256(OFF_CC + 2ull * 32 * 2048 * 2);
constexpr size_t OFF_HY = al256(OFF_XC + (size_t)NC * D * 4);
constexpr size_t OFF_BIG = al256(OFF_HY + (size_t)NT * D * 2);
constexpr size_t OFF_ACT = OFF_BIG;
constexpr size_t OFF_Z = OFF_BIG;
constexpr size_t OFF_Q = al256(OFF_Z + (size_t)NT * DIN * 2);
constexpr size_t OFF_K = al256(OFF_Q + (size_t)NT * 768 * 2);
constexpr size_t OFF_VT = al256(OFF_K + (size_t)NB * NH * LK * 96 * 2);
constexpr size_t OFF_MIX = al256(OFF_VT + (size_t)NB * NH * 64 * LK * 2);
constexpr size_t OFF_S5P = al256(OFF_MIX + (size_t)NT * DMIX * 2);
constexpr size_t OFF_E = al256(OFF_S5P + (size_t)NT * 256 * 2);
constexpr size_t OFF_S = al256(OFF_E + 2ull * 2 * NCHUNK * 1024 * 8);
constexpr size_t OFF_BAR = al256(OFF_S + 2ull * 2 * NCHUNK * 1024 * 8);
constexpr size_t WS_END = al256(OFF_BAR + 3456 * 4);
static_assert(OFF_ACT + (size_t)NT * FF * 2 <= WS_END, "act fits");

struct KP { const float* in[33]; float* out; char* ws; };

DI int TIDX() { int t = threadIdx.x; asm volatile("" : "+v"(t)); return t; }
DI float bf2f(bf16_t b) { return __uint_as_float((unsigned)b << 16); }
DI unsigned pack2(float a, float b) { f2_t v = {a, b}; bf16x2_t r = __builtin_convertvector(v, bf16x2_t); return __builtin_bit_cast(unsigned, r); }
DI bf16_t f2bf(float a) { return (bf16_t)(pack2(a, 0.f) & 0xffffu); }
DI float fast_exp(float x) { return __builtin_amdgcn_exp2f(x * 1.4426950408889634f); }
DI float sigmoidf_(float x) { return __builtin_amdgcn_rcpf(1.f + fast_exp(-x)); }
DI float siluf_(float x) { return x * sigmoidf_(x); }
DI float gelu_tanh(float x) { float u = 0.7978845608028654f * (x + 0.044715f * x * x * x); float t = 1.f - 2.f * __builtin_amdgcn_rcpf(1.f + fast_exp(2.f * u)); return 0.5f * x * (1.f + t); }
DI float shflx(float v, int m) { const int idx = ((TIDX() & 63) ^ m) << 2; return __int_as_float(__builtin_amdgcn_ds_bpermute(idx, __float_as_int(v))); }
DI float xhalf_max(float v) { const auto r = __builtin_amdgcn_permlane32_swap(__float_as_uint(v), __float_as_uint(v), false, false); return fmaxf(__uint_as_float(r[0]), __uint_as_float(r[1])); }
DI float xhalf_sum(float v) { const auto r = __builtin_amdgcn_permlane32_swap(__float_as_uint(v), __float_as_uint(v), false, false); return __uint_as_float(r[0]) + __uint_as_float(r[1]); }
DI float wave_sum(float v) { for (int m = 32; m >= 1; m >>= 1) v += shflx(v, m); return v; }
DI int crow(int i, int hh) { return (i & 3) + 8 * (i >> 2) + 4 * hh; }
DI int row_mod(int row) { return row < NL ? (row >= SEQ ? 1 : 0) : 2; }
DI int vblock() { const int G = gridDim.x, b = blockIdx.x; return (G & 7) ? b : (G >> 3) * (b & 7) + (b >> 3); }
DI void tile_mn(int it, int TM, int TN, int& mt, int& nt) {
    const int band = it / (8 * TN), within = it - band * 8 * TN;
    const int gm = min(8, TM - 8 * band);
    nt = within / gm; mt = 8 * band + (within - nt * gm);
}
DI void gld16(u32x4& r, const void* p) { asm volatile("global_load_dwordx4 %0, %1, off" : "=&v"(r) : "v"(p) : "memory"); }
DI void vm_wait8(u32x4& a, u32x4& b, u32x4& c, u32x4& d, u32x4& e, u32x4& f, u32x4& g, u32x4& h) {
    asm volatile("s_waitcnt vmcnt(0)" : "+v"(a), "+v"(b), "+v"(c), "+v"(d), "+v"(e), "+v"(f), "+v"(g), "+v"(h) : : "memory"); }
DI void vm_wait5(u32x4& a, u32x4& b, u32x4& c, u32x4& d, u32x4& e) {
    asm volatile("s_waitcnt vmcnt(0)" : "+v"(a), "+v"(b), "+v"(c), "+v"(d), "+v"(e) : : "memory"); }
#define MFMA32(a, b, c) __builtin_amdgcn_mfma_f32_32x32x16_bf16((a), (b), (c), 0, 0, 0)
#define MFMA16(a, b, c) __builtin_amdgcn_mfma_f32_16x16x32_bf16((a), (b), (c), 0, 0, 0)

#define XB_TMO      128
#define XB_XCNT(j)  (256  + 64 * (j))
#define XB_XSUB(j)  (1280 + 64 * (j))
#define XB_XGEN(j)  (2304 + 64 * (j))
#define XB_TOP      3328
#define XB_TOPGEN   3392
#define XCD_BAR_WORDS 3456
#define XB_SPIN_CAP (1u << 18)
#define LAS __attribute__((address_space(3)))

__device__ __forceinline__ unsigned xb_ld(unsigned* p)              { return __hip_atomic_load(p, __ATOMIC_RELAXED, __HIP_MEMORY_SCOPE_AGENT); }
__device__ __forceinline__ unsigned xb_add(unsigned* p, unsigned v) { return __hip_atomic_fetch_add(p, v, __ATOMIC_RELAXED, __HIP_MEMORY_SCOPE_AGENT); }
__device__ __forceinline__ unsigned xb_xcc_id() { return (unsigned)__builtin_amdgcn_s_getreg((3 << 11) | 20) & 0xFu; }
#define XB_SPIN(cond, bar) do { unsigned _sp = 0; while (cond) { __builtin_amdgcn_s_sleep(1); \
    if ((++_sp & 255u) == 0u) { if (xb_ld(&(bar)[XB_TMO])) break; if (_sp > XB_SPIN_CAP) { atomicAdd(&(bar)[XB_TMO], 1u); break; } } } } while (0)

struct XcdBarrier {
    unsigned* bar; unsigned x;
    volatile LAS unsigned* st;
};

__device__ __forceinline__ XcdBarrier xcd_barrier_post(unsigned* bar, volatile LAS unsigned* st) {
    XcdBarrier b; b.bar = bar; b.x = xb_xcc_id(); b.st = st;
    if (TIDX() == 0) (void)xb_add(&bar[XB_XCNT(b.x)], 1u);
    return b;
}
__device__ __forceinline__ void xcd_barrier_complete(unsigned* bar, unsigned x, unsigned& nloc, unsigned& nx) {
    const unsigned G = gridDim.x * gridDim.y * gridDim.z;
    unsigned sum, cnt, mine, sp = 0u;
    for (;;) {
        sum = 0u; cnt = 0u; mine = 0u;
#pragma unroll
        for (unsigned j = 0; j < 16; ++j) { const unsigned c = xb_ld(&bar[XB_XCNT(j)]); sum += c; cnt += (c > 0u) ? 1u : 0u; mine = (j == x) ? c : mine; }
        if (sum == G) break;
        __builtin_amdgcn_s_sleep(1);
        if ((++sp & 255u) == 0u) { if (xb_ld(&bar[XB_TMO])) break; if (sp > XB_SPIN_CAP) { atomicAdd(&bar[XB_TMO], 1u); break; } }
    }
    nloc = mine > 0u ? mine : 1u; nx = cnt > 0u ? cnt : 1u;
}

__device__ __forceinline__ void xcd_barrier(const XcdBarrier& b) {
    asm volatile("s_waitcnt vmcnt(0)" ::: "memory");
    __syncthreads();
    if (TIDX() == 0) {
        unsigned* bar = b.bar;
        __builtin_amdgcn_s_waitcnt(0);
        unsigned nloc = b.st[0], nx = b.st[1];
        if (nloc == 0u) { xcd_barrier_complete(bar, b.x, nloc, nx); b.st[0] = nloc; b.st[1] = nx; }
        const unsigned old = xb_add(&bar[XB_XSUB(b.x)], 1u);
        const unsigned gen = old / nloc;
        if (old + 1u == (gen + 1u) * nloc) {
            __builtin_amdgcn_fence(__ATOMIC_RELEASE, "agent");
            asm volatile("s_waitcnt vmcnt(0)" ::: "memory");
            const unsigned og = xb_add(&bar[XB_TOP], 1u);
            const unsigned tg = og / nx;
            if (og + 1u == (tg + 1u) * nx) xb_add(&bar[XB_TOPGEN], 1u);
            else XB_SPIN(xb_ld(&bar[XB_TOPGEN]) == tg, bar);
            __builtin_amdgcn_fence(__ATOMIC_ACQUIRE, "agent");
            xb_add(&bar[XB_XGEN(b.x)], 1u);
            asm volatile("s_waitcnt vmcnt(0)" ::: "memory");
        } else {
            XB_SPIN(xb_ld(&bar[XB_XGEN(b.x)]) == gen, bar);
            __builtin_amdgcn_fence(__ATOMIC_ACQUIRE, "agent");
            asm volatile("s_waitcnt vmcnt(0)" ::: "memory");
        }
    }
    __syncthreads();
}


DI void vm_wait_sel(u32x4& a, u32x4& b, u32x4& c, u32x4& d, u32x4& e, u32x4& f, u32x4& g, u32x4& h, int all) {
    asm volatile("s_cmp_lg_u32 %8, 0\n\ts_cbranch_scc1 1f\n\ts_waitcnt vmcnt(8)\n\ts_branch 2f\n1:\n\ts_waitcnt vmcnt(0)\n2:"
                 : "+v"(a), "+v"(b), "+v"(c), "+v"(d), "+v"(e), "+v"(f), "+v"(g), "+v"(h) : "s"(all) : "memory", "scc"); }

template <int MODE = 0, class Epi>
DI void gemm_tile(const bf16_t* __restrict__ A, int lda, const bf16_t* __restrict__ Bt, int ldb, int K, int row0, int col0, char* smem, Epi&& epi) {
    bf16_t* sA = (bf16_t*)smem;
    bf16_t* sB = sA + 2 * 8192;
    const int tid = TIDX(), lane = tid & 63, wave = tid >> 6;
    const int wm = wave >> 1, wn = wave & 1, l31 = lane & 31, hh = lane >> 5;
    u32x4 r0a[4], r0b[4], r1a[4], r1b[4];
    const bf16_t* Ap = A + (size_t)(row0 + (tid >> 3)) * lda + (tid & 7) * 8;
    const bf16_t* Bp = Bt + (size_t)(col0 + (tid >> 3)) * ldb + (tid & 7) * 8;
    const int wr_off = (tid >> 3) * 64 + (((tid & 7) ^ ((tid >> 4) & 7)) * 8);
    f32x16 acc[2][2];
#pragma unroll
    for (int a = 0; a < 2; ++a)
#pragma unroll
        for (int b = 0; b < 2; ++b)
#pragma unroll
            for (int i = 0; i < 16; ++i) acc[a][b][i] = 0.f;
    const int nk = K >> 6;
#pragma unroll
    for (int i = 0; i < 4; ++i) { r0a[i] = *(const u32x4*)(Ap + (size_t)i * 32 * lda); r0b[i] = *(const u32x4*)(Bp + (size_t)i * 32 * ldb); }
#pragma unroll
    for (int i = 0; i < 4; ++i) { *(u32x4*)(sA + wr_off + i * 2048) = r0a[i]; *(u32x4*)(sB + wr_off + i * 2048) = r0b[i]; }
#pragma unroll
    for (int i = 0; i < 4; ++i) { gld16(r1a[i], Ap + (size_t)i * 32 * lda + 64); gld16(r1b[i], Bp + (size_t)i * 32 * ldb + 64); }
    __syncthreads();
    const int sw = (l31 >> 1) & 7;
    const bf16_t* cA = sA + (wm * 64 + l31) * 64;
    const bf16_t* cB = sB + (wn * 64 + l31) * 64;
#define GEMM_LDFRAG(buf_, ks_, a0_, a1_, b0_, b1_) do { const int ch = ((2 * (ks_) + hh) ^ sw) * 8; \
            a0_ = *(const bf16x8*)(cA + (buf_) * 8192 + ch); a1_ = *(const bf16x8*)(cA + (buf_) * 8192 + 32 * 64 + ch); \
            b0_ = *(const bf16x8*)(cB + (buf_) * 8192 + ch); b1_ = *(const bf16x8*)(cB + (buf_) * 8192 + 32 * 64 + ch); } while (0)
#define GEMM_MMA(a0_, a1_, b0_, b1_) do { acc[0][0] = MFMA32(a0_, b0_, acc[0][0]); acc[0][1] = MFMA32(a0_, b1_, acc[0][1]); \
            acc[1][0] = MFMA32(a1_, b0_, acc[1][0]); acc[1][1] = MFMA32(a1_, b1_, acc[1][1]); } while (0)
#define SB_ __builtin_amdgcn_sched_barrier(0)
#define GEMM_COMPUTE(buf_) do { bf16x8 pa0, pa1, pb0, pb1, qa0, qa1, qb0, qb1; \
            GEMM_LDFRAG(buf_, 0, pa0, pa1, pb0, pb1); GEMM_LDFRAG(buf_, 1, qa0, qa1, qb0, qb1); SB_; GEMM_MMA(pa0, pa1, pb0, pb1); SB_; \
            GEMM_LDFRAG(buf_, 2, pa0, pa1, pb0, pb1); SB_; GEMM_MMA(qa0, qa1, qb0, qb1); SB_; \
            GEMM_LDFRAG(buf_, 3, qa0, qa1, qb0, qb1); SB_; GEMM_MMA(pa0, pa1, pb0, pb1); SB_; GEMM_MMA(qa0, qa1, qb0, qb1); SB_; } while (0)
    for (int kt = 0; kt < nk; kt += 2) {
        const bool m2 = (kt + 2) < nk, m3 = (kt + 3) < nk;
        if (m2 && MODE == 0) {
            const int k0 = (kt + 2) << 6;
#pragma unroll
            for (int i = 0; i < 4; ++i) { gld16(r0a[i], Ap + (size_t)i * 32 * lda + k0); gld16(r0b[i], Bp + (size_t)i * 32 * ldb + k0); }
        }
        GEMM_COMPUTE(0);
        vm_wait_sel(r1a[0], r1a[1], r1a[2], r1a[3], r1b[0], r1b[1], r1b[2], r1b[3], __builtin_amdgcn_readfirstlane((m2 && MODE == 0) ? 0 : 1));
        if (MODE < 2)
#pragma unroll
        for (int i = 0; i < 4; ++i) { *(u32x4*)(sA + 8192 + wr_off + i * 2048) = r1a[i]; *(u32x4*)(sB + 8192 + wr_off + i * 2048) = r1b[i]; }
        __syncthreads();
        if (m3 && MODE == 0) {
            const int k0 = (kt + 3) << 6;
#pragma unroll
            for (int i = 0; i < 4; ++i) { gld16(r1a[i], Ap + (size_t)i * 32 * lda + k0); gld16(r1b[i], Bp + (size_t)i * 32 * ldb + k0); }
        }
        GEMM_COMPUTE(1);
        if (m2) {
            vm_wait_sel(r0a[0], r0a[1], r0a[2], r0a[3], r0b[0], r0b[1], r0b[2], r0b[3], __builtin_amdgcn_readfirstlane((m3 && MODE == 0) ? 0 : 1));
            if (MODE < 2)
#pragma unroll
            for (int i = 0; i < 4; ++i) { *(u32x4*)(sA + wr_off + i * 2048) = r0a[i]; *(u32x4*)(sB + wr_off + i * 2048) = r0b[i]; }
        }
        __syncthreads();
    }
#undef GEMM_COMPUTE
#undef GEMM_LDFRAG
#undef GEMM_MMA
    epi(acc, row0 + wm * 64, col0 + wn * 64);
}

DI const bf16_t* uni_ptr(const bf16_t* p) {
    const unsigned long long v = (unsigned long long)p;
    const unsigned lo = __builtin_amdgcn_readfirstlane((unsigned)v), hi = __builtin_amdgcn_readfirstlane((unsigned)(v >> 32));
    return (const bf16_t*)(((unsigned long long)hi << 32) | lo); }
DI void gld16s(u32x4& r, unsigned voff, const void* sbase) { asm volatile("global_load_dwordx4 %0, %1, %2" : "=&v"(r) : "v"(voff), "s"(sbase) : "memory"); }
DI void vm_wait12(u32x4& a, u32x4& b, u32x4& c, u32x4& d, u32x4& e, u32x4& f, u32x4& g, u32x4& h, u32x4& i, u32x4& j, u32x4& k, u32x4& l) {
    asm volatile("s_waitcnt vmcnt(0)" : "+v"(a), "+v"(b), "+v"(c), "+v"(d), "+v"(e), "+v"(f), "+v"(g), "+v"(h), "+v"(i), "+v"(j), "+v"(k), "+v"(l) : : "memory"); }

template <class Epi>
DI void gemm_tile256(const bf16_t* __restrict__ A, int lda, const bf16_t* __restrict__ Bt, int ldb, int K, int row0, int col0, char* smem, Epi&& epi) {
    bf16_t* sA = (bf16_t*)smem;
    bf16_t* sB = sA + 256 * 64;
    const int tid = TIDX(), lane = tid & 63, wave = tid >> 6;
    const int wm = wave >> 1, wn = wave & 1, l31 = lane & 31, hh = lane >> 5;
    u32x4 ra[8], rb[4];
    const bf16_t* Ab = uni_ptr(A + (size_t)row0 * lda);
    const bf16_t* Bb = uni_ptr(Bt + (size_t)col0 * ldb);
    const unsigned voa = ((unsigned)(tid >> 3) * (unsigned)lda + (tid & 7) * 8) * 2u;
    const unsigned vob = ((unsigned)(tid >> 3) * (unsigned)ldb + (tid & 7) * 8) * 2u;
    const int wr_off = (tid >> 3) * 64 + (((tid & 7) ^ ((tid >> 4) & 7)) * 8);
    f32x16 acc[4][2];
#pragma unroll
    for (int a = 0; a < 4; ++a)
#pragma unroll
        for (int b = 0; b < 2; ++b)
#pragma unroll
            for (int i = 0; i < 16; ++i) acc[a][b][i] = 0.f;
    const int nk = K >> 6;
#pragma unroll
    for (int i = 0; i < 8; ++i) gld16s(ra[i], voa, Ab + (size_t)i * 32 * lda);
#pragma unroll
    for (int i = 0; i < 4; ++i) gld16s(rb[i], vob, Bb + (size_t)i * 32 * ldb);
    const int sw = (l31 >> 1) & 7;
    const bf16_t* cA = sA + (wm * 128 + l31) * 64;
    const bf16_t* cB = sB + (wn * 64 + l31) * 64;
    for (int kt = 0; kt < nk; ++kt) {
        vm_wait12(ra[0], ra[1], ra[2], ra[3], ra[4], ra[5], ra[6], ra[7], rb[0], rb[1], rb[2], rb[3]);
#pragma unroll
        for (int i = 0; i < 8; ++i) *(u32x4*)(sA + wr_off + i * 2048) = ra[i];
#pragma unroll
        for (int i = 0; i < 4; ++i) *(u32x4*)(sB + wr_off + i * 2048) = rb[i];
        __syncthreads();
        if (kt + 1 < nk) {
            const int k0 = (kt + 1) << 6;
#pragma unroll
            for (int i = 0; i < 8; ++i) gld16s(ra[i], voa, Ab + (size_t)i * 32 * lda + k0);
#pragma unroll
            for (int i = 0; i < 4; ++i) gld16s(rb[i], vob, Bb + (size_t)i * 32 * ldb + k0);
        }
        __builtin_amdgcn_s_setprio(1);
#pragma unroll
        for (int ks = 0; ks < 4; ++ks) {
            const int ch = ((2 * ks + hh) ^ sw) * 8;
            const bf16x8 b0 = *(const bf16x8*)(cB + ch), b1 = *(const bf16x8*)(cB + 32 * 64 + ch);
#pragma unroll
            for (int mi = 0; mi < 4; ++mi) {
                const bf16x8 a = *(const bf16x8*)(cA + mi * 32 * 64 + ch);
                acc[mi][0] = MFMA32(a, b0, acc[mi][0]);
                acc[mi][1] = MFMA32(a, b1, acc[mi][1]);
            }
        }
        __builtin_amdgcn_s_setprio(0);
        __syncthreads();
    }
    epi(acc, row0 + wm * 128, col0 + wn * 64);
}

DI void transpose_store(bf16_t* dst, int K, int n0, int k0, const float* tile) {
    const int kp = TIDX() & 31, nn = TIDX() >> 5;
#pragma unroll
    for (int i = 0; i < 8; ++i) {
        const int n = nn + 8 * i;
        *(unsigned*)(dst + (size_t)(n0 + n) * K + k0 + 2 * kp) = pack2(tile[(2 * kp) * 65 + n], tile[(2 * kp + 1) * 65 + n]);
    }
}
template <class F>
DI void transpose_tile(bf16_t* dst, int K, int tn, int tk, F src, float* tile) {
    const int tx = TIDX() & 63, ty = TIDX() >> 6;
    const int n0 = tn * 64, k0 = tk * 64;
    float v[16];
#pragma unroll
    for (int i = 0; i < 16; ++i) v[i] = src(k0 + ty + 4 * i, n0 + tx);
#pragma unroll
    for (int i = 0; i < 16; ++i) tile[(ty + 4 * i) * 65 + tx] = v[i];
    __syncthreads();
    transpose_store(dst, K, n0, k0, tile);
    __syncthreads();
}
DI void poolfold_tile(bf16_t* dst, int tn, int tk, const float* wi, const float* pw, const float* ps, float* smemf) {
    float* wt = smemf;
    float* pt = smemf + 64 * 65;
    float* ot = pt + 64 * 64;
    const int tx = TIDX() & 63, ty = TIDX() >> 6;
    const int n0 = tn * 64, k0 = tk * 64, g = (n0 - IN_POOL) >> 6;
    const float sc = ps[g * 64 + tx];
#pragma unroll
    for (int i = 0; i < 16; ++i) {
        const int r = ty + 4 * i;
        wt[r * 65 + tx] = wi[(size_t)(k0 + r) * DIN + IN_POOL + g * 64 + tx];
        pt[r * 64 + tx] = pw[g * 4096 + r * 64 + tx] * sc;
    }
    __syncthreads();
    float acc[16];
#pragma unroll
    for (int i = 0; i < 16; ++i) acc[i] = 0.f;
    for (int ii = 0; ii < 64; ++ii) {
        const float pv = pt[ii * 64 + tx];
#pragma unroll
        for (int i = 0; i < 16; ++i) acc[i] += wt[(ty + 4 * i) * 65 + ii] * pv;
    }
#pragma unroll
    for (int i = 0; i < 16; ++i) ot[(ty + 4 * i) * 65 + tx] = acc[i];
    __syncthreads();
    transpose_store(dst, 1024, n0, k0, ot);
    __syncthreads();
}

PH_FN void prep_phase(const KP& p, char* smem) {
    float* tile = (float*)smem;
    bf16_t* W = (bf16_t*)(p.ws + OFF_W);
    const int NTR = 5024;
    const int n_items = 2 * NTR + 288 + 1 + 16;
    for (int it = blockIdx.x; it < n_items; it += gridDim.x) {
        if (it < 2 * NTR) {
            const int l = it / NTR; int r = it % NTR;
            bf16_t* Wl = W + (size_t)l * WL_EL;
            if (r < 2816) {
                const int f = r / 1408; r %= 1408;
                const float* g = p.in[8] + (size_t)(l * 2 + f) * D * FF;
                const float* u = p.in[9] + (size_t)(l * 2 + f) * D * FF;
                transpose_tile(Wl + (f ? WO_GU1 : WO_GU0), 1024, r / 16, r % 16, [&](int k, int n) {
                    const int j = n >> 7, w = n & 127, c = j * 64 + (w >> 6) * 32 + (w & 31);
                    return ((w >> 5) & 1) ? u[(size_t)k * FF + c] : g[(size_t)k * FF + c]; }, tile);
            } else if (r < 2816 + 1408) {
                r -= 2816; const int f = r / 704; r %= 704;
                const float* dn = p.in[10] + (size_t)(l * 2 + f) * FF * D;
                transpose_tile(Wl + (f ? WO_D1 : WO_D0), 2816, r / 44, r % 44, [&](int k, int n) { return dn[(size_t)k * D + n]; }, tile);
            } else if (r < 4224 + 384) {
                r -= 4224;
                const float* wi = p.in[11] + (size_t)l * D * DIN;
                const float* pw = p.in[27] + (size_t)l * 4 * 64 * 64;
                const float* ps = p.in[28] + (size_t)l * 256;
                const int tn = r / 16, tk = r % 16;
                if (tn >= IN_POOL / 64 && tn < IN_CQ / 64) poolfold_tile(Wl + WO_IN, tn, tk, wi, pw, ps, tile);
                else transpose_tile(Wl + WO_IN, 1024, tn, tk, [&](int k, int n) { return n < DIN ? wi[(size_t)k * DIN + n] : 0.f; }, tile);
            } else if (r < 4608 + 320) {
                r -= 4608;
                const float* wo = p.in[12] + (size_t)l * DMIX * D;
                transpose_tile(Wl + WO_OUT, 1280, r / 20, r % 20, [&](int k, int n) { return wo[(size_t)k * D + n]; }, tile);
            } else if (r < 4928 + 48) {
                r -= 4928;
                const float* wq = p.in[30] + (size_t)l * 256 * 768;
                const float* gn = p.in[29] + (size_t)l * 256;
                transpose_tile(Wl + WO_UQ, 256, r / 4, r % 4, [&](int k, int n) { return wq[(size_t)k * 768 + n] * gn[k] * QSCALE; }, tile);
            } else if (r < 4976 + 32) {
                r -= 4976;
                const float* wk = p.in[32] + (size_t)l * 128 * 1024;
                const float* gn = p.in[31] + (size_t)l * 128;
                transpose_tile(Wl + WO_UKV, 128, r / 2, r % 2, [&](int k, int n) { return wk[(size_t)k * 1024 + n] * gn[k]; }, tile);
            } else {
                r -= 5008;
                const float* wg = p.in[21] + (size_t)l * 256 * 256;
                transpose_tile(Wl + WO_GLU, 256, r / 4, r % 4, [&](int k, int n) { return wg[(size_t)k * 256 + n]; }, tile);
            }
        } else if (it < 2 * NTR + 288) {
            const int r = it - 2 * NTR, l = r / 144, n0 = (r % 144) * 64;
            float* sc = (float*)smem;
            float* red = sc + 3072;
            for (int i = TIDX(); i < 3072; i += 256) {
                const int v = i >> 10, k = i & 1023;
                const float cv = v < 2 ? p.in[1][v * 1024 + k] : p.in[3][k];
                sc[i] = cv / (1.f + expf(-cv));
            }
            __syncthreads();
            const int tx = TIDX() & 63, ty = TIDX() >> 6;
            const float* wa = p.in[4] + (size_t)l * D * 9216 + n0 + tx;
            float a0 = 0.f, a1 = 0.f, a2 = 0.f;
#pragma unroll 32
            for (int k = ty * 256; k < ty * 256 + 256; ++k) {
                const float w = wa[(size_t)k * 9216];
                a0 += sc[k] * w; a1 += sc[1024 + k] * w; a2 += sc[2048 + k] * w;
            }
            red[(ty * 3 + 0) * 64 + tx] = a0; red[(ty * 3 + 1) * 64 + tx] = a1; red[(ty * 3 + 2) * 64 + tx] = a2;
            __syncthreads();
            if (TIDX() < 192) {
                const int v = TIDX() >> 6;
                float s = p.in[5][l * 9216 + n0 + tx];
                for (int q = 0; q < 4; ++q) s += red[(q * 3 + v) * 64 + tx];
                ((float*)(p.ws + OFF_MOD))[(size_t)(l * 3 + v) * 9216 + n0 + tx] = s;
            }
            __syncthreads();
        } else if (it == 2 * NTR + 288) {
            float* tab = (float*)(p.ws + OFF_ROPE);
            const int pos = TIDX();
            for (int i = 0; i < 8; ++i) {
                const float inv = powf(10000.f, -(float)(2 * i) / 16.f);
                const float ang = (float)pos * inv;
                tab[(pos * 8 + i) * 2 + 0] = cosf(ang);
                tab[(pos * 8 + i) * 2 + 1] = sinf(ang);
            }
        } else {
            const int idx = (it - (2 * NTR + 289)) * 256 + TIDX();
            const int pp = idx & 63, g = (idx >> 6) & 15, ld = idx >> 10;
            float lr = fminf(p.in[13][idx], -1e-4f), li = p.in[14][idx];
            const float dt = expf(p.in[15][ld * 16 + g]);
            const float mag = expf(lr * dt);
            const float br = mag * cosf(li * dt), bi = mag * sinf(li * dt);
            float tr = br, ti = bi;
            for (int q = 0; q < 6; ++q) { const float nr = tr * tr - ti * ti, ni = 2.f * tr * ti; tr = nr; ti = ni; }
            ((float4*)(p.ws + OFF_LAMB))[idx] = make_float4(br, bi, tr, ti);
            const float nr = br - 1.f, ni = bi, den = 1.f / (lr * lr + li * li);
            const float cr = (nr * lr + ni * li) * den, ci = (ni * lr - nr * li) * den;
            float* bb = (float*)(p.ws + OFF_BBAR) + (size_t)idx * 32;
            const float* sbr = p.in[16] + (size_t)idx * 16; const float* sbi = p.in[17] + (size_t)idx * 16;
            for (int h = 0; h < 16; ++h) { const float xr = sbr[h], xi = sbi[h]; bb[2 * h] = cr * xr - ci * xi; bb[2 * h + 1] = cr * xi + ci * xr; }
            bf16_t* cc = (bf16_t*)(p.ws + OFF_CC) + (size_t)(ld * 16 + g) * 2048;
            const float* scr = p.in[18] + (size_t)(ld * 16 + g) * 1024; const float* sci = p.in[19] + (size_t)(ld * 16 + g) * 1024;
            for (int h = 0; h < 16; ++h) { cc[h * 128 + pp] = f2bf(scr[h * 64 + pp]); cc[h * 128 + 64 + pp] = f2bf(-sci[h * 64 + pp]); }
        }
    }
}

PH_FN void rowop_phase(const KP& p, int l_mod_post, int gate_idx, float coef, const float* gpost, bool has_y,
                    int l_mod_pre, int shift_idx, const float* gpre, bool has_pre, bool first, int nrows = NT) {
    const int lane = TIDX() & 63;
    const int wid = blockIdx.x * 4 + (TIDX() >> 6), nw = gridDim.x * 4;
    bf16_t* HY = (bf16_t*)(p.ws + OFF_HY);
    float* Xc = (float*)(p.ws + OFF_XC);
    const float* MOD = (const float*)(p.ws + OFF_MOD);
    f4_t wpost[4], wpre[4], vg[4], vs0[4], vs1[4];
#pragma unroll
    for (int i = 0; i < 4; ++i) {
        wpost[i] = has_y ? *(const f4_t*)(gpost + lane * 4 + 256 * i) : f4_t{0.f, 0.f, 0.f, 0.f};
        wpre[i] = has_pre ? *(const f4_t*)(gpre + lane * 4 + 256 * i) : f4_t{0.f, 0.f, 0.f, 0.f};
        vg[i] = vs0[i] = vs1[i] = f4_t{0.f, 0.f, 0.f, 0.f};
    }
    int cur_mv = -1;
    for (int row0 = wid; row0 < nrows; row0 += 2 * nw) {
        int rows[2]; bool ok[2];
        rows[0] = row0; ok[0] = true;
        ok[1] = (row0 + nw) < nrows; rows[1] = ok[1] ? row0 + nw : row0;
        float* xp[2]; int mv[2];
        f4_t x[2][4], y[2][4];
        float ssy[2] = {0.f, 0.f};
#pragma unroll
        for (int q = 0; q < 2; ++q) {
            const int row = rows[q];
            mv[q] = row_mod(row);
            xp[q] = row < NL ? p.out + (size_t)row * D : Xc + (size_t)(row - NL) * D;
            const float* xin = first ? (row < NL ? p.in[0] + (size_t)row * D : p.in[2] + (size_t)(row - NL) * D) : xp[q];
#pragma unroll
            for (int i = 0; i < 4; ++i) x[q][i] = __builtin_nontemporal_load((const f4_t*)(xin + lane * 4 + 256 * i));
            if (has_y) {
#pragma unroll
                for (int i = 0; i < 4; ++i) {
                    const u2_t raw = __builtin_nontemporal_load((const u2_t*)(HY + (size_t)row * D + lane * 4 + 256 * i));
                    y[q][i].x = __uint_as_float(raw.x << 16); y[q][i].y = __uint_as_float(raw.x & 0xffff0000u);
                    y[q][i].z = __uint_as_float(raw.y << 16); y[q][i].w = __uint_as_float(raw.y & 0xffff0000u);
                    ssy[q] += y[q][i].x * y[q][i].x + y[q][i].y * y[q][i].y + y[q][i].z * y[q][i].z + y[q][i].w * y[q][i].w;
                }
            }
        }
        if (has_y) {
            for (int m = 32; m >= 1; m >>= 1) { ssy[0] += shflx(ssy[0], m); ssy[1] += shflx(ssy[1], m); }
        }
        float ssx[2] = {0.f, 0.f};
        f4_t hv[2][4];
#pragma unroll
        for (int qq = 0; qq < 2; ++qq) {
            const int q = 1 - qq;
            if (mv[q] != cur_mv) {
                cur_mv = mv[q];
#pragma unroll
                for (int i = 0; i < 4; ++i) {
                    if (has_y) vg[i] = *(const f4_t*)(MOD + (size_t)(l_mod_post * 3 + cur_mv) * 9216 + gate_idx * 1024 + lane * 4 + 256 * i);
                    if (has_pre) {
                        const float* sh = MOD + (size_t)(l_mod_pre * 3 + cur_mv) * 9216 + shift_idx * 1024 + lane * 4 + 256 * i;
                        vs0[i] = *(const f4_t*)sh; vs1[i] = *(const f4_t*)(sh + 1024);
                    }
                }
            }
            if (has_y) {
                const float rstd = rsqrtf(ssy[q] * (1.f / D) + EPS);
#pragma unroll
                for (int i = 0; i < 4; ++i) x[q][i] += coef * vg[i] * (y[q][i] * rstd * wpost[i]);
                if (ok[q]) {
#pragma unroll
                    for (int i = 0; i < 4; ++i) __builtin_nontemporal_store(x[q][i], (f4_t*)(xp[q] + lane * 4 + 256 * i));
                }
            }
            if (has_pre) {
#pragma unroll
                for (int i = 0; i < 4; ++i) {
                    ssx[q] += x[q][i].x * x[q][i].x + x[q][i].y * x[q][i].y + x[q][i].z * x[q][i].z + x[q][i].w * x[q][i].w;
                    hv[q][i] = x[q][i] * wpre[i] * (1.f + vs1[i]);
                    y[q][i] = vs0[i];
                }
            }
        }
        if (has_pre) {
            for (int m = 32; m >= 1; m >>= 1) { ssx[0] += shflx(ssx[0], m); ssx[1] += shflx(ssx[1], m); }
#pragma unroll
            for (int q = 0; q < 2; ++q) {
                const float rstd = rsqrtf(ssx[q] * (1.f / D) + EPS);
                if (ok[q]) {
#pragma unroll
                    for (int i = 0; i < 4; ++i) {
                        const f4_t h = hv[q][i] * rstd + y[q][i];
                        uint2 o; o.x = pack2(h.x, h.y); o.y = pack2(h.z, h.w);
                        *(uint2*)(HY + (size_t)rows[q] * D + lane * 4 + 256 * i) = o;
                    }
                }
            }
        }
    }
}

template <int MODE = 0>
PH_FN void gemm1_phase(const KP& p, int l, int f, char* smem, int ntm = NT / 256) {
    const bf16_t* H = (const bf16_t*)(p.ws + OFF_HY);
    const bf16_t* W = (const bf16_t*)(p.ws + OFF_W) + (size_t)l * WL_EL + (f ? WO_GU1 : WO_GU0);
    bf16_t* ACT = (bf16_t*)(p.ws + OFF_ACT);
    const int lane = TIDX() & 63, l31 = lane & 31, hh = lane >> 5;
    const int n_items = (NL / 256) * 44;
    const int n_ctx = ntm > NL / 256 ? (NC / 128) * 44 : 0;
    for (int it = vblock(); it < n_ctx; it += gridDim.x) {
        const int mt = it / 44, nt = it - mt * 44;
        gemm_tile(H, D, W, D, D, NL + mt * 128, nt * 128, smem, [&](f32x16 (&acc)[2][2], int r0, int c0) {
            const int col = (c0 >> 7) * 64 + ((c0 >> 6) & 1) * 32 + l31;
#pragma unroll
            for (int mi = 0; mi < 2; ++mi)
#pragma unroll
                for (int i = 0; i < 16; ++i) ACT[(size_t)(r0 + 32 * mi + crow(i, hh)) * FF + col] = f2bf(siluf_(acc[mi][0][i]) * acc[mi][1][i]);
        });
    }
    for (int it = vblock(); it < n_items; it += gridDim.x) {
        int mt, nt; tile_mn(it, NL / 256, 44, mt, nt);
        gemm_tile256(H, D, W, D, D, mt * 256, nt * 128, smem, [&](f32x16 (&acc)[4][2], int r0, int c0) {
            const int col = (c0 >> 7) * 64 + ((c0 >> 6) & 1) * 32 + l31;
#pragma unroll
            for (int mi = 0; mi < 4; ++mi)
#pragma unroll
                for (int i = 0; i < 16; ++i) {
                    const int row = r0 + 32 * mi + crow(i, hh);
                    ACT[(size_t)row * FF + col] = f2bf(siluf_(acc[mi][0][i]) * acc[mi][1][i]);
                }
        });
    }
}

template <int MODE = 0>
PH_FN void gemm_store_phase(const bf16_t* A, int lda, const bf16_t* W, int K, int ntn, bf16_t* C, int ldc, int ncols, char* smem, int ntm = NT / 128) {
    const int lane = TIDX() & 63, l31 = lane & 31, hh = lane >> 5;
    const int n_items = ntm * ntn;
    for (int it = vblock(); it < n_items; it += gridDim.x) {
        int mt, nt; tile_mn(it, ntm, ntn, mt, nt);
        gemm_tile<MODE>(A, lda, W, K, K, mt * 128, nt * 128, smem, [&](f32x16 (&acc)[2][2], int r0, int c0) {
            if (MODE != 0 && acc[0][0][0] != 123456.789f) return;
#pragma unroll
            for (int ni = 0; ni < 2; ++ni) {
                const int col = c0 + 32 * ni + l31;
                if (col < ncols) {
#pragma unroll
                    for (int mi = 0; mi < 2; ++mi)
#pragma unroll
                        for (int i = 0; i < 16; ++i) C[(size_t)(r0 + 32 * mi + crow(i, hh)) * ldc + col] = f2bf(acc[mi][ni][i]);
                }
            }
        });
    }
}

template <int LDC>
PH_FN void gemm_store_phase256(const bf16_t* A, int lda, const bf16_t* W, int K, int ntn, bf16_t* C, char* smem, int ntm, int nctx128) {
    const int lane = TIDX() & 63, l31 = lane & 31, hh = lane >> 5;
    const int n_items = ntm * ntn;
    for (int it = vblock(); it < nctx128 * ntn; it += gridDim.x) {
        const int mt = it / ntn, nt = it - mt * ntn;
        gemm_tile(A, lda, W, K, K, NL + mt * 128, nt * 128, smem, [&](f32x16 (&acc)[2][2], int r0, int c0) {
#pragma unroll
            for (int mi = 0; mi < 2; ++mi) {
                bf16_t* cp = C + (size_t)(r0 + 32 * mi + 4 * hh) * LDC + c0 + l31;
#pragma unroll
                for (int ni = 0; ni < 2; ++ni)
#pragma unroll
                    for (int i = 0; i < 16; ++i) if (LDC == D || c0 + l31 + 32 * ni < LDC) cp[((i & 3) + 8 * (i >> 2)) * LDC + 32 * ni] = f2bf(acc[mi][ni][i]);
            }
        });
    }
    for (int it = vblock(); it < n_items; it += gridDim.x) {
        int mt, nt; tile_mn(it, ntm, ntn, mt, nt);
        gemm_tile256(A, lda, W, K, K, mt * 256, nt * 128, smem, [&](f32x16 (&acc)[4][2], int r0, int c0) {
#pragma unroll
            for (int mi = 0; mi < 4; ++mi) {
                bf16_t* cp = C + (size_t)(r0 + 32 * mi + 4 * hh) * LDC + c0 + l31;
#pragma unroll
                for (int ni = 0; ni < 2; ++ni)
#pragma unroll
                    for (int i = 0; i < 16; ++i) if (LDC == D || c0 + l31 + 32 * ni < LDC) cp[((i & 3) + 8 * (i >> 2)) * LDC + 32 * ni] = f2bf(acc[mi][ni][i]);
                __builtin_amdgcn_sched_barrier(0);
            }
        });
    }
}

PH_FN void glu_phase(const KP& p, int l, char* smem) {
    const bf16_t* S5P = (const bf16_t*)(p.ws + OFF_S5P);
    const bf16_t* W = (const bf16_t*)(p.ws + OFF_W) + (size_t)l * WL_EL + WO_GLU;
    bf16_t* MIX = (bf16_t*)(p.ws + OFF_MIX);
    const float* bg = p.in[22] + l * 256;
    const int lane = TIDX() & 63, l31 = lane & 31, hh = lane >> 5;
    const int n_items = (NT / 128) * 2;
    for (int it = vblock(); it < n_items; it += gridDim.x) {
        const int mt = it >> 1, nt = it & 1;
        gemm_tile(S5P, 256, W, 256, 256, mt * 128, nt * 128, smem, [&](f32x16 (&acc)[2][2], int r0, int c0) {
#pragma unroll
            for (int ni = 0; ni < 2; ++ni) {
                const int col = c0 + 32 * ni + l31;
                const float b = bg[col];
#pragma unroll
                for (int mi = 0; mi < 2; ++mi)
#pragma unroll
                    for (int i = 0; i < 16; ++i) {
                        const int row = r0 + 32 * mi + crow(i, hh);
                        const float y = bf2f(S5P[(size_t)row * 256 + col]);
                        MIX[(size_t)row * DMIX + col] = f2bf(y * sigmoidf_(acc[mi][ni][i] + b));
                        if ((i & 3) == 3) __builtin_amdgcn_sched_barrier(0);
                    }
            }
        });
    }
}

DI void key_pos(int row, int& b, int& pos) {
    if (row < NL) { b = row >= SEQ ? 1 : 0; pos = row - b * SEQ; }
    else { const int r = row - NL; b = r >> 8; pos = SEQ + (r & 255); }
}

DI void qkv_item(const KP& p, int l, int it, char* smem) {
    const bf16_t* Z = (const bf16_t*)(p.ws + OFF_Z);
    const bf16_t* Wl = (const bf16_t*)(p.ws + OFF_W) + (size_t)l * WL_EL;
    bf16_t* Q = (bf16_t*)(p.ws + OFF_Q);
    bf16_t* Kb = (bf16_t*)(p.ws + OFF_K);
    bf16_t* Vt = (bf16_t*)(p.ws + OFF_VT);
    const float* tab = (const float*)(p.ws + OFF_ROPE);
    const int mt = it / 14, sub = it % 14, row0 = mt * 128;
    const int tid = TIDX(), lane = tid & 63, l31 = lane & 31, hh = lane >> 5;
    __shared__ float s_rs[128];
    {
        const int r = tid >> 1, half = tid & 1;
        const bool isq = sub < 6;
        const int n = isq ? 128 : 64;
        const bf16_t* src = Z + (size_t)(row0 + r) * DIN + (isq ? IN_CQ : IN_CKV) + half * n;
        float ss = 0.f;
        auto sq8 = [&](const u32x4& v) {
#pragma unroll
            for (int q = 0; q < 4; ++q) { const float a = __uint_as_float(v[q] << 16), b = __uint_as_float(v[q] & 0xffff0000u); ss += a * a + b * b; }
        };
        if (isq) {
            u32x4 v[16];
#pragma unroll
            for (int i = 0; i < 16; ++i) v[i] = *(const u32x4*)(src + 8 * i);
#pragma unroll
            for (int i = 0; i < 16; ++i) sq8(v[i]);
        } else {
            u32x4 v[8];
#pragma unroll
            for (int i = 0; i < 8; ++i) v[i] = *(const u32x4*)(src + 8 * i);
#pragma unroll
            for (int i = 0; i < 8; ++i) sq8(v[i]);
        }
        ss += shflx(ss, 1);
        if (half == 0) s_rs[r] = rsqrtf(ss / (float)(2 * n) + EPS);
    }
    __syncthreads();
    if (sub < 6) {
        gemm_tile(Z + IN_CQ, DIN, Wl + WO_UQ, 256, 256, row0, sub * 128, smem, [&](f32x16 (&acc)[2][2], int r0, int c0) {
#pragma unroll
            for (int ni = 0; ni < 2; ++ni) {
                const int cb = c0 + 32 * ni, col = cb + l31;
                const bool is_rope = ((cb >> 5) % 3) == 2;
                const int axis = l31 >> 4, second = (l31 >> 3) & 1, fi = l31 & 7;
#pragma unroll
                for (int mi = 0; mi < 2; ++mi)
#pragma unroll
                    for (int i = 0; i < 16; ++i) {
                        const int row = r0 + 32 * mi + crow(i, hh);
                        float v = acc[mi][ni][i] * s_rs[row - row0];
                        if (is_rope) {
                            const float pr = shflx(v, 8);
                            if (row < NL) {
                                const int t = row & (SEQ - 1);
                                const int pos = axis ? (t & 63) : (t >> 6);
                                const float cs = tab[(pos * 8 + fi) * 2], sn = tab[(pos * 8 + fi) * 2 + 1];
                                v = second ? (v * cs + pr * sn) : (v * cs - pr * sn);
                            }
                        }
                        Q[(size_t)row * 768 + col] = f2bf(v);
                        if ((i & 3) == 3) __builtin_amdgcn_sched_barrier(0);
                    }
            }
        });
    } else {
        const int head = sub - 6;
        gemm_tile(Z + IN_CKV, DIN, Wl + WO_UKV, 128, 128, row0, head * 128, smem, [&](f32x16 (&acc)[2][2], int r0, int c0) {
            const bool isv = (c0 >> 6) & 1;
#pragma unroll
            for (int ni = 0; ni < 2; ++ni) {
                const int dcol = 32 * ni + l31;
#pragma unroll
                for (int mi = 0; mi < 2; ++mi)
#pragma unroll
                    for (int q = 0; q < 4; ++q) {
                        const int rowb = r0 + 32 * mi + 8 * q + 4 * hh;
                        int b, pos; key_pos(rowb, b, pos);
                        float v[4];
#pragma unroll
                        for (int j = 0; j < 4; ++j) v[j] = acc[mi][ni][4 * q + j] * s_rs[rowb + j - row0];
                        if (isv) {
                            uint2 o; o.x = pack2(v[0], v[1]); o.y = pack2(v[2], v[3]);
                            *(uint2*)(Vt + ((size_t)(b * NH + head) * 64 + dcol) * LK + ((pos & ~12) | ((pos & 4) << 1) | ((pos & 8) >> 1))) = o;
                        } else {
#pragma unroll
                            for (int j = 0; j < 4; ++j) Kb[((size_t)(b * NH + head) * LK + pos + j) * DK + dcol] = f2bf(v[j]);
                        }
                    }
            }
        });
        for (int e = tid; e < 128 * 32; e += 256) {
            const int r = e >> 5, d = e & 31, row = row0 + r;
            const bf16_t* kr = Z + (size_t)row * DIN + IN_KR;
            float v = bf2f(kr[d]);
            if (row < NL) {
                const float pr = bf2f(kr[d ^ 8]);
                const int t = row & (SEQ - 1), axis = d >> 4, second = (d >> 3) & 1, fi = d & 7;
                const int pos = axis ? (t & 63) : (t >> 6);
                const float cs = tab[(pos * 8 + fi) * 2], sn = tab[(pos * 8 + fi) * 2 + 1];
                v = second ? (v * cs + pr * sn) : (v * cs - pr * sn);
            }
            int b, pos; key_pos(row, b, pos);
            Kb[((size_t)(b * NH + head) * LK + pos) * DK + 64 + d] = f2bf(v);
        }
    }
    __syncthreads();
}

DI void convpool_item(const KP& p, int l, int it, char* smem) {
    const bf16_t* Z = (const bf16_t*)(p.ws + OFF_Z);
    bf16_t* MIX = (bf16_t*)(p.ws + OFF_MIX);
    float* hs = (float*)smem;
    int L, rowbase, t0;
    if (it < 1024) { L = SEQ; rowbase = (it >> 9) * SEQ; t0 = (it & 511) * 32; }
    else { const int r = it - 1024; L = CTXL; rowbase = NL + (r >> 3) * CTXL; t0 = (r & 7) * 32; }
    const int c = TIDX(), lane = c & 63, wave = c >> 6;
    {
        const int c4 = (c & 63) * 4, ts = c >> 6;
#pragma unroll 4
        for (int j = ts; j < 62; j += 4) {
            const int t = t0 - 15 + j;
            float4 h = make_float4(0.f, 0.f, 0.f, 0.f);
            if (t >= 0 && t < L) {
                const bf16_t* zr = Z + (size_t)(rowbase + t) * DIN + IN_CONV + c4;
                const uint2 v = *(const uint2*)zr, g = *(const uint2*)(zr + 256);
                h.x = __uint_as_float(v.x << 16) * sigmoidf_(__uint_as_float(g.x << 16));
                h.y = __uint_as_float(v.x & 0xffff0000u) * sigmoidf_(__uint_as_float(g.x & 0xffff0000u));
                h.z = __uint_as_float(v.y << 16) * sigmoidf_(__uint_as_float(g.y << 16));
                h.w = __uint_as_float(v.y & 0xffff0000u) * sigmoidf_(__uint_as_float(g.y & 0xffff0000u));
            }
            *(float4*)(hs + j * 256 + c4) = h;
        }
    }
    __syncthreads();
    float w[31];
#pragma unroll
    for (int k = 0; k < 31; ++k) w[k] = p.in[23][(size_t)(l * 31 + k) * 256 + c];
    const float cb = p.in[24][l * 256 + c];
#pragma unroll 1
    for (int tt = 0; tt < 32; ++tt) {
        float s = cb;
#pragma unroll
        for (int k = 0; k < 31; ++k) s += w[k] * hs[(tt + k) * 256 + c];
        hs[tt * 256 + c] = s;
    }
    __syncthreads();
    {
        const float4 lg = *(const float4*)(p.in[25] + l * 256 + lane * 4);
        const float4 lb = *(const float4*)(p.in[26] + l * 256 + lane * 4);
#pragma unroll 1
        for (int q = 0; q < 8; ++q) {
            const int tt = wave * 8 + q;
            const float4 v = *(const float4*)(hs + tt * 256 + lane * 4);
            const float mean = wave_sum(v.x + v.y + v.z + v.w) * (1.f / 256.f);
            const float d0 = v.x - mean, d1 = v.y - mean, d2 = v.z - mean, d3 = v.w - mean;
            const float var = wave_sum(d0 * d0 + d1 * d1 + d2 * d2 + d3 * d3) * (1.f / 256.f);
            const float rstd = rsqrtf(var + EPS);
            uint2 o;
            o.x = pack2(siluf_(d0 * rstd * lg.x + lb.x), siluf_(d1 * rstd * lg.y + lb.y));
            o.y = pack2(siluf_(d2 * rstd * lg.z + lb.z), siluf_(d3 * rstd * lg.w + lb.w));
            *(uint2*)(MIX + (size_t)(rowbase + t0 + tt) * DMIX + 256 + lane * 4) = o;
        }
    }
    __syncthreads();
    {
        const int c4 = (c & 63) * 4, ts = c >> 6;
#pragma unroll 4
        for (int j = ts; j < 47; j += 4) {
            const int t = t0 - 7 + j;
            float4 h = make_float4(0.f, 0.f, 0.f, 0.f);
            if (t >= 0 && t < L) {
                const uint2 v = *(const uint2*)(Z + (size_t)(rowbase + t) * DIN + IN_POOL + c4);
                h.x = __uint_as_float(v.x << 16); h.y = __uint_as_float(v.x & 0xffff0000u); h.z = __uint_as_float(v.y << 16); h.w = __uint_as_float(v.y & 0xffff0000u);
            }
            *(float4*)(hs + j * 256 + c4) = h;
        }
    }
    __syncthreads();
    {
        const int win = 2 << (c >> 6), wa = (win - 1) >> 1, wb = win >> 1;
#pragma unroll 1
        for (int tt = 0; tt < 32; ++tt) {
            const int t = t0 + tt;
            const int lo = max(t - wa, 0), hi = min(t + wb, L - 1);
            float s = 0.f;
            for (int q = lo; q <= hi; ++q) s += hs[(q - t0 + 7) * 256 + c];
            const float o = s / (float)(hi - lo + 1) - hs[(tt + 7) * 256 + c];
            MIX[(size_t)(rowbase + t) * DMIX + 512 + c] = f2bf(o);
        }
    }
    __syncthreads();
}

DI int chunk_row(int b, int k) { return k < 4 ? NL + b * CTXL + 64 * k : b * SEQ + 64 * (k - 4); }

template <bool FINAL>
DI void s5_item(const KP& p, int l, int it, char* smem) {
    const int g4 = it & 3, k = (it >> 2) % NCHUNK, b = (it >> 2) / NCHUNK;
    const int tid = TIDX(), lane = tid & 63, wave = tid >> 6, g = g4 * 4 + wave;
    const bf16_t* Z = (const bf16_t*)(p.ws + OFF_Z);
    float* Us = (float*)smem + wave * 1024;
    bf16_t* Hs = (bf16_t*)(smem + 16384) + wave * (16 * 136);
    const int rbase = chunk_row(b, k);
    {
        const uint4* src = (const uint4*)(Z + (size_t)(rbase + lane) * DIN + g * 16);
        const uint4 v0 = src[0], v1 = src[1];
        const unsigned w[8] = {v0.x, v0.y, v0.z, v0.w, v1.x, v1.y, v1.z, v1.w};
#pragma unroll
        for (int q = 0; q < 8; ++q) { Us[lane * 16 + 2 * q] = __uint_as_float(w[q] << 16); Us[lane * 16 + 2 * q + 1] = __uint_as_float(w[q] & 0xffff0000u); }
    }
    __syncthreads();
    f32x4 yacc[4];
#pragma unroll
    for (int s = 0; s < 4; ++s) yacc[s] = f32x4{0.f, 0.f, 0.f, 0.f};
#pragma unroll
    for (int dir = 0; dir < 2; ++dir) {
        const int pidx = ((l * 2 + dir) * 16 + g) * 64 + lane;
        const float4 lam = ((const float4*)(p.ws + OFF_LAMB))[pidx];
        float br[16], bi[16];
        {
            const float4* bb = (const float4*)((const float*)(p.ws + OFF_BBAR) + (size_t)pidx * 32);
#pragma unroll
            for (int q = 0; q < 8; ++q) { const float4 v = bb[q]; br[2 * q] = v.x; bi[2 * q] = v.y; br[2 * q + 1] = v.z; bi[2 * q + 1] = v.w; }
        }
        const size_t sidx = ((size_t)((b * 2 + dir) * NCHUNK + k) * 16 + g) * 64 + lane;
        float hr = 0.f, hi = 0.f;
        bf16x8 cfr[4];
        if (FINAL) {
            const float2 s0 = ((const float2*)(p.ws + OFF_S))[sidx];
            hr = s0.x; hi = s0.y;
            const bf16_t* cc = (const bf16_t*)(p.ws + OFF_CC) + (size_t)((l * 2 + dir) * 16 + g) * 2048 + (lane & 15) * 128 + (lane >> 4) * 8;
#pragma unroll
            for (int ks = 0; ks < 4; ++ks) cfr[ks] = *(const bf16x8*)(cc + 32 * ks);
        }
#pragma unroll
        for (int s = 0; s < 4; ++s) {
            const int sb = dir ? 3 - s : s;
#pragma unroll 1
            for (int tt = 0; tt < 16; ++tt) {
                const int tl = dir ? 15 - tt : tt, t = sb * 16 + tl;
                const float4* up = (const float4*)(Us + t * 16);
                float ar = 0.f, ai = 0.f;
#pragma unroll
                for (int q = 0; q < 4; ++q) {
                    const float4 u = up[q];
                    ar += br[4 * q] * u.x + br[4 * q + 1] * u.y + br[4 * q + 2] * u.z + br[4 * q + 3] * u.w;
                    ai += bi[4 * q] * u.x + bi[4 * q + 1] * u.y + bi[4 * q + 2] * u.z + bi[4 * q + 3] * u.w;
                }
                const float nr = lam.x * hr - lam.y * hi + ar, ni = lam.x * hi + lam.y * hr + ai;
                hr = nr; hi = ni;
                if (FINAL) { Hs[tl * 136 + lane] = f2bf(hr); Hs[tl * 136 + 64 + lane] = f2bf(hi); }
            }
            if (FINAL) {
                __syncthreads();
                const bf16_t* hp = Hs + (lane & 15) * 136 + (lane >> 4) * 8;
#pragma unroll
                for (int ks = 0; ks < 4; ++ks) { const bf16x8 a = *(const bf16x8*)(hp + 32 * ks); yacc[sb] = MFMA16(a, cfr[ks], yacc[sb]); }
                __syncthreads();
            }
        }
        if (!FINAL) ((float2*)(p.ws + OFF_E))[sidx] = make_float2(hr, hi);
    }
    if (FINAL) {
        bf16_t* S5P = (bf16_t*)(p.ws + OFF_S5P);
        const int hcol = lane & 15;
        const float dg = p.in[20][l * 256 + g * 16 + hcol];
#pragma unroll
        for (int s = 0; s < 4; ++s)
#pragma unroll
            for (int j = 0; j < 4; ++j) {
                const int t = s * 16 + (lane >> 4) * 4 + j;
                const float y = yacc[s][j] + dg * Us[t * 16 + hcol];
                S5P[(size_t)(rbase + t) * 256 + g * 16 + hcol] = f2bf(gelu_tanh(y));
            }
    }
    __syncthreads();
}

DI void s5_carry(const KP& p, int l, int blk) {
    const int idx = blk * 256 + TIDX();
    const int gp = idx & 1023, dir = (idx >> 10) & 1, b = idx >> 11;
    const float4 lam = ((const float4*)(p.ws + OFF_LAMB))[(l * 2 + dir) * 1024 + gp];
    const float2* E = (const float2*)(p.ws + OFF_E) + (size_t)(b * 2 + dir) * NCHUNK * 1024 + gp;
    float2* S = (float2*)(p.ws + OFF_S) + (size_t)(b * 2 + dir) * NCHUNK * 1024 + gp;
    float sr = 0.f, si = 0.f;
    for (int j0 = 0; j0 < NCHUNK; j0 += 4) {
        const int k0 = dir ? (j0 < 4 ? 3 - j0 : 263 - j0) : j0, stp = dir ? -1 : 1;
        const float2 e0 = E[(size_t)k0 * 1024], e1 = E[(size_t)(k0 + stp) * 1024], e2 = E[(size_t)(k0 + 2 * stp) * 1024], e3 = E[(size_t)(k0 + 3 * stp) * 1024];
        float nr, ni;
        S[(size_t)k0 * 1024] = make_float2(sr, si);
        nr = lam.z * sr - lam.w * si + e0.x; ni = lam.z * si + lam.w * sr + e0.y; sr = nr; si = ni;
        S[(size_t)(k0 + stp) * 1024] = make_float2(sr, si);
        nr = lam.z * sr - lam.w * si + e1.x; ni = lam.z * si + lam.w * sr + e1.y; sr = nr; si = ni;
        S[(size_t)(k0 + 2 * stp) * 1024] = make_float2(sr, si);
        nr = lam.z * sr - lam.w * si + e2.x; ni = lam.z * si + lam.w * sr + e2.y; sr = nr; si = ni;
        S[(size_t)(k0 + 3 * stp) * 1024] = make_float2(sr, si);
        nr = lam.z * sr - lam.w * si + e3.x; ni = lam.z * si + lam.w * sr + e3.y; sr = nr; si = ni;
    }
}

DI void attn_item(const KP& p, int it, char* smem) {
    const bf16_t* Q = (const bf16_t*)(p.ws + OFF_Q);
    const bf16_t* Kg = (const bf16_t*)(p.ws + OFF_K);
    const bf16_t* Vg = (const bf16_t*)(p.ws + OFF_VT);
    bf16_t* MIX = (bf16_t*)(p.ws + OFF_MIX);
    const int tid = TIDX(), lane = tid & 63, wave = tid >> 6, l31 = lane & 31, hh = lane >> 5;
    int bh, qrow0, kt0, T;
    if (it < 1024) { bh = it >> 6; qrow0 = (bh >> 3) * SEQ + (it & 63) * 256; kt0 = 0; T = NCHUNK; }
    else { bh = it - 1024; qrow0 = NL + (bh >> 3) * CTXL; kt0 = SEQ / 64; T = CTXL / 64; }
    const int head = bh & 7;
    const bf16_t* Kb = Kg + (size_t)bh * LK * DK + (size_t)kt0 * 64 * DK;
    const bf16_t* Vb = Vg + (size_t)bh * 64 * LK + kt0 * 64;
    bf16_t* sK = (bf16_t*)smem;
    bf16_t* sV = sK + 2 * 64 * 104;
    const int qrow = qrow0 + wave * 64 + l31;
    bf16x8 qf[2][6];
#pragma unroll
    for (int qb = 0; qb < 2; ++qb)
#pragma unroll
        for (int s = 0; s < 6; ++s) qf[qb][s] = *(const bf16x8*)(Q + (size_t)(qrow + 32 * qb) * 768 + head * 96 + 16 * s + 8 * hh);
    f32x16 o[2][2];
#pragma unroll
    for (int i = 0; i < 16; ++i) { o[0][0][i] = 0.f; o[0][1][i] = 0.f; o[1][0][i] = 0.f; o[1][1][i] = 0.f; }
    float m_run[2] = {-1e30f, -1e30f}, l_run[2] = {0.f, 0.f};
    u32x4 rk0, rk1, rk2, rv0, rv1;
    const int vrow = tid >> 3, vcol = (tid & 7) * 8;
    const int kw0 = (tid / 12) * 104 + (tid % 12) * 8, kw1 = ((tid + 256) / 12) * 104 + ((tid + 256) % 12) * 8, kw2 = ((tid + 512) / 12) * 104 + ((tid + 512) % 12) * 8;
    const bf16_t* cK = sK + l31 * 104 + 8 * hh;
    const bf16_t* cV = sV + l31 * 72 + 8 * hh;
#define ATT_KWRITE(buf_) do { bf16_t* k_ = sK + (buf_) * 64 * 104; *(u32x4*)(k_ + kw0) = rk0; *(u32x4*)(k_ + kw1) = rk1; *(u32x4*)(k_ + kw2) = rk2; } while (0)
#define ATT_VWRITE(buf_) do { bf16_t* v_ = sV + (buf_) * 64 * 72 + vrow * 72 + vcol; *(u32x4*)(v_) = rv0; *(u32x4*)(v_ + 32 * 72) = rv1; } while (0)
    {
        const bf16_t* kp = Kb + tid * 8;
        rk0 = *(const u32x4*)(kp); rk1 = *(const u32x4*)(kp + 2048); rk2 = *(const u32x4*)(kp + 4096);
        const bf16_t* vp = Vb + (size_t)vrow * LK + vcol;
        rv0 = *(const u32x4*)(vp); rv1 = *(const u32x4*)(vp + (size_t)32 * LK);
        ATT_KWRITE(0); ATT_VWRITE(0);
    }
    __syncthreads();
#pragma unroll 2
    for (int t = 0; t < T; ++t) {
        const int buf = t & 1;
        const bool more = (t + 1) < T;
        if (more) {
            const bf16_t* kp_ = Kb + (size_t)(t + 1) * 64 * DK + tid * 8; gld16(rk0, kp_); gld16(rk1, kp_ + 2048); gld16(rk2, kp_ + 4096);
            const bf16_t* vp_ = Vb + (size_t)vrow * LK + (t + 1) * 64 + vcol; gld16(rv0, vp_); gld16(rv1, vp_ + (size_t)32 * LK);
        }
#pragma unroll
        for (int kb = 0; kb < 2; ++kb) {
            f32x16 s[2];
#pragma unroll
            for (int i = 0; i < 16; ++i) { s[0][i] = 0.f; s[1][i] = 0.f; }
            bf16x8 kf[6];
#pragma unroll
            for (int ks = 0; ks < 6; ++ks) kf[ks] = *(const bf16x8*)(cK + buf * 64 * 104 + kb * 32 * 104 + 16 * ks);
            __builtin_amdgcn_sched_barrier(0);
            __builtin_amdgcn_s_setprio(1);
#pragma unroll
            for (int ks = 0; ks < 6; ++ks) {
                s[0] = MFMA32(kf[ks], qf[0][ks], s[0]);
                s[1] = MFMA32(kf[ks], qf[1][ks], s[1]);
            }
            __builtin_amdgcn_s_setprio(0);
#pragma unroll
            for (int qb = 0; qb < 2; ++qb) {
                float mx = s[qb][0];
#pragma unroll
                for (int i = 1; i < 16; ++i) mx = fmaxf(mx, s[qb][i]);
                mx = xhalf_max(mx);
                const float m_new = fmaxf(m_run[qb], mx);
                if (__builtin_amdgcn_ballot_w64(m_new > m_run[qb]) != 0ull) {
                    const float alpha = __builtin_amdgcn_exp2f(m_run[qb] - m_new);
                    m_run[qb] = m_new; l_run[qb] *= alpha;
#pragma unroll
                    for (int i = 0; i < 16; ++i) { o[qb][0][i] *= alpha; o[qb][1][i] *= alpha; }
                }
                float ps = 0.f;
#pragma unroll
                for (int i = 0; i < 16; ++i) { s[qb][i] = __builtin_amdgcn_exp2f(s[qb][i] - m_run[qb]); ps += s[qb][i]; }
                l_run[qb] += ps;
            }
            bf16x8 vf[2][2];
#pragma unroll
            for (int u = 0; u < 2; ++u)
#pragma unroll
                for (int dvb = 0; dvb < 2; ++dvb) vf[u][dvb] = *(const bf16x8*)(cV + buf * 64 * 72 + dvb * 32 * 72 + 32 * kb + 16 * u);
            __builtin_amdgcn_sched_barrier(0);
#pragma unroll
            for (int u = 0; u < 2; ++u) {
                const bf16x8 p0 = __builtin_bit_cast(bf16x8, u32x4{pack2(s[0][8 * u], s[0][8 * u + 1]), pack2(s[0][8 * u + 2], s[0][8 * u + 3]), pack2(s[0][8 * u + 4], s[0][8 * u + 5]), pack2(s[0][8 * u + 6], s[0][8 * u + 7])});
                const bf16x8 p1 = __builtin_bit_cast(bf16x8, u32x4{pack2(s[1][8 * u], s[1][8 * u + 1]), pack2(s[1][8 * u + 2], s[1][8 * u + 3]), pack2(s[1][8 * u + 4], s[1][8 * u + 5]), pack2(s[1][8 * u + 6], s[1][8 * u + 7])});
                __builtin_amdgcn_s_setprio(1);
#pragma unroll
                for (int dvb = 0; dvb < 2; ++dvb) {
                    o[0][dvb] = MFMA32(vf[u][dvb], p0, o[0][dvb]);
                    o[1][dvb] = MFMA32(vf[u][dvb], p1, o[1][dvb]);
                }
                __builtin_amdgcn_s_setprio(0);
            }
        }
        if (more) { vm_wait5(rk0, rk1, rk2, rv0, rv1); ATT_KWRITE(buf ^ 1); ATT_VWRITE(buf ^ 1); }
        __syncthreads();
    }
#undef ATT_KWRITE
#undef ATT_VWRITE
#pragma unroll
    for (int qb = 0; qb < 2; ++qb) {
        const float lt = xhalf_sum(l_run[qb]);
        const float inv = 1.f / lt;
#pragma unroll
        for (int dvb = 0; dvb < 2; ++dvb)
#pragma unroll
            for (int q = 0; q < 4; ++q) {
                uint2 ov; ov.x = pack2(o[qb][dvb][4 * q] * inv, o[qb][dvb][4 * q + 1] * inv); ov.y = pack2(o[qb][dvb][4 * q + 2] * inv, o[qb][dvb][4 * q + 3] * inv);
                *(uint2*)(MIX + (size_t)(qrow + 32 * qb) * DMIX + 768 + head * 64 + 32 * dvb + 8 * q + 4 * hh) = ov;
            }
    }
}

PH_FN void misc_phase(const KP& p, int l, char* smem) {
    const int n_qkv = 260 * 14, n_cp = l == 1 ? 1024 : 1040, n_s5 = 2 * NCHUNK * 4;
    const int rot = (blockIdx.x + gridDim.x / 2) % gridDim.x;
    for (int it = vblock(); it < n_qkv; it += gridDim.x) qkv_item(p, l, it, smem);
    for (int it = rot; it < n_cp; it += gridDim.x) convpool_item(p, l, it, smem);
    for (int it = blockIdx.x; it < n_s5; it += gridDim.x) s5_item<false>(p, l, it, smem);
#if MISC_DUP == 1
    for (int it = vblock(); it < n_qkv; it += gridDim.x) qkv_item(p, l, it, smem);
#elif MISC_DUP == 2
    for (int it = rot; it < n_cp; it += gridDim.x) convpool_item(p, l, it, smem);
#elif MISC_DUP == 3
    for (int it = blockIdx.x; it < n_s5; it += gridDim.x) s5_item<false>(p, l, it, smem);
#endif
}
PH_FN void attn_phase(const KP& p, int l, char* smem) {
    const int n_att = l == 1 ? 1024 : 1024 + 16;
    if (blockIdx.x < 16) s5_carry(p, l, blockIdx.x);
    for (int it = vblock(); it < n_att; it += gridDim.x) attn_item(p, it, smem);
}
PH_FN void s5fin_phase(const KP& p, int l, char* smem) {
    for (int it = blockIdx.x; it < 2 * NCHUNK * 4; it += gridDim.x) s5_item<true>(p, l, it, smem);
}

DI void run_phase(const KP& p, int ph, char* smem) {
    if (ph == 0) { prep_phase(p, smem); return; }
    if (ph == 27) {
        rowop_phase(p, 1, 8, 0.5f, p.in[7] + (1 * 3 + 2) * D, true, 0, 0, nullptr, false, false, NL);
        return;
    }
    const int l = (ph - 1) / 13, s = (ph - 1) % 13;
    const bf16_t* Wl = (const bf16_t*)(p.ws + OFF_W) + (size_t)l * WL_EL;
    const float* npre = p.in[6] + (size_t)l * 3 * D;
    const float* npost = p.in[7] + (size_t)l * 3 * D;
    const bool lastl = l == 1;
    switch (s) {
    case 0:
        if (l == 0) rowop_phase(p, 0, 0, 0.f, nullptr, false, 0, 0, npre, true, true);
        else rowop_phase(p, l - 1, 8, 0.5f, p.in[7] + ((l - 1) * 3 + 2) * D, true, l, 0, npre, true, false);
        break;
    case 1: case 11: gemm1_phase(p, l, s == 11, smem, (lastl && s == 11) ? NL / 256 : NT / 256); break;
    case 2: case 9: case 12: {
        const bool isout = s == 9;
        const bf16_t* Ag = (const bf16_t*)(p.ws + (isout ? OFF_MIX : OFF_ACT));
        const bf16_t* Wg = Wl + (isout ? WO_OUT : (s == 12 ? WO_D1 : WO_D0));
        const int Kg = isout ? DMIX : FF;
        gemm_store_phase256<D>(Ag, Kg, Wg, Kg, 8, (bf16_t*)(p.ws + OFF_HY), smem, NL / 256, (lastl && s != 2) ? 0 : NC / 128);
    } break;
    case 3: rowop_phase(p, l, 2, 0.5f, npost, true, l, 3, npre + D, true, l == 0); break;
    case 4: gemm_store_phase256<DIN>((const bf16_t*)(p.ws + OFF_HY), D, Wl + WO_IN, D, 12, (bf16_t*)(p.ws + OFF_Z), smem, NL / 256, NC / 128); break;
    case 5: misc_phase(p, l, smem); break;
    case 6: attn_phase(p, l, smem); break;
    case 7: s5fin_phase(p, l, smem); break;
    case 8: glu_phase(p, l, smem); break;
    case 10: rowop_phase(p, l, 5, 1.0f, npost + D, true, l, 6, npre + 2 * D, true, false, lastl ? NL : NT); break;
    }
}

constexpr int N_PHASES = 28;

__global__ void __launch_bounds__(256, 2) mega_kernel(KP p, int ph_lo, int ph_hi) {
    __shared__ __attribute__((aligned(16))) char smem[65536];
    __shared__ KP s_kp;
    if (TIDX() < 33) s_kp.in[TIDX()] = p.in[TIDX()];
    if (TIDX() == 33) s_kp.out = p.out;
    if (TIDX() == 34) s_kp.ws = p.ws;
    __shared__ uint4 xb_words;
    if (TIDX() == 0) xb_words = make_uint4(0u, 0u, 0u, 0u);
    __syncthreads();
    XcdBarrier xb = xcd_barrier_post((unsigned*)(p.ws + OFF_BAR), (volatile LAS unsigned*)&xb_words);
    for (int ph = ph_lo; ph < ph_hi; ++ph) {
        run_phase(p, ph, smem);
        if (DUP_MASK) {
            const int sbit = ph == 0 ? 13 : (ph == 27 ? 14 : (ph - 1) % 13);
            if ((DUP_MASK >> sbit) & 1) { xcd_barrier(xb); run_phase(p, ph, smem); }
        }
#if PROBE_MODE
        {
            const int sb = ph == 0 || ph == 27 ? -1 : (ph - 1) % 13, pl = (ph - 1) / 13;
            const bf16_t* Wl = (const bf16_t*)(s_kp.ws + OFF_W) + (size_t)pl * WL_EL;
            if (sb == 1 || sb == 11) { cg::this_grid().sync(); gemm1_phase<PROBE_MODE>(s_kp, pl, sb == 11, smem); }
            if (sb == 2 || sb == 12) { cg::this_grid().sync(); gemm_store_phase<PROBE_MODE>((const bf16_t*)(s_kp.ws + OFF_ACT), FF, Wl + (sb == 12 ? WO_D1 : WO_D0), FF, 8, (bf16_t*)(s_kp.ws + OFF_HY), D, D, smem); }
        }
#endif
        if (EXTRA_SYNCS) { xcd_barrier(xb); xcd_barrier(xb); }
        if (ph + 1 < ph_hi) { if (ph_hi < 0) cg::this_grid().sync(); else xcd_barrier(xb); }
    }
}

extern "C" void kernel_launch(void* const* d_in, const int* in_sizes, int n_in, void* d_out, int out_size, void* d_ws, size_t ws_size, hipStream_t stream) {
    static int grid = 0;
    if (grid == 0) {
        if (n_in != 33 || ws_size < WS_END) { fprintf(stderr, "kernel_launch: unexpected n_in %d or ws_size %zu < %zu\n", n_in, ws_size, (size_t)WS_END); grid = -1; return; }
        int dev = 0, cus = 0, per_cu = 0;
        hipGetDevice(&dev);
        hipDeviceGetAttribute(&cus, hipDeviceAttributeMultiprocessorCount, dev);
        hipOccupancyMaxActiveBlocksPerMultiprocessor(&per_cu, (const void*)mega_kernel, 256, 0);
        if (per_cu < 1) per_cu = 1;
        if (per_cu > 2) per_cu = 2;
        grid = cus * per_cu;
    }
    if (grid < 0) return;
    KP p{};
    for (int i = 0; i < 33; ++i) p.in[i] = (const float*)d_in[i];
    p.out = (float*)d_out; p.ws = (char*)d_ws;
    if (hipMemsetAsync((char*)d_ws + OFF_BAR, 0, 3456 * 4, stream) != hipSuccess) { fprintf(stderr, "kernel_launch: memset of barrier words failed\n"); return; }
#if ONE_LAUNCH
    int lo = 0, hi = N_PHASES;
    void* args[] = {&p, &lo, &hi};
    hipError_t e = hipLaunchCooperativeKernel((const void*)mega_kernel, dim3(grid), dim3(256), args, 0, stream);
    if (e != hipSuccess) fprintf(stderr, "cooperative launch failed: %s (grid %d)\n", hipGetErrorString(e), grid);
#else
    for (int ph = 0; ph < N_PHASES; ++ph) hipLaunchKernelGGL(mega_kernel, dim3(grid), dim3(256), 0, stream, p, ph, ph + 1);
#endif
}
```

```cpp
#include <hip/hip_runtime.h>
#include <hip/hip_cooperative_groups.h>
#include <cstdio>
#include <cstdint>
namespace cg = cooperative_groups;

#ifndef ONE_LAUNCH
#define ONE_LAUNCH 1
#endif
#define PROBE_MODE 0
#define EXTRA_SYNCS 0
#define MISC_DUP 0
#define ATT_PROBE 0
#define DUP_MASK 0

#define DI __device__ __forceinline__
#define PH_FN __device__ __forceinline__
typedef unsigned short bf16_t;
using bf16x8 = __attribute__((ext_vector_type(8))) short;
using f32x16 = __attribute__((ext_vector_type(16))) float;
using f32x4 = __attribute__((ext_vector_type(4))) float;
typedef unsigned u32x4 __attribute__((ext_vector_type(4)));
typedef __bf16 bf16x2_t __attribute__((ext_vector_type(2)));
typedef float f2_t __attribute__((ext_vector_type(2)));
typedef float f4_t __attribute__((ext_vector_type(4)));
typedef unsigned u2_t __attribute__((ext_vector_type(2)));

constexpr int D = 1024, SEQ = 16384, NB = 2, CTXL = 256;
constexpr int NL = NB * SEQ, NC = NB * CTXL, NT = NL + NC;
constexpr int FF = 2816, DIN = 1440, DMIX = 1280;
constexpr int NH = 8, DK = 96, LK = SEQ + CTXL;
constexpr int IN_CONV = 256, IN_POOL = 768, IN_CQ = 1024, IN_CKV = 1280, IN_KR = 1408;
constexpr int NCHUNK = LK / 64;
constexpr float EPS = 1e-6f;
constexpr float QSCALE = 0.10206207261596575f * 1.4426950408889634f;

constexpr size_t EL_GU = 5632ull * 1024, EL_D = 1024ull * 2816, EL_IN = 1536ull * 1024, EL_OUT = 1024ull * 1280,
                 EL_UQ = 768ull * 256, EL_UKV = 1024ull * 128, EL_GLU = 256ull * 256;
constexpr size_t WO_GU0 = 0, WO_GU1 = EL_GU, WO_D0 = 2 * EL_GU, WO_D1 = WO_D0 + EL_D, WO_IN = WO_D1 + EL_D,
                 WO_OUT = WO_IN + EL_IN, WO_UQ = WO_OUT + EL_OUT, WO_UKV = WO_UQ + EL_UQ, WO_GLU = WO_UKV + EL_UKV,
                 WL_EL = WO_GLU + EL_GLU;
constexpr size_t al256(size_t x) { return (x + 255) & ~(size_t)255; }
constexpr size_t OFF_W = 0;
constexpr size_t OFF_MOD = al256(OFF_W + 2 * WL_EL * 2);
constexpr size_t OFF_ROPE = al256(OFF_MOD + 2ull * 3 * 9216 * 4);
constexpr size_t OFF_LAMB = al256(OFF_ROPE + 256ull * 8 * 2 * 4);
constexpr size_t OFF_BBAR = al256(OFF_LAMB + 2ull * 2048 * 16);
constexpr size_t OFF_CC = al256(OFF_BBAR + 2ull * 2048 * 32 * 4);
constexpr size_t OFF_XC = al256(OFF_CC + 2ull * 32 * 2048 * 2);
constexpr size_t OFF_HY = al256(OFF_XC + (size_t)NC * D * 4);
constexpr size_t OFF_BIG = al256(OFF_HY + (size_t)NT * D * 2);
constexpr size_t OFF_ACT = OFF_BIG;
constexpr size_t OFF_Z = OFF_BIG;
constexpr size_t OFF_Q = al256(OFF_Z + (size_t)NT * DIN * 2);
constexpr size_t OFF_K = al256(OFF_Q + (size_t)NT * 768 * 2);
constexpr size_t OFF_VT = al256(OFF_K + (size_t)NB * NH * LK * 96 * 2);
constexpr size_t OFF_MIX = al256(OFF_VT + (size_t)NB * NH * 64 * LK * 2);
constexpr size_t OFF_S5P = al256(OFF_MIX + (size_t)NT * DMIX * 2);
constexpr size_t OFF_E = al256(OFF_S5P + (size_t)NT * 256 * 2);
constexpr size_t OFF_S = al256(OFF_E + 2ull * 2 * NCHUNK * 1024 * 8);
constexpr size_t OFF_BAR = al256(OFF_S + 2ull * 2 * NCHUNK * 1024 * 8);
constexpr size_t WS_END = al256(OFF_BAR + 3456 * 4);
static_assert(OFF_ACT + (size_t)NT * FF * 2 <= WS_END, "act fits");

struct KP { const float* in[33]; float* out; char* ws; };

DI int TIDX() { int t = threadIdx.x; asm volatile("" : "+v"(t)); return t; }
DI float bf2f(bf16_t b) { return __uint_as_float((unsigned)b << 16); }
DI unsigned pack2(float a, float b) { f2_t v = {a, b}; bf16x2_t r = __builtin_convertvector(v, bf16x2_t); return __builtin_bit_cast(unsigned, r); }
DI bf16_t f2bf(float a) { return (bf16_t)(pack2(a, 0.f) & 0xffffu); }
DI float fast_exp(float x) { return __builtin_amdgcn_exp2f(x * 1.4426950408889634f); }
DI float sigmoidf_(float x) { return __builtin_amdgcn_rcpf(1.f + fast_exp(-x)); }
DI float siluf_(float x) { return x * sigmoidf_(x); }
DI float gelu_tanh(float x) { float u = 0.7978845608028654f * (x + 0.044715f * x * x * x); float t = 1.f - 2.f * __builtin_amdgcn_rcpf(1.f + fast_exp(2.f * u)); return 0.5f * x * (1.f + t); }
DI float shflx(float v, int m) { const int idx = ((TIDX() & 63) ^ m) << 2; return __int_as_float(__builtin_amdgcn_ds_bpermute(idx, __float_as_int(v))); }
DI float xhalf_max(float v) { const auto r = __builtin_amdgcn_permlane32_swap(__float_as_uint(v), __float_as_uint(v), false, false); return fmaxf(__uint_as_float(r[0]), __uint_as_float(r[1])); }
DI float xhalf_sum(float v) { const auto r = __builtin_amdgcn_permlane32_swap(__float_as_uint(v), __float_as_uint(v), false, false); return __uint_as_float(r[0]) + __uint_as_float(r[1]); }
DI float wave_sum(float v) { for (int m = 32; m >= 1; m >>= 1) v += shflx(v, m); return v; }
DI int crow(int i, int hh) { return (i & 3) + 8 * (i >> 2) + 4 * hh; }
DI int row_mod(int row) { return row < NL ? (row >= SEQ ? 1 : 0) : 2; }
DI int vblock() { const int G = gridDim.x, b = blockIdx.x; return (G & 7) ? b : (G >> 3) * (b & 7) + (b >> 3); }
DI void tile_mn(int it, int TM, int TN, int& mt, int& nt) {
    const int band = it / (8 * TN), within = it - band * 8 * TN;
    const int gm = min(8, TM - 8 * band);
    nt = within / gm; mt = 8 * band + (within - nt * gm);
}
DI void gld16(u32x4& r, const void* p) { asm volatile("global_load_dwordx4 %0, %1, off" : "=&v"(r) : "v"(p) : "memory"); }
DI void vm_wait8(u32x4& a, u32x4& b, u32x4& c, u32x4& d, u32x4& e, u32x4& f, u32x4& g, u32x4& h) {
    asm volatile("s_waitcnt vmcnt(0)" : "+v"(a), "+v"(b), "+v"(c), "+v"(d), "+v"(e), "+v"(f), "+v"(g), "+v"(h) : : "memory"); }
DI void vm_wait5(u32x4& a, u32x4& b, u32x4& c, u32x4& d, u32x4& e) {
    asm volatile("s_waitcnt vmcnt(0)" : "+v"(a), "+v"(b), "+v"(c), "+v"(d), "+v"(e) : : "memory"); }
#define MFMA32(a, b, c) __builtin_amdgcn_mfma_f32_32x32x16_bf16((a), (b), (c), 0, 0, 0)
#define MFMA16(a, b, c) __builtin_amdgcn_mfma_f32_16x16x32_bf16((a), (b), (c), 0, 0, 0)

#define XB_TMO      128
#define XB_XCNT(j)  (256  + 64 * (j))
#define XB_XSUB(j)  (1280 + 64 * (j))
#define XB_XGEN(j)  (2304 + 64 * (j))
#define XB_TOP      3328
#define XB_TOPGEN   3392
#define XCD_BAR_WORDS 3456
#define XB_SPIN_CAP (1u << 18)
#define LAS __attribute__((address_space(3)))

__device__ __forceinline__ unsigned xb_ld(unsigned* p)              { return __hip_atomic_load(p, __ATOMIC_RELAXED, __HIP_MEMORY_SCOPE_AGENT); }
__device__ __forceinline__ unsigned xb_add(unsigned* p, unsigned v) { return __hip_atomic_fetch_add(p, v, __ATOMIC_RELAXED, __HIP_MEMORY_SCOPE_AGENT); }
__device__ __forceinline__ unsigned xb_xcc_id() { return (unsigned)__builtin_amdgcn_s_getreg((3 << 11) | 20) & 0xFu; }
#define XB_SPIN(cond, bar) do { unsigned _sp = 0; while (cond) { __builtin_amdgcn_s_sleep(1); \
    if ((++_sp & 255u) == 0u) { if (xb_ld(&(bar)[XB_TMO])) break; if (_sp > XB_SPIN_CAP) { atomicAdd(&(bar)[XB_TMO], 1u); break; } } } } while (0)

struct XcdBarrier {
    unsigned* bar; unsigned x;
    volatile LAS unsigned* st;
};

__device__ __forceinline__ XcdBarrier xcd_barrier_post(unsigned* bar, volatile LAS unsigned* st) {
    XcdBarrier b; b.bar = bar; b.x = xb_xcc_id(); b.st = st;
    if (TIDX() == 0) (void)xb_add(&bar[XB_XCNT(b.x)], 1u);
    return b;
}
__device__ __forceinline__ void xcd_barrier_complete(unsigned* bar, unsigned x, unsigned& nloc, unsigned& nx) {
    const unsigned G = gridDim.x * gridDim.y * gridDim.z;
    unsigned sum, cnt, mine, sp = 0u;
    for (;;) {
        sum = 0u; cnt = 0u; mine = 0u;
#pragma unroll
        for (unsigned j = 0; j < 16; ++j) { const unsigned c = xb_ld(&bar[XB_XCNT(j)]); sum += c; cnt += (c > 0u) ? 1u : 0u; mine = (j == x) ? c : mine; }
        if (sum == G) break;
        __builtin_amdgcn_s_sleep(1);
        if ((++sp & 255u) == 0u) { if (xb_ld(&bar[XB_TMO])) break; if (sp > XB_SPIN_CAP) { atomicAdd(&bar[XB_TMO], 1u); break; } }
    }
    nloc = mine > 0u ? mine : 1u; nx = cnt > 0u ? cnt : 1u;
}

__device__ __forceinline__ void xcd_barrier(const XcdBarrier& b) {
    asm volatile("s_waitcnt vmcnt(0)" ::: "memory");
    __syncthreads();
    if (TIDX() == 0) {
        unsigned* bar = b.bar;
        __builtin_amdgcn_s_waitcnt(0);
        unsigned nloc = b.st[0], nx = b.st[1];
        if (nloc == 0u) { xcd_barrier_complete(bar, b.x, nloc, nx); b.st[0] = nloc; b.st[1] = nx; }
        const unsigned old = xb_add(&bar[XB_XSUB(b.x)], 1u);
        const unsigned gen = old / nloc;
        if (old + 1u == (gen + 1u) * nloc) {
            __builtin_amdgcn_fence(__ATOMIC_RELEASE, "agent");
            asm volatile("s_waitcnt vmcnt(0)" ::: "memory");
            const unsigned og = xb_add(&bar[XB_TOP], 1u);
            const unsigned tg = og / nx;
            if (og + 1u == (tg + 1u) * nx) xb_add(&bar[XB_TOPGEN], 1u);
            else XB_SPIN(xb_ld(&bar[XB_TOPGEN]) == tg, bar);
            __builtin_amdgcn_fence(__ATOMIC_ACQUIRE, "agent");
            xb_add(&bar[XB_XGEN(b.x)], 1u);
            asm volatile("s_waitcnt vmcnt(0)" ::: "memory");
        } else {
            XB_SPIN(xb_ld(&bar[XB_XGEN(b.x)]) == gen, bar);
            __builtin_amdgcn_fence(__ATOMIC_ACQUIRE, "agent");
            asm volatile("s_waitcnt vmcnt(0)" ::: "memory");
        }
    }
    __syncthreads();
}


DI void vm_wait_sel(u32x4& a, u32x4& b, u32x4& c, u32x4& d, u32x4& e, u32x4& f, u32x4& g, u32x4& h, int all) {
    asm volatile("s_cmp_lg_u32 %8, 0\n\ts_cbranch_scc1 1f\n\ts_waitcnt vmcnt(8)\n\ts_branch 2f\n1:\n\ts_waitcnt vmcnt(0)\n2:"
                 : "+v"(a), "+v"(b), "+v"(c), "+v"(d), "+v"(e), "+v"(f), "+v"(g), "+v"(h) : "s"(all) : "memory", "scc"); }

template <int MODE = 0, class Epi>
DI void gemm_tile(const bf16_t* __restrict__ A, int lda, const bf16_t* __restrict__ Bt, int ldb, int K, int row0, int col0, char* smem, Epi&& epi) {
    bf16_t* sA = (bf16_t*)smem;
    bf16_t* sB = sA + 2 * 8192;
    const int tid = TIDX(), lane = tid & 63, wave = tid >> 6;
    const int wm = wave >> 1, wn = wave & 1, l31 = lane & 31, hh = lane >> 5;
    u32x4 r0a[4], r0b[4], r1a[4], r1b[4];
    const bf16_t* Ap = A + (size_t)(row0 + (tid >> 3)) * lda + (tid & 7) * 8;
    const bf16_t* Bp = Bt + (size_t)(col0 + (tid >> 3)) * ldb + (tid & 7) * 8;
    const int wr_off = (tid >> 3) * 64 + (((tid & 7) ^ ((tid >> 4) & 7)) * 8);
    f32x16 acc[2][2];
#pragma unroll
    for (int a = 0; a < 2; ++a)
#pragma unroll
        for (int b = 0; b < 2; ++b)
#pragma unroll
            for (int i = 0; i < 16; ++i) acc[a][b][i] = 0.f;
    const int nk = K >> 6;
#pragma unroll
    for (int i = 0; i < 4; ++i) { r0a[i] = *(const u32x4*)(Ap + (size_t)i * 32 * lda); r0b[i] = *(const u32x4*)(Bp + (size_t)i * 32 * ldb); }
#pragma unroll
    for (int i = 0; i < 4; ++i) { *(u32x4*)(sA + wr_off + i * 2048) = r0a[i]; *(u32x4*)(sB + wr_off + i * 2048) = r0b[i]; }
#pragma unroll
    for (int i = 0; i < 4; ++i) { gld16(r1a[i], Ap + (size_t)i * 32 * lda + 64); gld16(r1b[i], Bp + (size_t)i * 32 * ldb + 64); }
    __syncthreads();
    const int sw = (l31 >> 1) & 7;
    const bf16_t* cA = sA + (wm * 64 + l31) * 64;
    const bf16_t* cB = sB + (wn * 64 + l31) * 64;
#define GEMM_LDFRAG(buf_, ks_, a0_, a1_, b0_, b1_) do { const int ch = ((2 * (ks_) + hh) ^ sw) * 8; \
            a0_ = *(const bf16x8*)(cA + (buf_) * 8192 + ch); a1_ = *(const bf16x8*)(cA + (buf_) * 8192 + 32 * 64 + ch); \
            b0_ = *(const bf16x8*)(cB + (buf_) * 8192 + ch); b1_ = *(const bf16x8*)(cB + (buf_) * 8192 + 32 * 64 + ch); } while (0)
#define GEMM_MMA(a0_, a1_, b0_, b1_) do { acc[0][0] = MFMA32(a0_, b0_, acc[0][0]); acc[0][1] = MFMA32(a0_, b1_, acc[0][1]); \
            acc[1][0] = MFMA32(a1_, b0_, acc[1][0]); acc[1][1] = MFMA32(a1_, b1_, acc[1][1]); } while (0)
#define SB_ __builtin_amdgcn_sched_barrier(0)
#define GEMM_COMPUTE(buf_) do { bf16x8 pa0, pa1, pb0, pb1, qa0, qa1, qb0, qb1; \
            GEMM_LDFRAG(buf_, 0, pa0, pa1, pb0, pb1); GEMM_LDFRAG(buf_, 1, qa0, qa1, qb0, qb1); SB_; GEMM_MMA(pa0, pa1, pb0, pb1); SB_; \
            GEMM_LDFRAG(buf_, 2, pa0, pa1, pb0, pb1); SB_; GEMM_MMA(qa0, qa1, qb0, qb1); SB_; \
            GEMM_LDFRAG(buf_, 3, qa0, qa1, qb0, qb1); SB_; GEMM_MMA(pa0, pa1, pb0, pb1); SB_; GEMM_MMA(qa0, qa1, qb0, qb1); SB_; } while (0)
    for (int kt = 0; kt < nk; kt += 2) {
        const bool m2 = (kt + 2) < nk, m3 = (kt + 3) < nk;
        if (m2 && MODE == 0) {
            const int k0 = (kt + 2) << 6;
#pragma unroll
            for (int i = 0; i < 4; ++i) { gld16(r0a[i], Ap + (size_t)i * 32 * lda + k0); gld16(r0b[i], Bp + (size_t)i * 32 * ldb + k0); }
        }
        GEMM_COMPUTE(0);
        vm_wait_sel(r1a[0], r1a[1], r1a[2], r1a[3], r1b[0], r1b[1], r1b[2], r1b[3], __builtin_amdgcn_readfirstlane((m2 && MODE == 0) ? 0 : 1));
        if (MODE < 2)
#pragma unroll
        for (int i = 0; i < 4; ++i) { *(u32x4*)(sA + 8192 + wr_off + i * 2048) = r1a[i]; *(u32x4*)(sB + 8192 + wr_off + i * 2048) = r1b[i]; }
        __syncthreads();
        if (m3 && MODE == 0) {
            const int k0 = (kt + 3) << 6;
#pragma unroll
            for (int i = 0; i < 4; ++i) { gld16(r1a[i], Ap + (size_t)i * 32 * lda + k0); gld16(r1b[i], Bp + (size_t)i * 32 * ldb + k0); }
        }
        GEMM_COMPUTE(1);
        if (m2) {
            vm_wait_sel(r0a[0], r0a[1], r0a[2], r0a[3], r0b[0], r0b[1], r0b[2], r0b[3], __builtin_amdgcn_readfirstlane((m3 && MODE == 0) ? 0 : 1));
            if (MODE < 2)
#pragma unroll
            for (int i = 0; i < 4; ++i) { *(u32x4*)(sA + wr_off + i * 2048) = r0a[i]; *(u32x4*)(sB + wr_off + i * 2048) = r0b[i]; }
        }
        __syncthreads();
    }
#undef GEMM_COMPUTE
#undef GEMM_LDFRAG
#undef GEMM_MMA
    epi(acc, row0 + wm * 64, col0 + wn * 64);
}

DI const bf16_t* uni_ptr(const bf16_t* p) {
    const unsigned long long v = (unsigned long long)p;
    const unsigned lo = __builtin_amdgcn_readfirstlane((unsigned)v), hi = __builtin_amdgcn_readfirstlane((unsigned)(v >> 32));
    return (const bf16_t*)(((unsigned long long)hi << 32) | lo); }
DI void gld16s(u32x4& r, unsigned voff, const void* sbase) { asm volatile("global_load_dwordx4 %0, %1, %2" : "=&v"(r) : "v"(voff), "s"(sbase) : "memory"); }
DI void vm_wait12(u32x4& a, u32x4& b, u32x4& c, u32x4& d, u32x4& e, u32x4& f, u32x4& g, u32x4& h, u32x4& i, u32x4& j, u32x4& k, u32x4& l) {
    asm volatile("s_waitcnt vmcnt(0)" : "+v"(a), "+v"(b), "+v"(c), "+v"(d), "+v"(e), "+v"(f), "+v"(g), "+v"(h), "+v"(i), "+v"(j), "+v"(k), "+v"(l) : : "memory"); }

template <class Epi>
DI void gemm_tile256(const bf16_t* __restrict__ A, int lda, const bf16_t* __restrict__ Bt, int ldb, int K, int row0, int col0, char* smem, Epi&& epi) {
    bf16_t* sA = (bf16_t*)smem;
    bf16_t* sB = sA + 256 * 64;
    const int tid = TIDX(), lane = tid & 63, wave = tid >> 6;
    const int wm = wave >> 1, wn = wave & 1, l31 = lane & 31, hh = lane >> 5;
    u32x4 ra[8], rb[4];
    const bf16_t* Ab = uni_ptr(A + (size_t)row0 * lda);
    const bf16_t* Bb = uni_ptr(Bt + (size_t)col0 * ldb);
    const unsigned voa = ((unsigned)(tid >> 3) * (unsigned)lda + (tid & 7) * 8) * 2u;
    const unsigned vob = ((unsigned)(tid >> 3) * (unsigned)ldb + (tid & 7) * 8) * 2u;
    const int wr_off = (tid >> 3) * 64 + (((tid & 7) ^ ((tid >> 4) & 7)) * 8);
    f32x16 acc[4][2];
#pragma unroll
    for (int a = 0; a < 4; ++a)
#pragma unroll
        for (int b = 0; b < 2; ++b)
#pragma unroll
            for (int i = 0; i < 16; ++i) acc[a][b][i] = 0.f;
    const int nk = K >> 6;
#pragma unroll
    for (int i = 0; i < 8; ++i) gld16s(ra[i], voa, Ab + (size_t)i * 32 * lda);
#pragma unroll
    for (int i = 0; i < 4; ++i) gld16s(rb[i], vob, Bb + (size_t)i * 32 * ldb);
    const int sw = (l31 >> 1) & 7;
    const bf16_t* cA = sA + (wm * 128 + l31) * 64;
    const bf16_t* cB = sB + (wn * 64 + l31) * 64;
    for (int kt = 0; kt < nk; ++kt) {
        vm_wait12(ra[0], ra[1], ra[2], ra[3], ra[4], ra[5], ra[6], ra[7], rb[0], rb[1], rb[2], rb[3]);
#pragma unroll
        for (int i = 0; i < 8; ++i) *(u32x4*)(sA + wr_off + i * 2048) = ra[i];
#pragma unroll
        for (int i = 0; i < 4; ++i) *(u32x4*)(sB + wr_off + i * 2048) = rb[i];
        __syncthreads();
        if (kt + 1 < nk) {
            const int k0 = (kt + 1) << 6;
#pragma unroll
            for (int i = 0; i < 8; ++i) gld16s(ra[i], voa, Ab + (size_t)i * 32 * lda + k0);
#pragma unroll
            for (int i = 0; i < 4; ++i) gld16s(rb[i], vob, Bb + (size_t)i * 32 * ldb + k0);
        }
        __builtin_amdgcn_s_setprio(1);
#pragma unroll
        for (int ks = 0; ks < 4; ++ks) {
            const int ch = ((2 * ks + hh) ^ sw) * 8;
            const bf16x8 b0 = *(const bf16x8*)(cB + ch), b1 = *(const bf16x8*)(cB + 32 * 64 + ch);
#pragma unroll
            for (int mi = 0; mi < 4; ++mi) {
                const bf16x8 a = *(const bf16x8*)(cA + mi * 32 * 64 + ch);
                acc[mi][0] = MFMA32(a, b0, acc[mi][0]);
                acc[mi][1] = MFMA32(a, b1, acc[mi][1]);
            }
        }
        __builtin_amdgcn_s_setprio(0);
        __syncthreads();
    }
    epi(acc, row0 + wm * 128, col0 + wn * 64);
}

DI void transpose_store(bf16_t* dst, int K, int n0, int k0, const float* tile) {
    const int kp = TIDX() & 31, nn = TIDX() >> 5;
#pragma unroll
    for (int i = 0; i < 8; ++i) {
        const int n = nn + 8 * i;
        *(unsigned*)(dst + (size_t)(n0 + n) * K + k0 + 2 * kp) = pack2(tile[(2 * kp) * 65 + n], tile[(2 * kp + 1) * 65 + n]);
    }
}
template <class F>
DI void transpose_tile(bf16_t* dst, int K, int tn, int tk, F src, float* tile) {
    const int tx = TIDX() & 63, ty = TIDX() >> 6;
    const int n0 = tn * 64, k0 = tk * 64;
    float v[16];
#pragma unroll
    for (int i = 0; i < 16; ++i) v[i] = src(k0 + ty + 4 * i, n0 + tx);
#pragma unroll
    for (int i = 0; i < 16; ++i) tile[(ty + 4 * i) * 65 + tx] = v[i];
    __syncthreads();
    transpose_store(dst, K, n0, k0, tile);
    __syncthreads();
}
DI void poolfold_tile(bf16_t* dst, int tn, int tk, const float* wi, const float* pw, const float* ps, float* smemf) {
    float* wt = smemf;
    float* pt = smemf + 64 * 65;
    float* ot = pt + 64 * 64;
    const int tx = TIDX() & 63, ty = TIDX() >> 6;
    const int n0 = tn * 64, k0 = tk * 64, g = (n0 - IN_POOL) >> 6;
    const float sc = ps[g * 64 + tx];
#pragma unroll
    for (int i = 0; i < 16; ++i) {
        const int r = ty + 4 * i;
        wt[r * 65 + tx] = wi[(size_t)(k0 + r) * DIN + IN_POOL + g * 64 + tx];
        pt[r * 64 + tx] = pw[g * 4096 + r * 64 + tx] * sc;
    }
    __syncthreads();
    float acc[16];
#pragma unroll
    for (int i = 0; i < 16; ++i) acc[i] = 0.f;
    for (int ii = 0; ii < 64; ++ii) {
        const float pv = pt[ii * 64 + tx];
#pragma unroll
        for (int i = 0; i < 16; ++i) acc[i] += wt[(ty + 4 * i) * 65 + ii] * pv;
    }
#pragma unroll
    for (int i = 0; i < 16; ++i) ot[(ty + 4 * i) * 65 + tx] = acc[i];
    __syncthreads();
    transpose_store(dst, 1024, n0, k0, ot);
    __syncthreads();
}

PH_FN void prep_phase(const KP& p, char* smem) {
    float* tile = (float*)smem;
    bf16_t* W = (bf16_t*)(p.ws + OFF_W);
    const int NTR = 5024;
    const int n_items = 2 * NTR + 288 + 1 + 16;
    for (int it = blockIdx.x; it < n_items; it += gridDim.x) {
        if (it < 2 * NTR) {
            const int l = it / NTR; int r = it % NTR;
            bf16_t* Wl = W + (size_t)l * WL_EL;
            if (r < 2816) {
                const int f = r / 1408; r %= 1408;
                const float* g = p.in[8] + (size_t)(l * 2 + f) * D * FF;
                const float* u = p.in[9] + (size_t)(l * 2 + f) * D * FF;
                transpose_tile(Wl + (f ? WO_GU1 : WO_GU0), 1024, r / 16, r % 16, [&](int k, int n) {
                    const int j = n >> 7, w = n & 127, c = j * 64 + (w >> 6) * 32 + (w & 31);
                    return ((w >> 5) & 1) ? u[(size_t)k * FF + c] : g[(size_t)k * FF + c]; }, tile);
            } else if (r < 2816 + 1408) {
                r -= 2816; const int f = r / 704; r %= 704;
                const float* dn = p.in[10] + (size_t)(l * 2 + f) * FF * D;
                transpose_tile(Wl + (f ? WO_D1 : WO_D0), 2816, r / 44, r % 44, [&](int k, int n) { return dn[(size_t)k * D + n]; }, tile);
            } else if (r < 4224 + 384) {
                r -= 4224;
                const float* wi = p.in[11] + (size_t)l * D * DIN;
                const float* pw = p.in[27] + (size_t)l * 4 * 64 * 64;
                const float* ps = p.in[28] + (size_t)l * 256;
                const int tn = r / 16, tk = r % 16;
                if (tn >= IN_POOL / 64 && tn < IN_CQ / 64) poolfold_tile(Wl + WO_IN, tn, tk, wi, pw, ps, tile);
                else transpose_tile(Wl + WO_IN, 1024, tn, tk, [&](int k, int n) { return n < DIN ? wi[(size_t)k * DIN + n] : 0.f; }, tile);
            } else if (r < 4608 + 320) {
                r -= 4608;
                const float* wo = p.in[12] + (size_t)l * DMIX * D;
                transpose_tile(Wl + WO_OUT, 1280, r / 20, r % 20, [&](int k, int n) { return wo[(size_t)k * D + n]; }, tile);
            } else if (r < 4928 + 48) {
                r -= 4928;
                const float* wq = p.in[30] + (size_t)l * 256 * 768;
                const float* gn = p.in[29] + (size_t)l * 256;
                transpose_tile(Wl + WO_UQ, 256, r / 4, r % 4, [&](int k, int n) { return wq[(size_t)k * 768 + n] * gn[k] * QSCALE; }, tile);
            } else if (r < 4976 + 32) {
                r -= 4976;
                const float* wk = p.in[32] + (size_t)l * 128 * 1024;
                const float* gn = p.in[31] + (size_t)l * 128;
                transpose_tile(Wl + WO_UKV, 128, r / 2, r % 2, [&](int k, int n) { return wk[(size_t)k * 1024 + n] * gn[k]; }, tile);
            } else {
                r -= 5008;
                const float* wg = p.in[21] + (size_t)l * 256 * 256;
                transpose_tile(Wl + WO_GLU, 256, r / 4, r % 4, [&](int k, int n) { return wg[(size_t)k * 256 + n]; }, tile);
            }
        } else if (it < 2 * NTR + 288) {
            const int r = it - 2 * NTR, l = r / 144, n0 = (r % 144) * 64;
            float* sc = (float*)smem;
            float* red = sc + 3072;
            for (int i = TIDX(); i < 3072; i += 256) {
                const int v = i >> 10, k = i & 1023;
                const float cv = v < 2 ? p.in[1][v * 1024 + k] : p.in[3][k];
                sc[i] = cv / (1.f + expf(-cv));
            }
            __syncthreads();
            const int tx = TIDX() & 63, ty = TIDX() >> 6;
            const float* wa = p.in[4] + (size_t)l * D * 9216 + n0 + tx;
            float a0 = 0.f, a1 = 0.f, a2 = 0.f;
#pragma unroll 32
            for (int k = ty * 256; k < ty * 256 + 256; ++k) {
                const float w = wa[(size_t)k * 9216];
                a0 += sc[k] * w; a1 += sc[1024 + k] * w; a2 += sc[2048 + k] * w;
            }
            red[(ty * 3 + 0) * 64 + tx] = a0; red[(ty * 3 + 1) * 64 + tx] = a1; red[(ty * 3 + 2) * 64 + tx] = a2;
            __syncthreads();
            if (TIDX() < 192) {
                const int v = TIDX() >> 6;
                float s = p.in[5][l * 9216 + n0 + tx];
                for (int q = 0; q < 4; ++q) s += red[(q * 3 + v) * 64 + tx];
                ((float*)(p.ws + OFF_MOD))[(size_t)(l * 3 + v) * 9216 + n0 + tx] = s;
            }
            __syncthreads();
        } else if (it == 2 * NTR + 288) {
            float* tab = (float*)(p.ws + OFF_ROPE);
            const int pos = TIDX();
            for (int i = 0; i < 8; ++i) {
                const float inv = powf(10000.f, -(float)(2 * i) / 16.f);
                const float ang = (float)pos * inv;
                tab[(pos * 8 + i) * 2 + 0] = cosf(ang);
                tab[(pos * 8 + i) * 2 + 1] = sinf(ang);
            }
        } else {
            const int idx = (it - (2 * NTR + 289)) * 256 + TIDX();
            const int pp = idx & 63, g = (idx >> 6) & 15, ld = idx >> 10;
            float lr = fminf(p.in[13][idx], -1e-4f), li = p.in[14][idx];
            const float dt = expf(p.in[15][ld * 16 + g]);
            const float mag = expf(lr * dt);
            const float br = mag * cosf(li * dt), bi = mag * sinf(li * dt);
            float tr = br, ti = bi;
            for (int q = 0; q < 6; ++q) { const float nr = tr * tr - ti * ti, ni = 2.f * tr * ti; tr = nr; ti = ni; }
            ((float4*)(p.ws + OFF_LAMB))[idx] = make_float4(br, bi, tr, ti);
            const float nr = br - 1.f, ni = bi, den = 1.f / (lr * lr + li * li);
            const float cr = (nr * lr + ni * li) * den, ci = (ni * lr - nr * li) * den;
            float* bb = (float*)(p.ws + OFF_BBAR) + (size_t)idx * 32;
            const float* sbr = p.in[16] + (size_t)idx * 16; const float* sbi = p.in[17] + (size_t)idx * 16;
            for (int h = 0; h < 16; ++h) { const float xr = sbr[h], xi = sbi[h]; bb[2 * h] = cr * xr - ci * xi; bb[2 * h + 1] = cr * xi + ci * xr; }
            bf16_t* cc = (bf16_t*)(p.ws + OFF_CC) + (size_t)(ld * 16 + g) * 2048;
            const float* scr = p.in[18] + (size_t)(ld * 16 + g) * 1024; const float* sci = p.in[19] + (size_t)(ld * 16 + g) * 1024;
            for (int h = 0; h < 16; ++h) { cc[h * 128 + pp] = f2bf(scr[h * 64 + pp]); cc[h * 128 + 64 + pp] = f2bf(-sci[h * 64 + pp]); }
        }
    }
}

PH_FN void rowop_phase(const KP& p, int l_mod_post, int gate_idx, float coef, const float* gpost, bool has_y,
                    int l_mod_pre, int shift_idx, const float* gpre, bool has_pre, bool first, int nrows = NT) {
    const int lane = TIDX() & 63;
    const int wid = blockIdx.x * 4 + (TIDX() >> 6), nw = gridDim.x * 4;
    bf16_t* HY = (bf16_t*)(p.ws + OFF_HY);
    float* Xc = (float*)(p.ws + OFF_XC);
    const float* MOD = (const float*)(p.ws + OFF_MOD);
    f4_t wpost[4], wpre[4], vg[4], vs0[4], vs1[4];
#pragma unroll
    for (int i = 0; i < 4; ++i) {
        wpost[i] = has_y ? *(const f4_t*)(gpost + lane * 4 + 256 * i) : f4_t{0.f, 0.f, 0.f, 0.f};
        wpre[i] = has_pre ? *(const f4_t*)(gpre + lane * 4 + 256 * i) : f4_t{0.f, 0.f, 0.f, 0.f};
        vg[i] = vs0[i] = vs1[i] = f4_t{0.f, 0.f, 0.f, 0.f};
    }
    int cur_mv = -1;
    for (int row0 = wid; row0 < nrows; row0 += 2 * nw) {
        int rows[2]; bool ok[2];
        rows[0] = row0; ok[0] = true;
        ok[1] = (row0 + nw) < nrows; rows[1] = ok[1] ? row0 + nw : row0;
        float* xp[2]; int mv[2];
        f4_t x[2][4], y[2][4];
        float ssy[2] = {0.f, 0.f};
#pragma unroll
        for (int q = 0; q < 2; ++q) {
            const int row = rows[q];
            mv[q] = row_mod(row);
            xp[q] = row < NL ? p.out + (size_t)row * D : Xc + (size_t)(row - NL) * D;
            const float* xin = first ? (row < NL ? p.in[0] + (size_t)row * D : p.in[2] + (size_t)(row - NL) * D) : xp[q];
#pragma unroll
            for (int i = 0; i < 4; ++i) x[q][i] = __builtin_nontemporal_load((const f4_t*)(xin + lane * 4 + 256 * i));
            if (has_y) {
#pragma unroll
                for (int i = 0; i < 4; ++i) {
                    const u2_t raw = __builtin_nontemporal_load((const u2_t*)(HY + (size_t)row * D + lane * 4 + 256 * i));
                    y[q][i].x = __uint_as_float(raw.x << 16); y[q][i].y = __uint_as_float(raw.x & 0xffff0000u);
                    y[q][i].z = __uint_as_float(raw.y << 16); y[q][i].w = __uint_as_float(raw.y & 0xffff0000u);
                    ssy[q] += y[q][i].x * y[q][i].x + y[q][i].y * y[q][i].y + y[q][i].z * y[q][i].z + y[q][i].w * y[q][i].w;
                }
            }
        }
        if (has_y) {
            for (int m = 32; m >= 1; m >>= 1) { ssy[0] += shflx(ssy[0], m); ssy[1] += shflx(ssy[1], m); }
        }
        float ssx[2] = {0.f, 0.f};
        f4_t hv[2][4];
#pragma unroll
        for (int qq = 0; qq < 2; ++qq) {
            const int q = 1 - qq;
            if (mv[q] != cur_mv) {
                cur_mv = mv[q];
#pragma unroll
                for (int i = 0; i < 4; ++i) {
                    if (has_y) vg[i] = *(const f4_t*)(MOD + (size_t)(l_mod_post * 3 + cur_mv) * 9216 + gate_idx * 1024 + lane * 4 + 256 * i);
                    if (has_pre) {
                        const float* sh = MOD + (size_t)(l_mod_pre * 3 + cur_mv) * 9216 + shift_idx * 1024 + lane * 4 + 256 * i;
                        vs0[i] = *(const f4_t*)sh; vs1[i] = *(const f4_t*)(sh + 1024);
                    }
                }
            }
            if (has_y) {
                const float rstd = rsqrtf(ssy[q] * (1.f / D) + EPS);
#pragma unroll
                for (int i = 0; i < 4; ++i) x[q][i] += coef * vg[i] * (y[q][i] * rstd * wpost[i]);
                if (ok[q]) {
#pragma unroll
                    for (int i = 0; i < 4; ++i) __builtin_nontemporal_store(x[q][i], (f4_t*)(xp[q] + lane * 4 + 256 * i));
                }
            }
            if (has_pre) {
#pragma unroll
                for (int i = 0; i < 4; ++i) {
                    ssx[q] += x[q][i].x * x[q][i].x + x[q][i].y * x[q][i].y + x[q][i].z * x[q][i].z + x[q][i].w * x[q][i].w;
                    hv[q][i] = x[q][i] * wpre[i] * (1.f + vs1[i]);
                    y[q][i] = vs0[i];
                }
            }
        }
        if (has_pre) {
            for (int m = 32; m >= 1; m >>= 1) { ssx[0] += shflx(ssx[0], m); ssx[1] += shflx(ssx[1], m); }
#pragma unroll
            for (int q = 0; q < 2; ++q) {
                const float rstd = rsqrtf(ssx[q] * (1.f / D) + EPS);
                if (ok[q]) {
#pragma unroll
                    for (int i = 0; i < 4; ++i) {
                        const f4_t h = hv[q][i] * rstd + y[q][i];
                        uint2 o; o.x = pack2(h.x, h.y); o.y = pack2(h.z, h.w);
                        *(uint2*)(HY + (size_t)rows[q] * D + lane * 4 + 256 * i) = o;
                    }
                }
            }
        }
    }
}

template <int MODE = 0>
PH_FN void gemm1_phase(const KP& p, int l, int f, char* smem, int ntm = NT / 256) {
    const bf16_t* H = (const bf16_t*)(p.ws + OFF_HY);
    const bf16_t* W = (const bf16_t*)(p.ws + OFF_W) + (size_t)l * WL_EL + (f ? WO_GU1 : WO_GU0);
    bf16_t* ACT = (bf16_t*)(p.ws + OFF_ACT);
    const int lane = TIDX() & 63, l31 = lane & 31, hh = lane >> 5;
    const int n_items = (NL / 256) * 44;
    const int n_ctx = ntm > NL / 256 ? (NC / 128) * 44 : 0;
    for (int it = vblock(); it < n_ctx; it += gridDim.x) {
        const int mt = it / 44, nt = it - mt * 44;
        gemm_tile(H, D, W, D, D, NL + mt * 128, nt * 128, smem, [&](f32x16 (&acc)[2][2], int r0, int c0) {
            const int col = (c0 >> 7) * 64 + ((c0 >> 6) & 1) * 32 + l31;
#pragma unroll
            for (int mi = 0; mi < 2; ++mi)
#pragma unroll
                for (int i = 0; i < 16; ++i) ACT[(size_t)(r0 + 32 * mi + crow(i, hh)) * FF + col] = f2bf(siluf_(acc[mi][0][i]) * acc[mi][1][i]);
        });
    }
    for (int it = vblock(); it < n_items; it += gridDim.x) {
        int mt, nt; tile_mn(it, NL / 256, 44, mt, nt);
        gemm_tile256(H, D, W, D, D, mt * 256, nt * 128, smem, [&](f32x16 (&acc)[4][2], int r0, int c0) {
            const int col = (c0 >> 7) * 64 + ((c0 >> 6) & 1) * 32 + l31;
#pragma unroll
            for (int mi = 0; mi < 4; ++mi)
#pragma unroll
                for (int i = 0; i < 16; ++i) {
                    const int row = r0 + 32 * mi + crow(i, hh);
                    ACT[(size_t)row * FF + col] = f2bf(siluf_(acc[mi][0][i]) * acc[mi][1][i]);
                }
        });
    }
}

template <int MODE = 0>
PH_FN void gemm_store_phase(const bf16_t* A, int lda, const bf16_t* W, int K, int ntn, bf16_t* C, int ldc, int ncols, char* smem, int ntm = NT / 128) {
    const int lane = TIDX() & 63, l31 = lane & 31, hh = lane >> 5;
    const int n_items = ntm * ntn;
    for (int it = vblock(); it < n_items; it += gridDim.x) {
        int mt, nt; tile_mn(it, ntm, ntn, mt, nt);
        gemm_tile<MODE>(A, lda, W, K, K, mt * 128, nt * 128, smem, [&](f32x16 (&acc)[2][2], int r0, int c0) {
            if (MODE != 0 && acc[0][0][0] != 123456.789f) return;
#pragma unroll
            for (int ni = 0; ni < 2; ++ni) {
                const int col = c0 + 32 * ni + l31;
                if (col < ncols) {
#pragma unroll
                    for (int mi = 0; mi < 2; ++mi)
#pragma unroll
                        for (int i = 0; i < 16; ++i) C[(size_t)(r0 + 32 * mi + crow(i, hh)) * ldc + col] = f2bf(acc[mi][ni][i]);
                }
            }
        });
    }
}

template <int LDC>
PH_FN void gemm_store_phase256(const bf16_t* A, int lda, const bf16_t* W, int K, int ntn, bf16_t* C, char* smem, int ntm, int nctx128) {
    const int lane = TIDX() & 63, l31 = lane & 31, hh = lane >> 5;
    const int n_items = ntm * ntn;
    for (int it = vblock(); it < nctx128 * ntn; it += gridDim.x) {
        const int mt = it / ntn, nt = it - mt * ntn;
        gemm_tile(A, lda, W, K, K, NL + mt * 128, nt * 128, smem, [&](f32x16 (&acc)[2][2], int r0, int c0) {
#pragma unroll
            for (int mi = 0; mi < 2; ++mi) {
                bf16_t* cp = C + (size_t)(r0 + 32 * mi + 4 * hh) * LDC + c0 + l31;
#pragma unroll
                for (int ni = 0; ni < 2; ++ni)
#pragma unroll
                    for (int i = 0; i < 16; ++i) if (LDC == D || c0 + l31 + 32 * ni < LDC) cp[((i & 3) + 8 * (i >> 2)) * LDC + 32 * ni] = f2bf(acc[mi][ni][i]);
            }
        });
    }
    for (int it = vblock(); it < n_items; it += gridDim.x) {
        int mt, nt; tile_mn(it, ntm, ntn, mt, nt);
        gemm_tile256(A, lda, W, K, K, mt * 256, nt * 128, smem, [&](f32x16 (&acc)[4][2], int r0, int c0) {
#pragma unroll
            for (int mi = 0; mi < 4; ++mi) {
                bf16_t* cp = C + (size_t)(r0 + 32 * mi + 4 * hh) * LDC + c0 + l31;
#pragma unroll
                for (int ni = 0; ni < 2; ++ni)
#pragma unroll
                    for (int i = 0; i < 16; ++i) if (LDC == D || c0 + l31 + 32 * ni < LDC) cp[((i & 3) + 8 * (i >> 2)) * LDC + 32 * ni] = f2bf(acc[mi][ni][i]);
                __builtin_amdgcn_sched_barrier(0);
            }
        });
    }
}

PH_FN void glu_phase(const KP& p, int l, char* smem) {
    const bf16_t* S5P = (const bf16_t*)(p.ws + OFF_S5P);
    const bf16_t* W = (const bf16_t*)(p.ws + OFF_W) + (size_t)l * WL_EL + WO_GLU;
    bf16_t* MIX = (bf16_t*)(p.ws + OFF_MIX);
    const float* bg = p.in[22] + l * 256;
    const int lane = TIDX() & 63, l31 = lane & 31, hh = lane >> 5;
    const int n_items = (NT / 128) * 2;
    for (int it = vblock(); it < n_items; it += gridDim.x) {
        const int mt = it >> 1, nt = it & 1;
        gemm_tile(S5P, 256, W, 256, 256, mt * 128, nt * 128, smem, [&](f32x16 (&acc)[2][2], int r0, int c0) {
#pragma unroll
            for (int ni = 0; ni < 2; ++ni) {
                const int col = c0 + 32 * ni + l31;
                const float b = bg[col];
#pragma unroll
                for (int mi = 0; mi < 2; ++mi)
#pragma unroll
                    for (int i = 0; i < 16; ++i) {
                        const int row = r0 + 32 * mi + crow(i, hh);
                        const float y = bf2f(S5P[(size_t)row * 256 + col]);
                        MIX[(size_t)row * DMIX + col] = f2bf(y * sigmoidf_(acc[mi][ni][i] + b));
                        if ((i & 3) == 3) __builtin_amdgcn_sched_barrier(0);
                    }
            }
        });
    }
}

DI void key_pos(int row, int& b, int& pos) {
    if (row < NL) { b = row >= SEQ ? 1 : 0; pos = row - b * SEQ; }
    else { const int r = row - NL; b = r >> 8; pos = SEQ + (r & 255); }
}

DI void qkv_item(const KP& p, int l, int it, char* smem) {
    const bf16_t* Z = (const bf16_t*)(p.ws + OFF_Z);
    const bf16_t* Wl = (const bf16_t*)(p.ws + OFF_W) + (size_t)l * WL_EL;
    bf16_t* Q = (bf16_t*)(p.ws + OFF_Q);
    bf16_t* Kb = (bf16_t*)(p.ws + OFF_K);
    bf16_t* Vt = (bf16_t*)(p.ws + OFF_VT);
    const float* tab = (const float*)(p.ws + OFF_ROPE);
    const int mt = it / 14, sub = it % 14, row0 = mt * 128;
    const int tid = TIDX(), lane = tid & 63, l31 = lane & 31, hh = lane >> 5;
    __shared__ float s_rs[128];
    {
        const int r = tid >> 1, half = tid & 1;
        const bool isq = sub < 6;
        const int n = isq ? 128 : 64;
        const bf16_t* src = Z + (size_t)(row0 + r) * DIN + (isq ? IN_CQ : IN_CKV) + half * n;
        float ss = 0.f;
        auto sq8 = [&](const u32x4& v) {
#pragma unroll
            for (int q = 0; q < 4; ++q) { const float a = __uint_as_float(v[q] << 16), b = __uint_as_float(v[q] & 0xffff0000u); ss += a * a + b * b; }
        };
        if (isq) {
            u32x4 v[16];
#pragma unroll
            for (int i = 0; i < 16; ++i) v[i] = *(const u32x4*)(src + 8 * i);
#pragma unroll
            for (int i = 0; i < 16; ++i) sq8(v[i]);
        } else {
            u32x4 v[8];
#pragma unroll
            for (int i = 0; i < 8; ++i) v[i] = *(const u32x4*)(src + 8 * i);
#pragma unroll
            for (int i = 0; i < 8; ++i) sq8(v[i]);
        }
        ss += shflx(ss, 1);
        if (half == 0) s_rs[r] = rsqrtf(ss / (float)(2 * n) + EPS);
    }
    __syncthreads();
    if (sub < 6) {
        gemm_tile(Z + IN_CQ, DIN, Wl + WO_UQ, 256, 256, row0, sub * 128, smem, [&](f32x16 (&acc)[2][2], int r0, int c0) {
#pragma unroll
            for (int ni = 0; ni < 2; ++ni) {
                const int cb = c0 + 32 * ni, col = cb + l31;
                const bool is_rope = ((cb >> 5) % 3) == 2;
                const int axis = l31 >> 4, second = (l31 >> 3) & 1, fi = l31 & 7;
#pragma unroll
                for (int mi = 0; mi < 2; ++mi)
#pragma unroll
                    for (int i = 0; i < 16; ++i) {
                        const int row = r0 + 32 * mi + crow(i, hh);
                        float v = acc[mi][ni][i] * s_rs[row - row0];
                        if (is_rope) {
                            const float pr = shflx(v, 8);
                            if (row < NL) {
                                const int t = row & (SEQ - 1);
                                const int pos = axis ? (t & 63) : (t >> 6);
                                const float cs = tab[(pos * 8 + fi) * 2], sn = tab[(pos * 8 + fi) * 2 + 1];
                                v = second ? (v * cs + pr * sn) : (v * cs - pr * sn);
                            }
                        }
                        Q[(size_t)row * 768 + col] = f2bf(v);
                        if ((i & 3) == 3) __builtin_amdgcn_sched_barrier(0);
                    }
            }
        });
    } else {
        const int head = sub - 6;
        gemm_tile(Z + IN_CKV, DIN, Wl + WO_UKV, 128, 128, row0, head * 128, smem, [&](f32x16 (&acc)[2][2], int r0, int c0) {
            const bool isv = (c0 >> 6) & 1;
#pragma unroll
            for (int ni = 0; ni < 2; ++ni) {
                const int dcol = 32 * ni + l31;
#pragma unroll
                for (int mi = 0; mi < 2; ++mi)
#pragma unroll
                    for (int q = 0; q < 4; ++q) {
                        const int rowb = r0 + 32 * mi + 8 * q + 4 * hh;
                        int b, pos; key_pos(rowb, b, pos);
                        float v[4];
#pragma unroll
                        for (int j = 0; j < 4; ++j) v[j] = acc[mi][ni][4 * q + j] * s_rs[rowb + j - row0];
                        if (isv) {
                            uint2 o; o.x = pack2(v[0], v[1]); o.y = pack2(v[2], v[3]);
                            *(uint2*)(Vt + ((size_t)(b * NH + head) * 64 + dcol) * LK + ((pos & ~12) | ((pos & 4) << 1) | ((pos & 8) >> 1))) = o;
                        } else {
#pragma unroll
                            for (int j = 0; j < 4; ++j) Kb[((size_t)(b * NH + head) * LK + pos + j) * DK + dcol] = f2bf(v[j]);
                        }
                    }
            }
        });
        for (int e = tid; e < 128 * 32; e += 256) {
            const int r = e >> 5, d = e & 31, row = row0 + r;
            const bf16_t* kr = Z + (size_t)row * DIN + IN_KR;
            float v = bf2f(kr[d]);
            if (row < NL) {
                const float pr = bf2f(kr[d ^ 8]);
                const int t = row & (SEQ - 1), axis = d >> 4, second = (d >> 3) & 1, fi = d & 7;
                const int pos = axis ? (t & 63) : (t >> 6);
                const float cs = tab[(pos * 8 + fi) * 2], sn = tab[(pos * 8 + fi) * 2 + 1];
                v = second ? (v * cs + pr * sn) : (v * cs - pr * sn);
            }
            int b, pos; key_pos(row, b, pos);
            Kb[((size_t)(b * NH + head) * LK + pos) * DK + 64 + d] = f2bf(v);
        }
    }
    __syncthreads();
}

DI void convpool_item(const KP& p, int l, int it, char* smem) {
    const bf16_t* Z = (const bf16_t*)(p.ws + OFF_Z);
    bf16_t* MIX = (bf16_t*)(p.ws + OFF_MIX);
    float* hs = (float*)smem;
    int L, rowbase, t0;
    if (it < 1024) { L = SEQ; rowbase = (it >> 9) * SEQ; t0 = (it & 511) * 32; }
    else { const int r = it - 1024; L = CTXL; rowbase = NL + (r >> 3) * CTXL; t0 = (r & 7) * 32; }
    const int c = TIDX(), lane = c & 63, wave = c >> 6;
    {
        const int c4 = (c & 63) * 4, ts = c >> 6;
#pragma unroll 4
        for (int j = ts; j < 62; j += 4) {
            const int t = t0 - 15 + j;
            float4 h = make_float4(0.f, 0.f, 0.f, 0.f);
            if (t >= 0 && t < L) {
                const bf16_t* zr = Z + (size_t)(rowbase + t) * DIN + IN_CONV + c4;
                const uint2 v = *(const uint2*)zr, g = *(const uint2*)(zr + 256);
                h.x = __uint_as_float(v.x << 16) * sigmoidf_(__uint_as_float(g.x << 16));
                h.y = __uint_as_float(v.x & 0xffff0000u) * sigmoidf_(__uint_as_float(g.x & 0xffff0000u));
                h.z = __uint_as_float(v.y << 16) * sigmoidf_(__uint_as_float(g.y << 16));
                h.w = __uint_as_float(v.y & 0xffff0000u) * sigmoidf_(__uint_as_float(g.y & 0xffff0000u));
            }
            *(float4*)(hs + j * 256 + c4) = h;
        }
    }
    __syncthreads();
    float w[31];
#pragma unroll
    for (int k = 0; k < 31; ++k) w[k] = p.in[23][(size_t)(l * 31 + k) * 256 + c];
    const float cb = p.in[24][l * 256 + c];
#pragma unroll 1
    for (int tt = 0; tt < 32; ++tt) {
        float s = cb;
#pragma unroll
        for (int k = 0; k < 31; ++k) s += w[k] * hs[(tt + k) * 256 + c];
        hs[tt * 256 + c] = s;
    }
    __syncthreads();
    {
        const float4 lg = *(const float4*)(p.in[25] + l * 256 + lane * 4);
        const float4 lb = *(const float4*)(p.in[26] + l * 256 + lane * 4);
#pragma unroll 1
        for (int q = 0; q < 8; ++q) {
            const int tt = wave * 8 + q;
            const float4 v = *(const float4*)(hs + tt * 256 + lane * 4);
            const float mean = wave_sum(v.x + v.y + v.z + v.w) * (1.f / 256.f);
            const float d0 = v.x - mean, d1 = v.y - mean, d2 = v.z - mean, d3 = v.w - mean;
            const float var = wave_sum(d0 * d0 + d1 * d1 + d2 * d2 + d3 * d3) * (1.f / 256.f);
            const float rstd = rsqrtf(var + EPS);
            uint2 o;
            o.x = pack2(siluf_(d0 * rstd * lg.x + lb.x), siluf_(d1 * rstd * lg.y + lb.y));
            o.y = pack2(siluf_(d2 * rstd * lg.z + lb.z), siluf_(d3 * rstd * lg.w + lb.w));
            *(uint2*)(MIX + (size_t)(rowbase + t0 + tt) * DMIX + 256 + lane * 4) = o;
        }
    }
    __syncthreads();
    {
        const int c4 = (c & 63) * 4, ts = c >> 6;
#pragma unroll 4
        for (int j = ts; j < 47; j += 4) {
            const int t = t0 - 7 + j;
            float4 h = make_float4(0.f, 0.f, 0.f, 0.f);
            if (t >= 0 && t < L) {
                const uint2 v = *(const uint2*)(Z + (size_t)(rowbase + t) * DIN + IN_POOL + c4);
                h.x = __uint_as_float(v.x << 16); h.y = __uint_as_float(v.x & 0xffff0000u); h.z = __uint_as_float(v.y << 16); h.w = __uint_as_float(v.y & 0xffff0000u);
            }
            *(float4*)(hs + j * 256 + c4) = h;
        }
    }
    __syncthreads();
    {
        const int win = 2 << (c >> 6), wa = (win - 1) >> 1, wb = win >> 1;
#pragma unroll 1
        for (int tt = 0; tt < 32; ++tt) {
            const int t = t0 + tt;
            const int lo = max(t - wa, 0), hi = min(t + wb, L - 1);
            float s = 0.f;
            for (int q = lo; q <= hi; ++q) s += hs[(q - t0 + 7) * 256 + c];
            const float o = s / (float)(hi - lo + 1) - hs[(tt + 7) * 256 + c];
            MIX[(size_t)(rowbase + t) * DMIX + 512 + c] = f2bf(o);
        }
    }
    __syncthreads();
}

DI int chunk_row(int b, int k) { return k < 4 ? NL + b * CTXL + 64 * k : b * SEQ + 64 * (k - 4); }

template <bool FINAL>
DI void s5_item(const KP& p, int l, int it, char* smem) {
    const int g4 = it & 3, k = (it >> 2) % NCHUNK, b = (it >> 2) / NCHUNK;
    const int tid = TIDX(), lane = tid & 63, wave = tid >> 6, g = g4 * 4 + wave;
    const bf16_t* Z = (const bf16_t*)(p.ws + OFF_Z);
    float* Us = (float*)smem + wave * 1024;
    bf16_t* Hs = (bf16_t*)(smem + 16384) + wave * (16 * 136);
    const int rbase = chunk_row(b, k);
    {
        const uint4* src = (const uint4*)(Z + (size_t)(rbase + lane) * DIN + g * 16);
        const uint4 v0 = src[0], v1 = src[1];
        const unsigned w[8] = {v0.x, v0.y, v0.z, v0.w, v1.x, v1.y, v1.z, v1.w};
#pragma unroll
        for (int q = 0; q < 8; ++q) { Us[lane * 16 + 2 * q] = __uint_as_float(w[q] << 16); Us[lane * 16 + 2 * q + 1] = __uint_as_float(w[q] & 0xffff0000u); }
    }
    __syncthreads();
    f32x4 yacc[4];
#pragma unroll
    for (int s = 0; s < 4; ++s) yacc[s] = f32x4{0.f, 0.f, 0.f, 0.f};
#pragma unroll
    for (int dir = 0; dir < 2; ++dir) {
        const int pidx = ((l * 2 + dir) * 16 + g) * 64 + lane;
        const float4 lam = ((const float4*)(p.ws + OFF_LAMB))[pidx];
        float br[16], bi[16];
        {
            const float4* bb = (const float4*)((const float*)(p.ws + OFF_BBAR) + (size_t)pidx * 32);
#pragma unroll
            for (int q = 0; q < 8; ++q) { const float4 v = bb[q]; br[2 * q] = v.x; bi[2 * q] = v.y; br[2 * q + 1] = v.z; bi[2 * q + 1] = v.w; }
        }
        const size_t sidx = ((size_t)((b * 2 + dir) * NCHUNK + k) * 16 + g) * 64 + lane;
        float hr = 0.f, hi = 0.f;
        bf16x8 cfr[4];
        if (FINAL) {
            const float2 s0 = ((const float2*)(p.ws + OFF_S))[sidx];
            hr = s0.x; hi = s0.y;
            const bf16_t* cc = (const bf16_t*)(p.ws + OFF_CC) + (size_t)((l * 2 + dir) * 16 + g) * 2048 + (lane & 15) * 128 + (lane >> 4) * 8;
#pragma unroll
            for (int ks = 0; ks < 4; ++ks) cfr[ks] = *(const bf16x8*)(cc + 32 * ks);
        }
#pragma unroll
        for (int s = 0; s < 4; ++s) {
            const int sb = dir ? 3 - s : s;
#pragma unroll 1
            for (int tt = 0; tt < 16; ++tt) {
                const int tl = dir ? 15 - tt : tt, t = sb * 16 + tl;
                const float4* up = (const float4*)(Us + t * 16);
                float ar = 0.f, ai = 0.f;
#pragma unroll
                for (int q = 0; q < 4; ++q) {
                    const float4 u = up[q];
                    ar += br[4 * q] * u.x + br[4 * q + 1] * u.y + br[4 * q + 2] * u.z + br[4 * q + 3] * u.w;
                    ai += bi[4 * q] * u.x + bi[4 * q + 1] * u.y + bi[4 * q + 2] * u.z + bi[4 * q + 3] * u.w;
                }
                const float nr = lam.x * hr - lam.y * hi + ar, ni = lam.x * hi + lam.y * hr + ai;
                hr = nr; hi = ni;
                if (FINAL) { Hs[tl * 136 + lane] = f2bf(hr); Hs[tl * 136 + 64 + lane] = f2bf(hi); }
            }
            if (FINAL) {
                __syncthreads();
                const bf16_t* hp = Hs + (lane & 15) * 136 + (lane >> 4) * 8;
#pragma unroll
                for (int ks = 0; ks < 4; ++ks) { const bf16x8 a = *(const bf16x8*)(hp + 32 * ks); yacc[sb] = MFMA16(a, cfr[ks], yacc[sb]); }
                __syncthreads();
            }
        }
        if (!FINAL) ((float2*)(p.ws + OFF_E))[sidx] = make_float2(hr, hi);
    }
    if (FINAL) {
        bf16_t* S5P = (bf16_t*)(p.ws + OFF_S5P);
        const int hcol = lane & 15;
        const float dg = p.in[20][l * 256 + g * 16 + hcol];
#pragma unroll
        for (int s = 0; s < 4; ++s)
#pragma unroll
            for (int j = 0; j < 4; ++j) {
                const int t = s * 16 + (lane >> 4) * 4 + j;
                const float y = yacc[s][j] + dg * Us[t * 16 + hcol];
                S5P[(size_t)(rbase + t) * 256 + g * 16 + hcol] = f2bf(gelu_tanh(y));
            }
    }
    __syncthreads();
}

DI void s5_carry(const KP& p, int l, int blk) {
    const int idx = blk * 256 + TIDX();
    const int gp = idx & 1023, dir = (idx >> 10) & 1, b = idx >> 11;
    const float4 lam = ((const float4*)(p.ws + OFF_LAMB))[(l * 2 + dir) * 1024 + gp];
    const float2* E = (const float2*)(p.ws + OFF_E) + (size_t)(b * 2 + dir) * NCHUNK * 1024 + gp;
    float2* S = (float2*)(p.ws + OFF_S) + (size_t)(b * 2 + dir) * NCHUNK * 1024 + gp;
    float sr = 0.f, si = 0.f;
    for (int j0 = 0; j0 < NCHUNK; j0 += 4) {
        const int k0 = dir ? (j0 < 4 ? 3 - j0 : 263 - j0) : j0, stp = dir ? -1 : 1;
        const float2 e0 = E[(size_t)k0 * 1024], e1 = E[(size_t)(k0 + stp) * 1024], e2 = E[(size_t)(k0 + 2 * stp) * 1024], e3 = E[(size_t)(k0 + 3 * stp) * 1024];
        float nr, ni;
        S[(size_t)k0 * 1024] = make_float2(sr, si);
        nr = lam.z * sr - lam.w * si + e0.x; ni = lam.z * si + lam.w * sr + e0.y; sr = nr; si = ni;
        S[(size_t)(k0 + stp) * 1024] = make_float2(sr, si);
        nr = lam.z * sr - lam.w * si + e1.x; ni = lam.z * si + lam.w * sr + e1.y; sr = nr; si = ni;
        S[(size_t)(k0 + 2 * stp) * 1024] = make_float2(sr, si);
        nr = lam.z * sr - lam.w * si + e2.x; ni = lam.z * si + lam.w * sr + e2.y; sr = nr; si = ni;
        S[(size_t)(k0 + 3 * stp) * 1024] = make_float2(sr, si);
        nr = lam.z * sr - lam.w * si + e3.x; ni = lam.z * si + lam.w * sr + e3.y; sr = nr; si = ni;
    }
}

DI void attn_item(const KP& p, int it, char* smem) {
    const bf16_t* Q = (const bf16_t*)(p.ws + OFF_Q);
    const bf16_t* Kg = (const bf16_t*)(p.ws + OFF_K);
    const bf16_t* Vg = (const bf16_t*)(p.ws + OFF_VT);
    bf16_t* MIX = (bf16_t*)(p.ws + OFF_MIX);
    const int tid = TIDX(), lane = tid & 63, wave = tid >> 6, l31 = lane & 31, hh = lane >> 5;
    int bh, qrow0, kt0, T;
    if (it < 1024) { bh = it >> 6; qrow0 = (bh >> 3) * SEQ + (it & 63) * 256; kt0 = 0; T = NCHUNK; }
    else { bh = it - 1024; qrow0 = NL + (bh >> 3) * CTXL; kt0 = SEQ / 64; T = CTXL / 64; }
    const int head = bh & 7;
    const bf16_t* Kb = Kg + (size_t)bh * LK * DK + (size_t)kt0 * 64 * DK;
    const bf16_t* Vb = Vg + (size_t)bh * 64 * LK + kt0 * 64;
    bf16_t* sK = (bf16_t*)smem;
    bf16_t* sV = sK + 2 * 64 * 104;
    const int qrow = qrow0 + wave * 64 + l31;
    bf16x8 qf[2][6];
#pragma unroll
    for (int qb = 0; qb < 2; ++qb)
#pragma unroll
        for (int s = 0; s < 6; ++s) qf[qb][s] = *(const bf16x8*)(Q + (size_t)(qrow + 32 * qb) * 768 + head * 96 + 16 * s + 8 * hh);
    f32x16 o[2][2];
#pragma unroll
    for (int i = 0; i < 16; ++i) { o[0][0][i] = 0.f; o[0][1][i] = 0.f; o[1][0][i] = 0.f; o[1][1][i] = 0.f; }
    float m_run[2] = {-1e30f, -1e30f}, l_run[2] = {0.f, 0.f};
    u32x4 rk0, rk1, rk2, rv0, rv1;
    const int vrow = tid >> 3, vcol = (tid & 7) * 8;
    const int kw0 = (tid / 12) * 104 + (tid % 12) * 8, kw1 = ((tid + 256) / 12) * 104 + ((tid + 256) % 12) * 8, kw2 = ((tid + 512) / 12) * 104 + ((tid + 512) % 12) * 8;
    const bf16_t* cK = sK + l31 * 104 + 8 * hh;
    const bf16_t* cV = sV + l31 * 72 + 8 * hh;
#define ATT_KWRITE(buf_) do { bf16_t* k_ = sK + (buf_) * 64 * 104; *(u32x4*)(k_ + kw0) = rk0; *(u32x4*)(k_ + kw1) = rk1; *(u32x4*)(k_ + kw2) = rk2; } while (0)
#define ATT_VWRITE(buf_) do { bf16_t* v_ = sV + (buf_) * 64 * 72 + vrow * 72 + vcol; *(u32x4*)(v_) = rv0; *(u32x4*)(v_ + 32 * 72) = rv1; } while (0)
    {
        const bf16_t* kp = Kb + tid * 8;
        rk0 = *(const u32x4*)(kp); rk1 = *(const u32x4*)(kp + 2048); rk2 = *(const u32x4*)(kp + 4096);
        const bf16_t* vp = Vb + (size_t)vrow * LK + vcol;
        rv0 = *(const u32x4*)(vp); rv1 = *(const u32x4*)(vp + (size_t)32 * LK);
        ATT_KWRITE(0); ATT_VWRITE(0);
    }
    __syncthreads();
#pragma unroll 2
    for (int t = 0; t < T; ++t) {
        const int buf = t & 1;
        const bool more = (t + 1) < T;
        if (more) {
            const bf16_t* kp_ = Kb + (size_t)(t + 1) * 64 * DK + tid * 8; gld16(rk0, kp_); gld16(rk1, kp_ + 2048); gld16(rk2, kp_ + 4096);
            const bf16_t* vp_ = Vb + (size_t)vrow * LK + (t + 1) * 64 + vcol; gld16(rv0, vp_); gld16(rv1, vp_ + (size_t)32 * LK);
        }
#pragma unroll
        for (int kb = 0; kb < 2; ++kb) {
            if (kb == 1 && more) { vm_wait5(rk0, rk1, rk2, rv0, rv1); ATT_KWRITE(buf ^ 1); ATT_VWRITE(buf ^ 1); }
            f32x16 s[2];
#pragma unroll
            for (int i = 0; i < 16; ++i) { s[0][i] = 0.f; s[1][i] = 0.f; }
            bf16x8 kf[6];
#pragma unroll
            for (int ks = 0; ks < 6; ++ks) kf[ks] = *(const bf16x8*)(cK + buf * 64 * 104 + kb * 32 * 104 + 16 * ks);
            __builtin_amdgcn_sched_barrier(0);
            __builtin_amdgcn_s_setprio(1);
#pragma unroll
            for (int ks = 0; ks < 6; ++ks) {
                s[0] = MFMA32(kf[ks], qf[0][ks], s[0]);
                s[1] = MFMA32(kf[ks], qf[1][ks], s[1]);
            }
            __builtin_amdgcn_s_setprio(0);
#pragma unroll
            for (int qb = 0; qb < 2; ++qb) {
                float mx = s[qb][0];
#pragma unroll
                for (int i = 1; i < 16; ++i) mx = fmaxf(mx, s[qb][i]);
                mx = xhalf_max(mx);
                const float m_new = fmaxf(m_run[qb], mx);
                if (__builtin_amdgcn_ballot_w64(m_new > m_run[qb]) != 0ull) {
                    const float alpha = __builtin_amdgcn_exp2f(m_run[qb] - m_new);
                    m_run[qb] = m_new; l_run[qb] *= alpha;
#pragma unroll
                    for (int i = 0; i < 16; ++i) { o[qb][0][i] *= alpha; o[qb][1][i] *= alpha; }
                }
                float ps = 0.f;
#pragma unroll
                for (int i = 0; i < 16; ++i) { s[qb][i] = __builtin_amdgcn_exp2f(s[qb][i] - m_run[qb]); ps += s[qb][i]; }
                l_run[qb] += ps;
            }
            bf16x8 vf[2][2];
#pragma unroll
            for (int u = 0; u < 2; ++u)
#pragma unroll
                for (int dvb = 0; dvb < 2; ++dvb) vf[u][dvb] = *(const bf16x8*)(cV + buf * 64 * 72 + dvb * 32 * 72 + 32 * kb + 16 * u);
            __builtin_amdgcn_sched_barrier(0);
#pragma unroll
            for (int u = 0; u < 2; ++u) {
                const bf16x8 p0 = __builtin_bit_cast(bf16x8, u32x4{pack2(s[0][8 * u], s[0][8 * u + 1]), pack2(s[0][8 * u + 2], s[0][8 * u + 3]), pack2(s[0][8 * u + 4], s[0][8 * u + 5]), pack2(s[0][8 * u + 6], s[0][8 * u + 7])});
                const bf16x8 p1 = __builtin_bit_cast(bf16x8, u32x4{pack2(s[1][8 * u], s[1][8 * u + 1]), pack2(s[1][8 * u + 2], s[1][8 * u + 3]), pack2(s[1][8 * u + 4], s[1][8 * u + 5]), pack2(s[1][8 * u + 6], s[1][8 * u + 7])});
                __builtin_amdgcn_s_setprio(1);
#pragma unroll
                for (int dvb = 0; dvb < 2; ++dvb) {
                    o[0][dvb] = MFMA32(vf[u][dvb], p0, o[0][dvb]);
                    o[1][dvb] = MFMA32(vf[u][dvb], p1, o[1][dvb]);
                }
                __builtin_amdgcn_s_setprio(0);
            }
        }
        __syncthreads();
    }
#undef ATT_KWRITE
#undef ATT_VWRITE
#pragma unroll
    for (int qb = 0; qb < 2; ++qb) {
        const float lt = xhalf_sum(l_run[qb]);
        const float inv = 1.f / lt;
#pragma unroll
        for (int dvb = 0; dvb < 2; ++dvb)
#pragma unroll
            for (int q = 0; q < 4; ++q) {
                uint2 ov; ov.x = pack2(o[qb][dvb][4 * q] * inv, o[qb][dvb][4 * q + 1] * inv); ov.y = pack2(o[qb][dvb][4 * q + 2] * inv, o[qb][dvb][4 * q + 3] * inv);
                *(uint2*)(MIX + (size_t)(qrow + 32 * qb) * DMIX + 768 + head * 64 + 32 * dvb + 8 * q + 4 * hh) = ov;
            }
    }
}

PH_FN void misc_phase(const KP& p, int l, char* smem) {
    const int n_qkv = 260 * 14, n_cp = l == 1 ? 1024 : 1040, n_s5 = 2 * NCHUNK * 4;
    const int rot = (blockIdx.x + gridDim.x / 2) % gridDim.x;
    for (int it = vblock(); it < n_qkv; it += gridDim.x) qkv_item(p, l, it, smem);
    for (int it = rot; it < n_cp; it += gridDim.x) convpool_item(p, l, it, smem);
    for (int it = blockIdx.x; it < n_s5; it += gridDim.x) s5_item<false>(p, l, it, smem);
#if MISC_DUP == 1
    for (int it = vblock(); it < n_qkv; it += gridDim.x) qkv_item(p, l, it, smem);
#elif MISC_DUP == 2
    for (int it = rot; it < n_cp; it += gridDim.x) convpool_item(p, l, it, smem);
#elif MISC_DUP == 3
    for (int it = blockIdx.x; it < n_s5; it += gridDim.x) s5_item<false>(p, l, it, smem);
#endif
}
PH_FN void attn_phase(const KP& p, int l, char* smem) {
    const int n_att = l == 1 ? 1024 : 1024 + 16;
    if (blockIdx.x < 16) s5_carry(p, l, blockIdx.x);
    for (int it = vblock(); it < n_att; it += gridDim.x) attn_item(p, it, smem);
}
PH_FN void s5fin_phase(const KP& p, int l, char* smem) {
    for (int it = blockIdx.x; it < 2 * NCHUNK * 4; it += gridDim.x) s5_item<true>(p, l, it, smem);
}

DI void run_phase(const KP& p, int ph, char* smem) {
    if (ph == 0) { prep_phase(p, smem); return; }
    if (ph == 27) {
        rowop_phase(p, 1, 8, 0.5f, p.in[7] + (1 * 3 + 2) * D, true, 0, 0, nullptr, false, false, NL);
        return;
    }
    const int l = (ph - 1) / 13, s = (ph - 1) % 13;
    const bf16_t* Wl = (const bf16_t*)(p.ws + OFF_W) + (size_t)l * WL_EL;
    const float* npre = p.in[6] + (size_t)l * 3 * D;
    const float* npost = p.in[7] + (size_t)l * 3 * D;
    const bool lastl = l == 1;
    switch (s) {
    case 0:
        if (l == 0) rowop_phase(p, 0, 0, 0.f, nullptr, false, 0, 0, npre, true, true);
        else rowop_phase(p, l - 1, 8, 0.5f, p.in[7] + ((l - 1) * 3 + 2) * D, true, l, 0, npre, true, false);
        break;
    case 1: case 11: gemm1_phase(p, l, s == 11, smem, (lastl && s == 11) ? NL / 256 : NT / 256); break;
    case 2: case 9: case 12: {
        const bool isout = s == 9;
        const bf16_t* Ag = (const bf16_t*)(p.ws + (isout ? OFF_MIX : OFF_ACT));
        const bf16_t* Wg = Wl + (isout ? WO_OUT : (s == 12 ? WO_D1 : WO_D0));
        const int Kg = isout ? DMIX : FF;
        gemm_store_phase256<D>(Ag, Kg, Wg, Kg, 8, (bf16_t*)(p.ws + OFF_HY), smem, NL / 256, (lastl && s != 2) ? 0 : NC / 128);
    } break;
    case 3: rowop_phase(p, l, 2, 0.5f, npost, true, l, 3, npre + D, true, l == 0); break;
    case 4: gemm_store_phase256<DIN>((const bf16_t*)(p.ws + OFF_HY), D, Wl + WO_IN, D, 12, (bf16_t*)(p.ws + OFF_Z), smem, NL / 256, NC / 128); break;
    case 5: misc_phase(p, l, smem); break;
    case 6: attn_phase(p, l, smem); break;
    case 7: s5fin_phase(p, l, smem); break;
    case 8: glu_phase(p, l, smem); break;
    case 10: rowop_phase(p, l, 5, 1.0f, npost + D, true, l, 6, npre + 2 * D, true, false, lastl ? NL : NT); break;
    }
}

constexpr int N_PHASES = 28;

__global__ void __launch_bounds__(256, 2) mega_kernel(KP p, int ph_lo, int ph_hi) {
    __shared__ __attribute__((aligned(16))) char smem[65536];
    __shared__ KP s_kp;
    if (TIDX() < 33) s_kp.in[TIDX()] = p.in[TIDX()];
    if (TIDX() == 33) s_kp.out = p.out;
    if (TIDX() == 34) s_kp.ws = p.ws;
    __shared__ uint4 xb_words;
    if (TIDX() == 0) xb_words = make_uint4(0u, 0u, 0u, 0u);
    __syncthreads();
    XcdBarrier xb = xcd_barrier_post((unsigned*)(p.ws + OFF_BAR), (volatile LAS unsigned*)&xb_words);
    for (int ph = ph_lo; ph < ph_hi; ++ph) {
        run_phase(p, ph, smem);
        if (DUP_MASK) {
            const int sbit = ph == 0 ? 13 : (ph == 27 ? 14 : (ph - 1) % 13);
            if ((DUP_MASK >> sbit) & 1) { xcd_barrier(xb); run_phase(p, ph, smem); }
        }
#if PROBE_MODE
        {
            const int sb = ph == 0 || ph == 27 ? -1 : (ph - 1) % 13, pl = (ph - 1) / 13;
            const bf16_t* Wl = (const bf16_t*)(s_kp.ws + OFF_W) + (size_t)pl * WL_EL;
            if (sb == 1 || sb == 11) { cg::this_grid().sync(); gemm1_phase<PROBE_MODE>(s_kp, pl, sb == 11, smem); }
            if (sb == 2 || sb == 12) { cg::this_grid().sync(); gemm_store_phase<PROBE_MODE>((const bf16_t*)(s_kp.ws + OFF_ACT), FF, Wl + (sb == 12 ? WO_D1 : WO_D0), FF, 8, (bf16_t*)(s_kp.ws + OFF_HY), D, D, smem); }
        }
#endif
        if (EXTRA_SYNCS) { xcd_barrier(xb); xcd_barrier(xb); }
        if (ph + 1 < ph_hi) { if (ph_hi < 0) cg::this_grid().sync(); else xcd_barrier(xb); }
    }
}

extern "C" void kernel_launch(void* const* d_in, const int* in_sizes, int n_in, void* d_out, int out_size, void* d_ws, size_t ws_size, hipStream_t stream) {
    static int grid = 0;
    if (grid == 0) {
        if (n_in != 33 || ws_size < WS_END) { fprintf(stderr, "kernel_launch: unexpected n_in %d or ws_size %zu < %zu\n", n_in, ws_size, (size_t)WS_END); grid = -1; return; }
        int dev = 0, cus = 0, per_cu = 0;
        hipGetDevice(&dev);
        hipDeviceGetAttribute(&cus, hipDeviceAttributeMultiprocessorCount, dev);
        hipOccupancyMaxActiveBlocksPerMultiprocessor(&per_cu, (const void*)mega_kernel, 256, 0);
        if (per_cu < 1) per_cu = 1;
        if (per_cu > 2) per_cu = 2;
        grid = cus * per_cu;
    }
    if (grid < 0) return;
    KP p{};
    for (int i = 0; i < 33; ++i) p.in[i] = (const float*)d_in[i];
    p.out = (float*)d_out; p.ws = (char*)d_ws;
    if (hipMemsetAsync((char*)d_ws + OFF_BAR, 0, 3456 * 4, stream) != hipSuccess) { fprintf(stderr, "kernel_launch: memset of barrier words failed\n"); return; }
#if ONE_LAUNCH
    int lo = 0, hi = N_PHASES;
    void* args[] = {&p, &lo, &hi};
    hipError_t e = hipLaunchCooperativeKernel((const void*)mega_kernel, dim3(grid), dim3(256), args, 0, stream);
    if (e != hipSuccess) fprintf(stderr, "cooperative launch failed: %s (grid %d)\n", hipGetErrorString(e), grid);
#else
    for (int ph = 0; ph < N_PHASES; ++ph) hipLaunchKernelGGL(mega_kernel, dim3(grid), dim3(256), 0, stream, p, ph, ph + 1);
#endif
}
```
